# Optimizing an MI355X kernel written in HIP

```python
import jax, jax.numpy as jnp
from jax import lax
import numpy as np

D_MODEL = 1024
BATCH = 8
SEQ = 2048
DEPTH = 2

HEAD_DIM = 64
N_ATTN_HEADS = 8
N_SGU_GROUPS = 8
ATTN_WIDTH = N_ATTN_HEADS * HEAD_DIM
SGU_WIDTH = N_SGU_GROUPS * HEAD_DIM
MIX_WIDTH = ATTN_WIDTH + SGU_WIDTH
IN_COLS = 3 * ATTN_WIDTH + N_ATTN_HEADS + 2 * SGU_WIDTH
Q_BLOCK = 128
CHUNK = 128
D_FF_DENSE = 2816
N_EXPERTS = 8
TOP_K = 2
D_FF_EXPERT = 3584
N_MOD = 6
EPS = 1e-6
N_DENSE = (DEPTH + 1) // 2
N_MOE = DEPTH // 2

kernel_name = "hybrid_fox_sgu_moe_block"


def rmsnorm(x, g):
    xf = x.astype(jnp.float32)
    y = xf * lax.rsqrt(jnp.mean(xf * xf, axis=-1, keepdims=True) + EPS)
    return (y * g.astype(jnp.float32)).astype(x.dtype)


def layernorm_nobias(x, g):
    xf = x.astype(jnp.float32)
    xc = xf - jnp.mean(xf, axis=-1, keepdims=True)
    y = xc * lax.rsqrt(jnp.mean(xc * xc, axis=-1, keepdims=True) + EPS)
    return (y * g.astype(jnp.float32)).astype(x.dtype)


def forgetting_attention(q, k, v, log_f):
    B, H, S, dh = q.shape
    nb = S // Q_BLOCK
    scale = HEAD_DIM ** -0.5
    L = jnp.cumsum(log_f, axis=-1)
    qb = q.reshape(B, H, nb, Q_BLOCK, dh).transpose(2, 0, 1, 3, 4)
    Lb = L.reshape(B, H, nb, Q_BLOCK).transpose(2, 0, 1, 3)
    k_pos = jnp.arange(S)

    def one_block(args):
        q_blk, L_blk, i = args
        q_pos = i * Q_BLOCK + jnp.arange(Q_BLOCK)
        logits = jnp.einsum('bhqd,bhkd->bhqk', q_blk, k).astype(jnp.float32) * scale
        logits = logits + L_blk[..., :, None] - L[..., None, :]
        logits = jnp.where(k_pos[None, :] <= q_pos[:, None], logits, -jnp.inf)
        p = jax.nn.softmax(logits, axis=-1).astype(v.dtype)
        return jnp.einsum('bhqk,bhkd->bhqd', p, v)

    out = lax.map(one_block, (qb, Lb, jnp.arange(nb)))
    return out.transpose(1, 2, 0, 3, 4).reshape(B, H, S, dh)


def spatial_gating(u, v, w_spatial, b_spatial):
    B, S, _ = u.shape
    nc = S // CHUNK
    causal = jnp.tril(jnp.ones((CHUNK, CHUNK), dtype=w_spatial.dtype))
    w = w_spatial * causal[None]
    vc = v.reshape(B, nc, CHUNK, N_SGU_GROUPS, HEAD_DIM)
    mixed = jnp.einsum('gts,bcsgd->bctgd', w, vc) + b_spatial.T[:, :, None]
    out = u.reshape(B, nc, CHUNK, N_SGU_GROUPS, HEAD_DIM) * mixed
    return out.reshape(B, S, SGU_WIDTH)


def token_mixer(h, w_in, b_forget, g_v, w_spatial, b_spatial, g_out_attn, g_out_sgu, w_out):
    B, S, _ = h.shape
    z = jnp.einsum('bsd,dc->bsc', h, w_in)
    o1 = ATTN_WIDTH
    o2 = 2 * ATTN_WIDTH
    o3 = 3 * ATTN_WIDTH
    o4 = o3 + N_ATTN_HEADS
    def heads(t):
        return t.reshape(B, S, N_ATTN_HEADS, HEAD_DIM).transpose(0, 2, 1, 3)
    q = heads(z[..., :o1])
    k = heads(z[..., o1:o2])
    v = heads(z[..., o2:o3])
    log_f = jax.nn.log_sigmoid(z[..., o3:o4].astype(jnp.float32)
                               + b_forget.astype(jnp.float32)).transpose(0, 2, 1)
    attn = forgetting_attention(q, k, v, log_f)
    attn = attn.transpose(0, 2, 1, 3).reshape(B, S, ATTN_WIDTH)
    uv = jax.nn.gelu(z[..., o4:])
    u = uv[..., :SGU_WIDTH]
    sv = layernorm_nobias(uv[..., SGU_WIDTH:], g_v)
    sgu = spatial_gating(u, sv, w_spatial, b_spatial)
    merged = jnp.concatenate([rmsnorm(attn, g_out_attn), rmsnorm(sgu, g_out_sgu)], axis=-1)
    return jnp.einsum('bsm,md->bsd', merged, w_out)


def swiglu(h, w_gate_up, w_down, d_ff):
    gu = jnp.einsum('...d,df->...f', h, w_gate_up)
    act = jax.nn.silu(gu[..., :d_ff]) * gu[..., d_ff:]
    return jnp.einsum('...f,fd->...d', act, w_down)


def moe_swiglu(h, w_router, w_gate_up_exp, w_down_exp):
    B, S, D = h.shape
    xt = h.reshape(B * S, D)
    logits = jnp.einsum('nd,de->ne', xt, w_router).astype(jnp.float32)
    top_vals, top_idx = lax.top_k(logits, TOP_K)
    top_w = jax.nn.softmax(top_vals, axis=-1)
    gates = jnp.sum(jax.nn.one_hot(top_idx, N_EXPERTS, dtype=jnp.float32) * top_w[..., None], axis=1)
    gates = gates.astype(h.dtype)
    out = jnp.zeros_like(xt)
    for e in range(N_EXPERTS):
        out = out + gates[:, e:e + 1] * swiglu(xt, w_gate_up_exp[e], w_down_exp[e], D_FF_EXPERT)
    return out.reshape(B, S, D)


def setup_inputs(seed: int = 0) -> dict:
    key = jax.random.key(seed)
    ks = jax.random.split(key, 24)
    f32 = jnp.float32
    D = D_MODEL
    def nrm(k, shape, scale):
        return jax.random.normal(k, shape, f32) * scale
    def gain(k, shape):
        return 1.0 + 0.02 * jax.random.normal(k, shape, f32)
    return {
        "x": jax.random.normal(ks[0], (BATCH, SEQ, D), f32),
        "c": jax.random.normal(ks[1], (BATCH, D), f32),
        "w_ada": nrm(ks[2], (DEPTH, D, N_MOD * D), 0.1 * D ** -0.5),
        "b_ada": nrm(ks[3], (DEPTH, N_MOD * D), 0.01),
        "g_pre_mix": gain(ks[4], (DEPTH, D)),
        "g_post_mix": gain(ks[5], (DEPTH, D)),
        "g_pre_ffn": gain(ks[6], (DEPTH, D)),
        "g_post_ffn": gain(ks[7], (DEPTH, D)),
        "w_in": nrm(ks[8], (DEPTH, D, IN_COLS), D ** -0.5),
        "b_forget": jax.random.uniform(ks[9], (DEPTH, N_ATTN_HEADS), f32, 1.0, 5.0),
        "g_v": gain(ks[10], (DEPTH, SGU_WIDTH)),
        "w_spatial": nrm(ks[11], (DEPTH, N_SGU_GROUPS, CHUNK, CHUNK), 0.5 * CHUNK ** -0.5),
        "b_spatial": 1.0 + nrm(ks[12], (DEPTH, N_SGU_GROUPS, CHUNK), 0.1),
        "g_out_attn": gain(ks[13], (DEPTH, ATTN_WIDTH)),
        "g_out_sgu": gain(ks[14], (DEPTH, SGU_WIDTH)),
        "w_out": nrm(ks[15], (DEPTH, MIX_WIDTH, D), MIX_WIDTH ** -0.5),
        "w_gate_up_dense": nrm(ks[16], (N_DENSE, D, 2 * D_FF_DENSE), D ** -0.5),
        "w_down_dense": nrm(ks[17], (N_DENSE, D_FF_DENSE, D), D_FF_DENSE ** -0.5),
        "w_router": nrm(ks[18], (N_MOE, D, N_EXPERTS), D ** -0.5),
        "w_gate_up_exp": nrm(ks[19], (N_MOE, N_EXPERTS, D, 2 * D_FF_EXPERT), D ** -0.5),
        "w_down_exp": nrm(ks[20], (N_MOE, N_EXPERTS, D_FF_EXPERT, D), D_FF_EXPERT ** -0.5),
    }


def reference(x, c, w_ada, b_ada, g_pre_mix, g_post_mix, g_pre_ffn, g_post_ffn,
              w_in, b_forget, g_v, w_spatial, b_spatial, g_out_attn, g_out_sgu, w_out,
              w_gate_up_dense, w_down_dense, w_router, w_gate_up_exp, w_down_exp):
    c_act = jax.nn.silu(c)
    for l in range(DEPTH):
        mod = jnp.einsum('bd,dm->bm', c_act, w_ada[l]) + b_ada[l]
        sh_m, sc_m, gt_m, sh_f, sc_f, gt_f = [m[:, None, :] for m in jnp.split(mod, N_MOD, axis=-1)]
        h = rmsnorm(x, g_pre_mix[l]) * (1.0 + sc_m) + sh_m
        y = token_mixer(h, w_in[l], b_forget[l], g_v[l], w_spatial[l], b_spatial[l],
                        g_out_attn[l], g_out_sgu[l], w_out[l])
        x = x + (1.0 + gt_m) * rmsnorm(y, g_post_mix[l])
        h = rmsnorm(x, g_pre_ffn[l]) * (1.0 + sc_f) + sh_f
        if l % 2 == 0:
            y = swiglu(h, w_gate_up_dense[l // 2], w_down_dense[l // 2], D_FF_DENSE)
        else:
            y = moe_swiglu(h, w_router[l // 2], w_gate_up_exp[l // 2], w_down_exp[l // 2])
        x = x + (1.0 + gt_f) * rmsnorm(y, g_post_ffn[l])
    return x
```

```cpp
#include <hip/hip_runtime.h>
#include <cstdio>
#include <cstdint>

#define GAS __attribute__((address_space(1)))
#define LAS __attribute__((address_space(3)))
typedef unsigned short bf16;
typedef float f32x4 __attribute__((ext_vector_type(4)));
typedef float f32x2 __attribute__((ext_vector_type(2)));
typedef unsigned u32x4 __attribute__((ext_vector_type(4)));
typedef unsigned u32x2 __attribute__((ext_vector_type(2)));
typedef unsigned long long u64;

constexpr int NB = 8, SEQ = 2048, DM = 1024, M = NB * SEQ, NL = 2;
constexpr int AW = 512, NH = 8, HD = 64, NIN = 2560, INC = 2568, DFF = 2816, EFF = 3584, NE = 8, NMOD = 6;
constexpr int CAPROWS = 2 * M + NE * 256;
constexpr float EPS = 1e-6f;
constexpr float LOG2E = 1.4426950408889634f;
constexpr float C2 = 0.125f * LOG2E;
constexpr int NWAVES = 8, NTHREADS = 512;

constexpr size_t MiB = 1u << 20;
constexpr size_t WS_CTL = 0, CTL_ZERO_BYTES = 64 * 1024;
constexpr size_t WS_MOD = 1 * MiB;
constexpr size_t WS_WF = 1 * MiB + 512 * 1024;
constexpr size_t WS_WR = WS_WF + 64 * 1024;
constexpr size_t WS_LOGF = 2 * MiB;
constexpr size_t WS_SSQA = 2 * MiB + 512 * 1024;
constexpr size_t WS_SSQS = 3 * MiB;
constexpr size_t WS_TOK = 512 * 1024;
constexpr size_t WS_WIN = 4 * MiB;
constexpr size_t WS_WOUT = 14 * MiB;
constexpr size_t WS_WGU = 18 * MiB;
constexpr size_t WS_WD = 29 * MiB;
constexpr size_t WS_EGU = 35 * MiB;
constexpr size_t WS_ED = 147 * MiB;
constexpr size_t WS_PART = WS_EGU;
constexpr size_t WS_H = 203 * MiB;
constexpr size_t WS_QKVUV = 235 * MiB;
constexpr size_t WS_MG = 315 * MiB;
constexpr size_t WS_Y = 347 * MiB;
constexpr size_t WS_YS = WS_QKVUV;
constexpr size_t WS_ACT = 411 * MiB;
constexpr size_t WS_HS = 649 * MiB;
constexpr size_t WS_MG2 = WS_HS;
constexpr size_t WS_END = 717 * MiB;
static_assert(WS_YS + (size_t)CAPROWS * DM * 4 <= WS_ACT && WS_ACT + (size_t)CAPROWS * EFF * 2 <= WS_HS && WS_HS + (size_t)CAPROWS * DM * 2 <= WS_END, "ws map");
constexpr int CW_TMO = 0, CW_CODE = 1, CW_BAR = 4096, CW_CNT = 8192;

constexpr int RING_BYTES = 131072, MISC_OFF = RING_BYTES + 320, LDS_BYTES = 147456;

__device__ __forceinline__ float bf2f(bf16 v) { return __uint_as_float((unsigned)v << 16); }
__device__ __forceinline__ unsigned f2bf(float f) { unsigned u = __float_as_uint(f); return (u + 0x7fffu + ((u >> 16) & 1u)) >> 16; }
typedef __bf16 bf16x2_t __attribute__((ext_vector_type(2)));
__device__ __forceinline__ unsigned pk2(float lo, float hi) { const f32x2 v = {lo, hi}; return __builtin_bit_cast(unsigned, __builtin_convertvector(v, bf16x2_t)); }
__device__ __forceinline__ float wave_sum(float v) {
#pragma unroll
    for (int o = 1; o < 64; o <<= 1) v += __shfl_xor(v, o);
    return v;
}
__device__ __forceinline__ float gelu_tanh(float x) {
    const float u = x * (-2.f * 0.7978845608028654f * LOG2E) * (1.f + 0.044715f * x * x);
    return x * __builtin_amdgcn_rcpf(1.f + __builtin_amdgcn_exp2f(u));
}
__device__ __forceinline__ float silu_f(float x) { return x * __builtin_amdgcn_rcpf(1.f + __builtin_amdgcn_exp2f(-LOG2E * x)); }
__device__ __forceinline__ float dot4(f32x4 a, f32x4 b) { return (a.x * b.x + a.y * b.y) + (a.z * b.z + a.w * b.w); }
__device__ __forceinline__ void store8_bf16(bf16* p, const float (&v)[8]) {
    u32x4 w; w.x = pk2(v[0], v[1]); w.y = pk2(v[2], v[3]); w.z = pk2(v[4], v[5]); w.w = pk2(v[6], v[7]); *(u32x4*)p = w;
}
__device__ __forceinline__ void store8_f32(float* p, const float (&v)[8]) {
    *(f32x4*)p = (f32x4){v[0], v[1], v[2], v[3]}; *(f32x4*)(p + 4) = (f32x4){v[4], v[5], v[6], v[7]};
}

__device__ __forceinline__ int fresh_lane() { int l; asm volatile("v_mbcnt_lo_u32_b32 %0, -1, 0\n\tv_mbcnt_hi_u32_b32 %0, -1, %0" : "=v"(l)); return l; }
struct Frame {
    LAS unsigned char* lds;
    unsigned* ctl;
    int tid, lane, wave, vcu, G;
    __device__ __forceinline__ void refresh() { lane = fresh_lane(); tid = wave * 64 + lane; }
    unsigned char* ws;
    const float* in[21];
    float* out;
};
enum { I_X = 0, I_C, I_WADA, I_BADA, I_GPREMIX, I_GPOSTMIX, I_GPREFFN, I_GPOSTFFN, I_WIN, I_BFORGET, I_GV, I_WSP, I_BSP, I_GOA, I_GOS, I_WOUT, I_WGUD, I_WDD, I_WROUTER, I_WGUE, I_WDE };

struct Unit { int pm, pn, kt0, nkt, part; };
struct StaticOrder {
    int nM, nN, nwg, G, c, nkt;
    __device__ void init(int M_, int N_, int G_, int c_, int K_) { nM = M_ / 256; nN = N_ / 256; nwg = nM * nN; G = G_; c = c_; nkt = K_ / 64; }
    __device__ bool next(int i, Unit& u) const {
        const long L = (long)i * G + c; if (L >= nwg) return false;
        int wgid = (int)L; { const int q = nwg / 8, r = nwg % 8, xcd = wgid % 8, off = wgid / 8; wgid = (xcd < r ? xcd * (q + 1) : r * (q + 1) + (xcd - r) * q) + off; }
        const int nig = 8 * nN, gid = wgid / nig, fm = gid * 8, gsz = (nM - fm) < 8 ? (nM - fm) : 8;
        u.pm = fm + ((wgid % nig) % gsz); u.pn = (wgid % nig) / gsz; u.kt0 = 0; u.nkt = nkt; u.part = -1; return true;
    }
    __device__ __forceinline__ void a_ready(const Unit&) const {}
    __device__ __forceinline__ void done(const Unit&) const {}
};
struct MoeLayout {
    int P1, P2, P3, P4, P5, P6, P7, P8;
    __device__ void init(const unsigned* cnt) {
        int c0 = (int)cnt[0], c1 = (int)cnt[64], c2 = (int)cnt[128], c3 = (int)cnt[192], c4 = (int)cnt[256], c5 = (int)cnt[320], c6 = (int)cnt[384], c7 = (int)cnt[448];
        P1 = (c0 + 255) >> 8; P2 = P1 + ((c1 + 255) >> 8); P3 = P2 + ((c2 + 255) >> 8); P4 = P3 + ((c3 + 255) >> 8);
        P5 = P4 + ((c4 + 255) >> 8); P6 = P5 + ((c5 + 255) >> 8); P7 = P6 + ((c6 + 255) >> 8); P8 = P7 + ((c7 + 255) >> 8);
        if (P8 > CAPROWS / 256) P8 = CAPROWS / 256;
    }
    __device__ __forceinline__ int expert_of_panel(int p) const { return (p >= P1) + (p >= P2) + (p >= P3) + (p >= P4) + (p >= P5) + (p >= P6) + (p >= P7); }
    __device__ __forceinline__ int panel_base(int e) const { int b = 0; b = e == 1 ? P1 : b; b = e == 2 ? P2 : b; b = e == 3 ? P3 : b; b = e == 4 ? P4 : b; b = e == 5 ? P5 : b; b = e == 6 ? P6 : b; b = e == 7 ? P7 : b; return b; }
};
struct MoeOrder {
    MoeLayout Lay; int NT, G, c, nkt, U, R, Lf, sp;
    __device__ void init(const unsigned* cnt, int NT_, int G_, int c_, int K_, bool split) {
        Lay.init(cnt); NT = NT_; G = G_; c = c_; nkt = K_ / 64; U = Lay.P8 * NT; R = U / G; Lf = U - R * G; sp = 1;
        if (split && (nkt % 28) == 0) { if (Lf * 2 <= G) sp = 2; if (Lf * 4 <= G) sp = 4; if (Lf * 7 <= G) sp = 7; if (Lf * 14 <= G) sp = 14; }
    }
    __device__ __forceinline__ void decode(int L, Unit& u) const {
        const int TP = Lay.P8, nig = 8 * NT, gid = L / nig, fm = gid * 8, gsz = (TP - fm) < 8 ? (TP - fm) : 8, r = L % nig;
        const int p = fm + r % gsz, j = r / gsz;
        u.pm = p; u.pn = Lay.expert_of_panel(p) * NT + j;
    }
    __device__ __forceinline__ int unit_index(int p, int j) const {
        const int TP = Lay.P8, gid = p >> 3, fm = gid * 8, gsz = (TP - fm) < 8 ? (TP - fm) : 8;
        return gid * 8 * NT + j * gsz + (p - fm);
    }
    __device__ bool next(int i, Unit& u) const {
        if (i < R) { decode(i * G + c, u); u.kt0 = 0; u.nkt = nkt; u.part = -1; return true; }
        if (i == R && c < Lf * sp) { const int q = c % Lf, sl = c / Lf; decode(R * G + q, u); u.nkt = nkt / sp; u.kt0 = sl * u.nkt; u.part = sp > 1 ? q * 14 + sl : -1; return true; }
        return false;
    }
    __device__ __forceinline__ void a_ready(const Unit&) const {}
    __device__ __forceinline__ void done(const Unit&) const {}
};

struct EpiInproj {
    bf16* base;
    __device__ __forceinline__ void pair8(const Unit& u, int row, int c, const float (&lo)[8], const float (&hi)[8]) const {
        const int t = u.pn >> 1; bf16* dst = base + (size_t)t * M * 512 + (size_t)row * 512 + (u.pn & 1) * 256 + c;
        float a[8], b[8];
#pragma unroll
        for (int i = 0; i < 8; ++i) { float x = lo[i], y = hi[i]; if (t == 0) { x *= C2; y *= C2; } else if (t >= 3) { x = gelu_tanh(x); y = gelu_tanh(y); } a[i] = x; b[i] = y; }
        store8_bf16(dst, a); store8_bf16(dst + 128, b);
    }
};
struct EpiF32 {
    float* O; int ldc, ntn; float* part;
    __device__ __forceinline__ void pair8(const Unit& u, int row, int c, const float (&lo)[8], const float (&hi)[8]) const {
        const bool sp = u.part >= 0; const int ld = sp ? 256 : ldc;
        float* base = sp ? part + (long)(u.part - u.pm) * 65536 : O + (u.pn % ntn) * 256;
        float* dst = base + (size_t)row * ld + c; store8_f32(dst, lo); store8_f32(dst + 128, hi);
    }
};
struct EpiSwiglu {
    bf16* O; int ldc, ntn;
    __device__ __forceinline__ void pair8(const Unit& u, int row, int c, const float (&lo)[8], const float (&hi)[8]) const {
        float a[8];
#pragma unroll
        for (int i = 0; i < 8; ++i) a[i] = silu_f(lo[i]) * hi[i];
        store8_bf16(O + (size_t)row * ldc + (u.pn % ntn) * 128 + c, a);
    }
};

#define PG8_LAS __attribute__((address_space(3)))
typedef short bf16x8 __attribute__((ext_vector_type(8)));
typedef unsigned short bf16_t;
constexpr int BM = 256, BK = 64, HALF = 128, HTB = HALF * BK * 2, STAGE_BYTES = 8 * HTB;
__host__ __device__ __forceinline__ int lds_byte(int r, int c) { const int st = (r >> 4) * 2 + (c >> 5), rr = r & 15, cc = c & 31, ob = rr * 64 + cc * 2; return st * 1024 + (ob ^ (((ob >> 9) & 1) << 5)); }
__host__ __device__ __forceinline__ void stage_rc(int b, int& R, int& C) { const int st = b / 1024, sb = b % 1024, swz = sb ^ (((sb >> 9) & 1) << 5); R = (st >> 1) * 16 + swz / 64; C = (st & 1) * 32 + (swz % 64) / 2; }
__host__ __device__ __forceinline__ int perm32(int rho) { const int n = rho >> 4, i = rho & 15; return 8 * (i >> 2) + 4 * n + (i & 3); }
struct Gemm { const bf16_t* A; const bf16_t* Bt; int M, N, K; };
template <class E> struct EpiWrap {
    static constexpr bool PERM = true, AFTER_DRAIN = false; E e;
    __device__ __forceinline__ void operator()(const f32x4 (&acc)[2][2][4][2], const Unit& u, int wr, int wc, int fr, int fq) const {
#pragma unroll
        for (int ai = 0; ai < 2; ++ai)
#pragma unroll
            for (int m = 0; m < 4; ++m) { const int row = u.pm * BM + ai * HALF + wr * 64 + m * 16 + fr;
                const f32x4 a0 = acc[ai][0][m][0], a1 = acc[ai][0][m][1], b0 = acc[ai][1][m][0], b1 = acc[ai][1][m][1];
                const float lo[8] = {a0[0], a0[1], a0[2], a0[3], a1[0], a1[1], a1[2], a1[3]}, hi[8] = {b0[0], b0[1], b0[2], b0[3], b1[0], b1[1], b1[2], b1[3]};
                e.pair8(u, row, wc * 32 + 8 * fq, lo, hi); }
    }
};
template <class Epi, class Sched, bool ALIGN_EPI = false, bool SP2 = false>
__device__ __forceinline__ void gemm_phase(PG8_LAS unsigned char* lds, const Gemm g, const Sched& S, const Epi& E, const int wid) {
    const int lane = fresh_lane(), tid = wid * 64 + lane, wr = wid >> 2, wc = wid & 3, fr = lane & 15, fq = lane >> 4;
    const int K = g.K;
    unsigned voffA[2], voffB[2];
#pragma unroll
    for (int i = 0; i < 2; ++i) { int R, C; stage_rc(tid * 16 + i * 8192, R, C); const int Rb = Epi::PERM ? ((R & ~31) + perm32(R & 31)) : R;
        voffA[i] = (unsigned)(R * K + C) * 2u; voffB[i] = (unsigned)(Rb * K + C) * 2u; }
    const size_t kstep = (size_t)(BK * 2);
    const size_t hstep = (size_t)HALF * K * 2;
    const size_t tstep = 2 * hstep;
    const unsigned ldsw = (unsigned)wid * 1024u;
    const int aoff = lds_byte(wr * 64 + fr, fq * 8), boff = lds_byte(wc * 32 + fr, fq * 8);
#define PG8_SA(b, h) (((b) * 2 + (h)) * HTB)
#define PG8_SB(b, h) ((4 + (b) * 2 + (h)) * HTB)
#define PG8_STAGE(bufoff, gbase, voff) do { _Pragma("unroll") for (int _i = 0; _i < 2; ++_i) \
        __builtin_amdgcn_global_load_lds((const unsigned*)((const char*)(gbase) + (voff)[_i]), (PG8_LAS unsigned*)(lds + (bufoff) + ldsw + _i * 8192), 16, 0, 0); } while (0)
#define PG8_LDA(dst, b, h) do { _Pragma("unroll") for (int m = 0; m < 4; ++m) _Pragma("unroll") for (int k = 0; k < 2; ++k) dst[m][k] = *(const PG8_LAS bf16x8*)(lds + PG8_SA(b, h) + aoff + m * 2048 + k * 1024); } while (0)
#define PG8_LDB(dst, b, h) do { _Pragma("unroll") for (int n = 0; n < 2; ++n) _Pragma("unroll") for (int k = 0; k < 2; ++k) dst[n][k] = *(const PG8_LAS bf16x8*)(lds + PG8_SB(b, h) + boff + n * 2048 + k * 1024); } while (0)
#define PG8_MMA(ai, bj, At, Bt) do { __builtin_amdgcn_s_setprio(1); _Pragma("unroll") for (int m = 0; m < 4; ++m) _Pragma("unroll") for (int n = 0; n < 2; ++n) _Pragma("unroll") for (int k = 0; k < 2; ++k) \
        acc[ai][bj][m][n] = __builtin_amdgcn_mfma_f32_16x16x32_bf16(Bt[n][k], At[m][k], acc[ai][bj][m][n], 0, 0, 0); __builtin_amdgcn_s_setprio(0); } while (0)
#define PG8_WAIT_V(n) asm volatile("s_waitcnt vmcnt(" #n ")" ::: "memory")
#define PG8_WAIT_L(n) asm volatile("s_waitcnt lgkmcnt(" #n ")" ::: "memory")
#define PG8_BAR __builtin_amdgcn_s_barrier()
#define PG8_SCHED __builtin_amdgcn_sched_barrier(0)
    Unit cur, nxt; int ui = 0;
    if (!S.next(0, cur)) return;
    f32x4 acc[2][2][4][2];
#pragma unroll
    for (int a = 0; a < 2; ++a)
#pragma unroll
        for (int b = 0; b < 2; ++b)
#pragma unroll
            for (int m = 0; m < 4; ++m)
#pragma unroll
                for (int n = 0; n < 2; ++n) acc[a][b][m][n] = (f32x4){0.f, 0.f, 0.f, 0.f};
    bf16x8 At[4][2], B0[2][2], B1[2][2];
    const char* cA = (const char*)g.A + (size_t)cur.pm * tstep + (size_t)cur.kt0 * kstep; const char* cB = (const char*)g.Bt + (size_t)cur.pn * tstep + (size_t)cur.kt0 * kstep;
    S.a_ready(cur);
    if constexpr (SP2) {
        PG8_STAGE(PG8_SB(0, 0), cB, voffB); PG8_STAGE(PG8_SB(0, 1), cB + hstep, voffB); PG8_STAGE(PG8_SA(0, 0), cA, voffA); PG8_STAGE(PG8_SA(0, 1), cA + hstep, voffA);
        if (wr == 1) PG8_BAR;
        PG8_WAIT_V(2); PG8_BAR;
        PG8_STAGE(PG8_SB(1, 0), cB + kstep, voffB); PG8_STAGE(PG8_SA(1, 0), cA + kstep, voffA); PG8_STAGE(PG8_SB(1, 1), cB + hstep + kstep, voffB);
        PG8_WAIT_V(6); PG8_BAR;
    } else {
        PG8_STAGE(PG8_SB(0, 0), cB, voffB); PG8_STAGE(PG8_SA(0, 0), cA, voffA); PG8_STAGE(PG8_SB(0, 1), cB + hstep, voffB); PG8_STAGE(PG8_SA(0, 1), cA + hstep, voffA);
        if (wr == 1) PG8_BAR;
        PG8_WAIT_V(4); PG8_BAR;
        PG8_STAGE(PG8_SB(1, 0), cB + kstep, voffB); PG8_STAGE(PG8_SA(1, 0), cA + kstep, voffA); PG8_STAGE(PG8_SB(1, 1), cB + hstep + kstep, voffB);
        PG8_WAIT_V(6); PG8_BAR;
    }
    for (;;) {
        const bool has_next = S.next(ui + 1, nxt);
        const char* nA = has_next ? (const char*)g.A + (size_t)nxt.pm * tstep + (size_t)nxt.kt0 * kstep : cA; const char* nB = has_next ? (const char*)g.Bt + (size_t)nxt.pn * tstep + (size_t)nxt.kt0 * kstep : cB;
        const int nt = cur.nkt;
        for (int t = 0; t < nt; t += 2) {
            const bool last = (t == nt - 2);
            const char* a1 = cA + (size_t)(t + 1) * kstep;
            const char* a2 = last ? nA : cA + (size_t)(t + 2) * kstep; const char* b2 = last ? nB : cB + (size_t)(t + 2) * kstep;
            const char* a3 = a2 + kstep; const char* b3 = b2 + kstep;
            if (last && has_next) S.a_ready(nxt);
            if constexpr (SP2) {
            PG8_LDB(B0, 0, 0); PG8_LDB(B1, 0, 1); PG8_SCHED; PG8_LDA(At, 0, 0); PG8_STAGE(PG8_SA(1, 1), a1 + hstep, voffA);
            PG8_WAIT_V(8); PG8_WAIT_L(0); PG8_BAR; PG8_MMA(0, 0, At, B0); PG8_MMA(0, 1, At, B1); PG8_BAR; PG8_SCHED;
            PG8_LDA(At, 0, 1); PG8_STAGE(PG8_SB(0, 0), b2, voffB); PG8_STAGE(PG8_SB(0, 1), b2 + hstep, voffB); PG8_STAGE(PG8_SA(0, 0), a2, voffA);
            PG8_WAIT_V(8); PG8_WAIT_L(0); PG8_BAR; PG8_MMA(1, 0, At, B0); PG8_MMA(1, 1, At, B1); PG8_BAR; PG8_SCHED;
            PG8_LDB(B0, 1, 0); PG8_LDB(B1, 1, 1); PG8_SCHED; PG8_LDA(At, 1, 0); PG8_STAGE(PG8_SA(0, 1), a2 + hstep, voffA);
            PG8_WAIT_V(8); PG8_WAIT_L(0); PG8_BAR; PG8_MMA(0, 0, At, B0); PG8_MMA(0, 1, At, B1); PG8_BAR; PG8_SCHED;
            PG8_LDA(At, 1, 1); PG8_STAGE(PG8_SB(1, 0), b3, voffB); PG8_STAGE(PG8_SB(1, 1), b3 + hstep, voffB); PG8_STAGE(PG8_SA(1, 0), a3, voffA);
            PG8_WAIT_V(8); PG8_WAIT_L(0); PG8_BAR; PG8_MMA(1, 0, At, B0); PG8_MMA(1, 1, At, B1); PG8_BAR; PG8_SCHED;
            } else {
            PG8_LDB(B0, 0, 0); PG8_SCHED; PG8_LDA(At, 0, 0); PG8_STAGE(PG8_SA(1, 1), a1 + hstep, voffA);
            PG8_WAIT_L(8); PG8_BAR; PG8_WAIT_L(0); PG8_MMA(0, 0, At, B0); PG8_BAR; PG8_SCHED;
            PG8_LDB(B1, 0, 1); PG8_STAGE(PG8_SB(0, 0), b2, voffB);
            PG8_BAR; PG8_WAIT_L(0); PG8_MMA(0, 1, At, B1); PG8_BAR;
            PG8_LDA(At, 0, 1); PG8_STAGE(PG8_SA(0, 0), a2, voffA);
            PG8_BAR; PG8_WAIT_L(0); PG8_MMA(1, 0, At, B0); PG8_BAR; PG8_SCHED;
            PG8_STAGE(PG8_SB(0, 1), b2 + hstep, voffB);
            PG8_WAIT_V(6); PG8_BAR; PG8_MMA(1, 1, At, B1); PG8_BAR;
            PG8_LDB(B0, 1, 0); PG8_SCHED; PG8_LDA(At, 1, 0); PG8_STAGE(PG8_SA(0, 1), a2 + hstep, voffA);
            PG8_WAIT_L(8); PG8_BAR; PG8_WAIT_L(0); PG8_MMA(0, 0, At, B0); PG8_BAR; PG8_SCHED;
            PG8_LDB(B1, 1, 1); PG8_STAGE(PG8_SB(1, 0), b3, voffB);
            PG8_BAR; PG8_WAIT_L(0); PG8_MMA(0, 1, At, B1); PG8_BAR;
            PG8_LDA(At, 1, 1); PG8_STAGE(PG8_SA(1, 0), a3, voffA);
            PG8_BAR; PG8_WAIT_L(0); PG8_MMA(1, 0, At, B0); PG8_BAR; PG8_SCHED;
            PG8_STAGE(PG8_SB(1, 1), b3 + hstep, voffB);
            PG8_WAIT_V(6); PG8_BAR; PG8_MMA(1, 1, At, B1); PG8_BAR;
            }
        }
        if constexpr (ALIGN_EPI) { if (wr == 0) PG8_BAR; }
        if constexpr (!Epi::AFTER_DRAIN) { E(acc, cur, wr, wc, fr, fq); S.done(cur); }
        if (!has_next) break;
#pragma unroll
        for (int a = 0; a < 2; ++a)
#pragma unroll
            for (int b = 0; b < 2; ++b)
#pragma unroll
                for (int m = 0; m < 4; ++m)
#pragma unroll
                    for (int n = 0; n < 2; ++n) acc[a][b][m][n] = (f32x4){0.f, 0.f, 0.f, 0.f};
        cur = nxt; cA = nA; cB = nB; ++ui;
        if constexpr (ALIGN_EPI) { if (wr == 1) PG8_BAR; }
    }
    PG8_WAIT_V(0);
    if constexpr (!ALIGN_EPI) { if (wr == 0) PG8_BAR; }
    PG8_BAR;
    if constexpr (Epi::AFTER_DRAIN) { E.fused(acc, cur, wr, wc, fr, fq, lds, wid, lane); S.done(cur); }
#undef PG8_SA
#undef PG8_SB
#undef PG8_STAGE
#undef PG8_LDA
#undef PG8_LDB
#undef PG8_MMA
#undef PG8_WAIT_V
#undef PG8_WAIT_L
#undef PG8_BAR
#undef PG8_SCHED
}

template <class Epi, class Sched>
__device__ __forceinline__ void gemm_simple(Frame& F, const bf16* A, const bf16* Bt, int K, const Sched& S, const Epi& E) {
    LAS float* As = (LAS float*)F.lds;
    LAS float* Bs = (LAS float*)(F.lds + 16 * 132 * 4);
    const int tid = F.tid, ty = tid >> 4, tx = tid & 15;
    Unit u;
    for (int i = 0; S.next(i, u); ++i) {
        for (int half = 0; half < 2; ++half) {
            const bf16* Ab = A + (size_t)(u.pm * 256 + half * 128) * K; const bf16* Bb = Bt + (size_t)u.pn * 256 * K;
            float acc[4][16];
#pragma unroll
            for (int r = 0; r < 4; ++r)
#pragma unroll
                for (int q = 0; q < 16; ++q) acc[r][q] = 0.f;
            for (int k0 = u.kt0 * 64; k0 < (u.kt0 + u.nkt) * 64; k0 += 16) {
                __syncthreads();
                { const int r = tid >> 1, kh = tid & 1;
                  if (tid < 256) { const u32x4 w = *(const u32x4*)(Ab + (size_t)r * K + k0 + kh * 8);
#pragma unroll
                      for (int q = 0; q < 4; ++q) { As[(kh * 8 + 2 * q) * 132 + r] = __uint_as_float(w[q] << 16); As[(kh * 8 + 2 * q + 1) * 132 + r] = __uint_as_float(w[q] & 0xffff0000u); } }
                  const u32x4 w = *(const u32x4*)(Bb + (size_t)r * K + k0 + kh * 8);
#pragma unroll
                  for (int q = 0; q < 4; ++q) { Bs[(kh * 8 + 2 * q) * 260 + r] = __uint_as_float(w[q] << 16); Bs[(kh * 8 + 2 * q + 1) * 260 + r] = __uint_as_float(w[q] & 0xffff0000u); } }
                __syncthreads();
#pragma unroll 4
                for (int k = 0; k < 16; ++k) {
                    const f32x4 a = *(const LAS f32x4*)(As + k * 132 + 4 * ty);
                    const f32x4 b0 = *(const LAS f32x4*)(Bs + k * 260 + 8 * tx), b1 = *(const LAS f32x4*)(Bs + k * 260 + 8 * tx + 4);
                    const f32x4 b2 = *(const LAS f32x4*)(Bs + k * 260 + 128 + 8 * tx), b3 = *(const LAS f32x4*)(Bs + k * 260 + 128 + 8 * tx + 4);
#pragma unroll
                    for (int r = 0; r < 4; ++r) {
#pragma unroll
                        for (int q = 0; q < 4; ++q) { acc[r][q] += a[r] * b0[q]; acc[r][4 + q] += a[r] * b1[q]; acc[r][8 + q] += a[r] * b2[q]; acc[r][12 + q] += a[r] * b3[q]; }
                    }
                }
            }
#pragma unroll
            for (int r = 0; r < 4; ++r) {
                float lo[8], hi[8];
#pragma unroll
                for (int q = 0; q < 8; ++q) { lo[q] = acc[r][q]; hi[q] = acc[r][8 + q]; }
                E.pair8(u, u.pm * 256 + half * 128 + 4 * ty + r, 8 * tx, lo, hi);
            }
        }
    }
    __syncthreads();
}

template <bool FAST, class Epi, class Sched>
__device__ __forceinline__ void gemm_run(Frame& F, const bf16* A, const bf16* Bt, int K, const Sched& S, const Epi& E) {
    if constexpr (FAST) { const Gemm g{A, Bt, 0, 0, K}; const EpiWrap<Epi> W{E}; gemm_phase<EpiWrap<Epi>, Sched, true, true>(F.lds, g, S, W, F.wave); }
    else { F.refresh(); gemm_simple(F, A, Bt, K, S, E); }
}
#ifndef FAST_ATTN
#define FAST_ATTN 1
#endif
#ifndef FAST_SGU
#define FAST_SGU 1
#endif
#ifndef FAST_INPROJ
#define FAST_INPROJ true
#endif
#ifndef FAST_OUTPROJ
#define FAST_OUTPROJ true
#endif
#ifndef FAST_FFN1D
#define FAST_FFN1D true
#endif
#ifndef FAST_FFN2D
#define FAST_FFN2D true
#endif
#ifndef FAST_FFN1E
#define FAST_FFN1E true
#endif
#ifndef FAST_FFN2E
#define FAST_FFN2E true
#endif
__device__ __forceinline__ void tr_item(const float* W, int ldw, int k0, int srcCol0, bf16* WT, int Kd, int dstRow0, const float* scaleK, LAS float* scr, int lane) {
    const int kr = lane >> 4, nc = (lane & 15) * 4, c4 = lane & 3;
#pragma unroll
    for (int ps = 0; ps < 2; ++ps) {
        f32x4 v[8];
#pragma unroll
        for (int i = 0; i < 8; ++i) v[i] = *(const f32x4*)(W + (size_t)(k0 + 32 * ps + 4 * i + kr) * ldw + srcCol0 + nc);
        if (scaleK) {
#pragma unroll
            for (int i = 0; i < 8; ++i) v[i] = v[i] * scaleK[k0 + 32 * ps + 4 * i + kr];
        }
#pragma unroll
        for (int i = 0; i < 8; ++i)
#pragma unroll
            for (int q = 0; q < 4; ++q) scr[(4 * i + kr) * 65 + nc + q] = v[i][q];
        asm volatile("s_waitcnt lgkmcnt(0)" ::: "memory");
#pragma unroll
        for (int j = 0; j < 4; ++j) { const int n = (lane >> 2) + 16 * j; const LAS float* sp = scr + (8 * c4) * 65 + n;
            u32x4 o; o.x = pk2(sp[0], sp[65]); o.y = pk2(sp[2 * 65], sp[3 * 65]); o.z = pk2(sp[4 * 65], sp[5 * 65]); o.w = pk2(sp[6 * 65], sp[7 * 65]);
            *(u32x4*)(WT + (size_t)(dstRow0 + n) * Kd + k0 + 32 * ps + 8 * c4) = o; }
        asm volatile("s_waitcnt lgkmcnt(0)" ::: "memory");
    }
}
__device__ __forceinline__ void p0_prologue(Frame& F) {
    F.refresh();
    {
        LAS float* cact = (LAS float*)F.lds;
        LAS float* red = (LAS float*)(F.lds + 32768);
        const float* c = F.in[I_C];
        for (int i = F.tid; i < NB * DM; i += NTHREADS) cact[i] = silu_f(c[i]);
        __syncthreads();
        float* mod = (float*)(F.ws + WS_MOD);
        for (int it = F.vcu; it < NL * (NMOD * DM / 64); it += F.G) {
            const int l = it / (NMOD * DM / 64), j0 = (it % (NMOD * DM / 64)) * 64;
            const float* W = F.in[I_WADA] + (size_t)l * DM * (NMOD * DM) + j0 + F.lane;
            float acc[8];
#pragma unroll
            for (int b = 0; b < 8; ++b) acc[b] = 0.f;
            const int d0 = F.wave * 128;
#pragma unroll 8
            for (int d = 0; d < 128; ++d) { const float w = W[(size_t)(d0 + d) * (NMOD * DM)];
#pragma unroll
                for (int b = 0; b < 8; ++b) acc[b] += cact[b * DM + d0 + d] * w; }
#pragma unroll
            for (int b = 0; b < 8; ++b) red[(F.wave * 8 + b) * 64 + F.lane] = acc[b];
            __syncthreads();
            { const int b = F.tid >> 6, ln = F.tid & 63; float s = 0.f;
#pragma unroll
              for (int w = 0; w < 8; ++w) s += red[(w * 8 + b) * 64 + ln];
              mod[((size_t)l * NB + b) * (NMOD * DM) + j0 + ln] = s + F.in[I_BADA][(size_t)l * (NMOD * DM) + j0 + ln]; }
            __syncthreads();
        }
    }
    {
        float* wf = (float*)(F.ws + WS_WF); float* wr = (float*)(F.ws + WS_WR);
        const int gt = F.vcu * NTHREADS + F.tid, GT = F.G * NTHREADS;
        for (int i = gt; i < NL * 8 * DM; i += GT) { const int l = i / (8 * DM), j = (i / DM) % 8, d = i % DM; wf[i] = F.in[I_WIN][((size_t)l * DM + d) * INC + 3 * AW + j]; }
        for (int i = gt; i < 8 * DM; i += GT) { const int j = i / DM, d = i % DM; wr[i] = F.in[I_WROUTER][(size_t)d * NE + j]; }
    }
    {
        LAS float* scr = (LAS float*)(F.lds + F.wave * 8320);
        const int gw = F.vcu * NWAVES + F.wave, NGW = F.G * NWAVES;
        constexpr int N_IN = NL * (NIN / 64) * (DM / 64);
        constexpr int N_OUT = NL * (DM / 64) * (DM / 64);
        constexpr int N_GU = (2 * DFF / 64) * (DM / 64);
        constexpr int N_D = (DM / 64) * (DFF / 64);
        constexpr int N_EGU = NE * (2 * EFF / 64) * (DM / 64);
        constexpr int N_ED = NE * (DM / 64) * (EFF / 64);
        constexpr int NITEMS = N_IN + N_OUT + N_GU + N_D + N_EGU + N_ED;
        for (int it = gw; it < NITEMS; it += NGW) {
            int r = it;
            if (r < N_IN) {
                const int l = r / (40 * 16), nb = (r / 16) % 40, kb = r % 16; const int dr = nb * 64, sc = dr < 1536 ? dr : dr + 8;
                tr_item(F.in[I_WIN] + (size_t)l * DM * INC, INC, kb * 64, sc, (bf16*)(F.ws + WS_WIN) + (size_t)l * NIN * DM, DM, dr, nullptr, scr, F.lane); continue; }
            r -= N_IN;
            if (r < N_OUT) {
                const int l = r / 256, nb = (r / 16) % 16, kb = r % 16; const float* g = kb < 8 ? F.in[I_GOA] + l * AW : F.in[I_GOS] + l * AW - AW;
                tr_item(F.in[I_WOUT] + (size_t)l * DM * DM, DM, kb * 64, nb * 64, (bf16*)(F.ws + WS_WOUT) + (size_t)l * DM * DM, DM, nb * 64, g, scr, F.lane); continue; }
            r -= N_OUT;
            if (r < N_GU) {
                const int nb = r / 16, kb = r % 16; const int dr = nb * 64, t = dr >> 8, w = dr & 255; const int sc = (w < 128) ? (128 * t + w) : (DFF + 128 * t + (w - 128));
                tr_item(F.in[I_WGUD], 2 * DFF, kb * 64, sc, (bf16*)(F.ws + WS_WGU), DM, dr, nullptr, scr, F.lane); continue; }
            r -= N_GU;
            if (r < N_D) {
                const int nb = r / 44, kb = r % 44;
                tr_item(F.in[I_WDD], DM, kb * 64, nb * 64, (bf16*)(F.ws + WS_WD), DFF, nb * 64, nullptr, scr, F.lane); continue; }
            r -= N_D;
            if (r < N_EGU) {
                const int e = r / (112 * 16), nb = (r / 16) % 112, kb = r % 16; const int dr = nb * 64, t = dr >> 8, w = dr & 255; const int sc = (w < 128) ? (128 * t + w) : (EFF + 128 * t + (w - 128));
                tr_item(F.in[I_WGUE] + (size_t)e * DM * 2 * EFF, 2 * EFF, kb * 64, sc, (bf16*)(F.ws + WS_EGU) + (size_t)e * 2 * EFF * DM, DM, dr, nullptr, scr, F.lane); continue; }
            r -= N_EGU;
            {
                const int e = r / (16 * 56), nb = (r / 56) % 16, kb = r % 56;
                tr_item(F.in[I_WDE] + (size_t)e * EFF * DM, DM, kb * 64, nb * 64, (bf16*)(F.ws + WS_ED) + (size_t)e * DM * EFF, EFF, nb * 64, nullptr, scr, F.lane); }
        }
    }
}

__device__ __forceinline__ f32x4 ld4(const float* p, int j, int lane) { return *((const f32x4*)p + 64 * j + lane); }
__device__ __forceinline__ float log_sigmoid_f(float a) { return fminf(a, 0.f) - log1pf(__expf(-fabsf(a))); }
__device__ __forceinline__ void ada_norm_row(f32x4 (&v)[4], const float* g, const float* sc, const float* sh, bf16* hrow, int lane) {
    float ss = 0.f;
#pragma unroll
    for (int j = 0; j < 4; ++j) ss += dot4(v[j], v[j]);
    const float rstd = 1.0f / sqrtf(wave_sum(ss) * (1.f / DM) + EPS);
#pragma unroll
    for (int j = 0; j < 4; ++j) { const f32x4 gg = ld4(g, j, lane), s1 = ld4(sc, j, lane), s0 = ld4(sh, j, lane); v[j] = v[j] * rstd * gg * (1.f + s1) + s0;
        *((u64*)hrow + 64 * j + lane) = (u64)pk2(v[j].x, v[j].y) | ((u64)pk2(v[j].z, v[j].w) << 32); }
}
__device__ __forceinline__ void forget_row(Frame& F, const f32x4 (&h)[4], const LAS float* wf  , const float* bf, int b, int s) {
    float z = 0.f;
#pragma unroll
    for (int jj = 0; jj < 8; ++jj) { float p = 0.f;
#pragma unroll
        for (int j = 0; j < 4; ++j) p += dot4(h[j], *((const LAS f32x4*)(wf + jj * DM) + 64 * j + F.lane));
        p = wave_sum(p); if (F.lane == jj) z = p; }
    if (F.lane < 8) ((float*)(F.ws + WS_LOGF))[((size_t)b * NH + F.lane) * SEQ + s] = log_sigmoid_f(z + bf[F.lane]);
}
__device__ __forceinline__ void stage_lds_f32(Frame& F, LAS float* dst, const float* src, int n) {
    for (int i = F.tid * 4; i < n; i += NTHREADS * 4) *(LAS f32x4*)(dst + i) = *(const f32x4*)(src + i);
    __syncthreads();
}
__device__ __forceinline__ void phase_premix(Frame& F, int l, const float* xsrc) {
    F.refresh();
    LAS float* wf = (LAS float*)F.lds; stage_lds_f32(F, wf, (const float*)(F.ws + WS_WF) + (size_t)l * 8 * DM, 8 * DM);
    const int gw = F.vcu * NWAVES + F.wave, NGW = F.G * NWAVES; const float* mod = (const float*)(F.ws + WS_MOD);
    for (int row = gw; row < M; row += NGW) {
        const int b = row / SEQ, s = row % SEQ; const float* mb = mod + ((size_t)l * NB + b) * (NMOD * DM);
        f32x4 v[4];
#pragma unroll
        for (int j = 0; j < 4; ++j) v[j] = ld4(xsrc + (size_t)row * DM, j, F.lane);
        ada_norm_row(v, F.in[I_GPREMIX] + l * DM, mb + 1 * DM, mb + 0 * DM, (bf16*)(F.ws + WS_H) + (size_t)row * DM, F.lane);
        forget_row(F, v, wf, F.in[I_BFORGET] + l * NH, b, s);
    }
    __syncthreads();
}
__device__ __forceinline__ void phase_merge_norm(Frame& F) {
    F.refresh();
    const int gw = F.vcu * NWAVES + F.wave, NGW = F.G * NWAVES;
    const float* sa = (const float*)(F.ws + WS_SSQA); const float* ss = (const float*)(F.ws + WS_SSQS);
    for (int row = gw; row < M; row += NGW) {
        const f32x4 a0 = *(const f32x4*)(sa + (size_t)row * 8), a1 = *(const f32x4*)(sa + (size_t)row * 8 + 4);
        const f32x4 s0 = *(const f32x4*)(ss + (size_t)row * 16) + *(const f32x4*)(ss + (size_t)row * 16 + 8), s1 = *(const f32x4*)(ss + (size_t)row * 16 + 4) + *(const f32x4*)(ss + (size_t)row * 16 + 12);
        const float ra = 1.0f / sqrtf(((a0.x + a0.y) + (a0.z + a0.w) + (a1.x + a1.y) + (a1.z + a1.w)) * (1.f / AW) + EPS);
        const float rs = 1.0f / sqrtf(((s0.x + s0.y) + (s0.z + s0.w) + (s1.x + s1.y) + (s1.z + s1.w)) * (1.f / AW) + EPS);
        const u32x4* p = (const u32x4*)((const bf16*)(F.ws + WS_MG) + (size_t)row * DM); u32x4* po = (u32x4*)((bf16*)(F.ws + WS_MG2) + (size_t)row * DM);
#pragma unroll
        for (int j = 0; j < 2; ++j) { u32x4 w = p[64 * j + F.lane]; const float r = j == 0 ? ra : rs;
#pragma unroll
            for (int q = 0; q < 4; ++q) w[q] = pk2(__uint_as_float(w[q] << 16) * r, __uint_as_float(w[q] & 0xffff0000u) * r);
            po[64 * j + F.lane] = w; }
    }
}
__device__ __forceinline__ void phase_postmix(Frame& F, int l, const float* xsrc, bool moe) {
    F.refresh();
    LAS float* wr = (LAS float*)F.lds; LAS unsigned* lcnt = (LAS unsigned*)(F.lds + 32768); LAS unsigned* lbase = lcnt + 8;
    if (moe) { if (F.tid < 16) lcnt[F.tid] = 0u; stage_lds_f32(F, wr, (const float*)(F.ws + WS_WR), 8 * DM); }
    const int gw = F.vcu * NWAVES + F.wave, NGW = F.G * NWAVES; const float* mod = (const float*)(F.ws + WS_MOD);
    const float* Y = (const float*)(F.ws + WS_Y); unsigned* tok = (unsigned*)(F.ws + WS_TOK);
    for (int row = gw; row < M; row += NGW) {
        const int b = row / SEQ; const float* mb = mod + ((size_t)l * NB + b) * (NMOD * DM);
        f32x4 y[4], v[4]; float ss = 0.f;
#pragma unroll
        for (int j = 0; j < 4; ++j) { y[j] = ld4(Y + (size_t)row * DM, j, F.lane); v[j] = ld4(xsrc + (size_t)row * DM, j, F.lane); ss += dot4(y[j], y[j]); }
        const float rstd = 1.0f / sqrtf(wave_sum(ss) * (1.f / DM) + EPS);
#pragma unroll
        for (int j = 0; j < 4; ++j) { const f32x4 g = ld4(F.in[I_GPOSTMIX] + l * DM, j, F.lane), gt = ld4(mb + 2 * DM, j, F.lane); v[j] = v[j] + (1.f + gt) * (y[j] * rstd * g);
            *((f32x4*)(F.out + (size_t)row * DM) + 64 * j + F.lane) = v[j]; }
        ada_norm_row(v, F.in[I_GPREFFN] + l * DM, mb + 4 * DM, mb + 3 * DM, (bf16*)(F.ws + WS_H) + (size_t)row * DM, F.lane);
        if (moe) {
            float lg[8];
#pragma unroll
            for (int jj = 0; jj < 8; ++jj) { float p = 0.f;
#pragma unroll
                for (int j = 0; j < 4; ++j) p += dot4(v[j], *((const LAS f32x4*)(wr + jj * DM) + 64 * j + F.lane));
                lg[jj] = wave_sum(p); }
            int e0 = 0; float v0 = lg[0];
#pragma unroll
            for (int jj = 1; jj < 8; ++jj) if (lg[jj] > v0) { v0 = lg[jj]; e0 = jj; }
            int e1 = -1; float v1 = -INFINITY;
#pragma unroll
            for (int jj = 0; jj < 8; ++jj) if (jj != e0 && lg[jj] > v1) { v1 = lg[jj]; e1 = jj; }
            if (e1 < 0) e1 = (e0 + 1) & 7;
            if (F.lane == 0) {
                const float w1 = 1.f / (1.f + __expf(v0 - v1)), w0 = 1.f - w1;
                const unsigned r0 = __hip_atomic_fetch_add(&lcnt[e0], 1u, __ATOMIC_RELAXED, __HIP_MEMORY_SCOPE_WORKGROUP), r1 = __hip_atomic_fetch_add(&lcnt[e1], 1u, __ATOMIC_RELAXED, __HIP_MEMORY_SCOPE_WORKGROUP);
                u32x4 a; a.x = (unsigned)e0; a.y = (unsigned)e1; a.z = r0; a.w = r1; *(u32x4*)(tok + (size_t)row * 8) = a;
                u32x2 w; w.x = __float_as_uint(w0); w.y = __float_as_uint(w1); *(u32x2*)(tok + (size_t)row * 8 + 4) = w;
            }
        }
    }
    if (moe) {
        __syncthreads();
        if (F.tid < 8) lbase[F.tid] = __hip_atomic_fetch_add(F.ctl + CW_CNT + 64 * F.tid, lcnt[F.tid], __ATOMIC_RELAXED, __HIP_MEMORY_SCOPE_AGENT);
        __syncthreads();
        if (F.lane == 0) for (int row = gw; row < M; row += NGW) { u32x4 a = *(u32x4*)(tok + (size_t)row * 8); a.z += lbase[a.x]; a.w += lbase[a.y]; *(u32x4*)(tok + (size_t)row * 8) = a; }
    }
    __syncthreads();
}
__device__ __forceinline__ void phase_scatter(Frame& F) {
    F.refresh();
    MoeLayout Lay; Lay.init(F.ctl + CW_CNT);
    const int gw = F.vcu * NWAVES + F.wave, NGW = F.G * NWAVES; const unsigned* tok = (const unsigned*)(F.ws + WS_TOK);
    const bf16* H = (const bf16*)(F.ws + WS_H); bf16* HS = (bf16*)(F.ws + WS_HS);
    for (int row = gw; row < M; row += NGW) {
        const u32x4 a = *(const u32x4*)(tok + (size_t)row * 8);
        const int s0 = Lay.panel_base((int)a.x) * 256 + (int)a.z, s1 = Lay.panel_base((int)a.y) * 256 + (int)a.w;
        const u32x4* src = (const u32x4*)(H + (size_t)row * DM); u32x4* d0 = (u32x4*)(HS + (size_t)s0 * DM); u32x4* d1 = (u32x4*)(HS + (size_t)s1 * DM);
#pragma unroll
        for (int j = 0; j < 2; ++j) { const u32x4 w = src[64 * j + F.lane]; if (s0 < CAPROWS) d0[64 * j + F.lane] = w; if (s1 < CAPROWS) d1[64 * j + F.lane] = w; }
    }
}
__device__ __forceinline__ void phase_final(Frame& F, int l, bool moe) {
    F.refresh();
    const bool nxt = (l + 1 < NL);
    LAS float* wf = (LAS float*)F.lds; if (nxt) stage_lds_f32(F, wf, (const float*)(F.ws + WS_WF) + (size_t)(l + 1) * 8 * DM, 8 * DM);
    MoeOrder MO; if (moe) MO.init(F.ctl + CW_CNT, DM / 256, F.G, 0, EFF, true);
    const MoeLayout& Lay = MO.Lay; const float* PART = (const float*)(F.ws + WS_PART);
    const int gw = F.vcu * NWAVES + F.wave, NGW = F.G * NWAVES; const float* mod = (const float*)(F.ws + WS_MOD);
    const float* Y = (const float*)(F.ws + WS_Y); const float* YS = (const float*)(F.ws + WS_YS); const unsigned* tok = (const unsigned*)(F.ws + WS_TOK);
    for (int row = gw; row < M; row += NGW) {
        const int b = row / SEQ, s = row % SEQ; const float* mb = mod + ((size_t)l * NB + b) * (NMOD * DM);
        f32x4 y[4], v[4]; float ss = 0.f;
        if (moe) {
            const u32x4 a = *(const u32x4*)(tok + (size_t)row * 8); const u32x2 ww = *(const u32x2*)(tok + (size_t)row * 8 + 4);
            int s0 = Lay.panel_base((int)a.x) * 256 + (int)a.z, s1 = Lay.panel_base((int)a.y) * 256 + (int)a.w; if (s0 >= CAPROWS) s0 = 0; if (s1 >= CAPROWS) s1 = 0;
            const float w0 = __uint_as_float(ww.x), w1 = __uint_as_float(ww.y);
#pragma unroll
            for (int j = 0; j < 4; ++j) {
                f32x4 ya, yb;
                { const int q = MO.unit_index(s0 >> 8, j) - MO.R * MO.G;
                  if (MO.sp > 1 && q >= 0) { ya = (f32x4){0.f, 0.f, 0.f, 0.f}; for (int sl = 0; sl < MO.sp; ++sl) ya += *((const f32x4*)(PART + ((size_t)(q * 14 + sl) * 256 + (s0 & 255)) * 256) + F.lane); }
                  else ya = ld4(YS + (size_t)s0 * DM, j, F.lane); }
                { const int q = MO.unit_index(s1 >> 8, j) - MO.R * MO.G;
                  if (MO.sp > 1 && q >= 0) { yb = (f32x4){0.f, 0.f, 0.f, 0.f}; for (int sl = 0; sl < MO.sp; ++sl) yb += *((const f32x4*)(PART + ((size_t)(q * 14 + sl) * 256 + (s1 & 255)) * 256) + F.lane); }
                  else yb = ld4(YS + (size_t)s1 * DM, j, F.lane); }
                y[j] = w0 * ya + w1 * yb;
            }
        } else {
#pragma unroll
            for (int j = 0; j < 4; ++j) y[j] = ld4(Y + (size_t)row * DM, j, F.lane);
        }
#pragma unroll
        for (int j = 0; j < 4; ++j) { v[j] = ld4(F.out + (size_t)row * DM, j, F.lane); ss += dot4(y[j], y[j]); }
        const float rstd = 1.0f / sqrtf(wave_sum(ss) * (1.f / DM) + EPS);
#pragma unroll
        for (int j = 0; j < 4; ++j) { const f32x4 g = ld4(F.in[I_GPOSTFFN] + l * DM, j, F.lane), gt = ld4(mb + 5 * DM, j, F.lane); v[j] = v[j] + (1.f + gt) * (y[j] * rstd * g);
            *((f32x4*)(F.out + (size_t)row * DM) + 64 * j + F.lane) = v[j]; }
        if (nxt) {
            const float* mn = mod + ((size_t)(l + 1) * NB + b) * (NMOD * DM);
            ada_norm_row(v, F.in[I_GPREMIX] + (l + 1) * DM, mn + 1 * DM, mn + 0 * DM, (bf16*)(F.ws + WS_H) + (size_t)row * DM, F.lane);
            forget_row(F, v, wf, F.in[I_BFORGET] + (l + 1) * NH, b, s);
        }
    }
    __syncthreads();
}

__device__ __forceinline__ void attn_simple(Frame& F) {
    F.refresh();
    const bf16* Q = (const bf16*)(F.ws + WS_QKVUV); const bf16* Kb = Q + (size_t)M * 512; const bf16* Vb = Kb + (size_t)M * 512;
    const float* logf = (const float*)(F.ws + WS_LOGF); bf16* MG = (bf16*)(F.ws + WS_MG); float* ssq = (float*)(F.ws + WS_SSQA);
    for (int g2 = F.vcu * NTHREADS + F.tid; g2 < NB * NH * SEQ * 2; g2 += F.G * NTHREADS) {
        const int gt = g2 >> 1, hf = g2 & 1;
        const int bh = gt / SEQ, t = gt % SEQ, b = bh / NH, h = bh % NH; const size_t rb = (size_t)b * SEQ;
        float q[32], o[32];
        { const u32x4* qp = (const u32x4*)(Q + (rb + t) * 512 + h * 64 + hf * 32);
#pragma unroll
          for (int i = 0; i < 4; ++i) { const u32x4 w = qp[i];
#pragma unroll
              for (int k = 0; k < 4; ++k) { q[8 * i + 2 * k] = __uint_as_float(w[k] << 16); q[8 * i + 2 * k + 1] = __uint_as_float(w[k] & 0xffff0000u); } } }
#pragma unroll
        for (int d = 0; d < 32; ++d) o[d] = 0.f;
        float m = -INFINITY, lsum = 0.f, Lrun = 0.f;
        const int tmax = __builtin_amdgcn_readfirstlane(t | 31);
        for (int s = 0; s <= tmax; ++s) {
            Lrun += logf[(size_t)bh * SEQ + s];
            const u32x4* kp = (const u32x4*)(Kb + (rb + s) * 512 + h * 64 + hf * 32); float dot = 0.f;
#pragma unroll
            for (int i = 0; i < 4; ++i) { const u32x4 w = kp[i];
#pragma unroll
                for (int k = 0; k < 4; ++k) dot += q[8 * i + 2 * k] * __uint_as_float(w[k] << 16) + q[8 * i + 2 * k + 1] * __uint_as_float(w[k] & 0xffff0000u); }
            dot += __shfl_xor(dot, 1);
            if (s <= t) {
                const float sc = dot - Lrun * LOG2E, mn = fmaxf(m, sc), al = exp2f(m - mn), p = exp2f(sc - mn);
                lsum = lsum * al + p; m = mn;
                const u32x4* vp = (const u32x4*)(Vb + (rb + s) * 512 + h * 64 + hf * 32);
#pragma unroll
                for (int i = 0; i < 4; ++i) { const u32x4 w = vp[i];
#pragma unroll
                    for (int k = 0; k < 4; ++k) { o[8 * i + 2 * k] = o[8 * i + 2 * k] * al + p * __uint_as_float(w[k] << 16); o[8 * i + 2 * k + 1] = o[8 * i + 2 * k + 1] * al + p * __uint_as_float(w[k] & 0xffff0000u); } }
            }
        }
        const float il = 1.f / lsum; float sq = 0.f;
        bf16* op = MG + (rb + t) * DM + h * 64 + hf * 32;
#pragma unroll
        for (int i = 0; i < 4; ++i) { float v[8];
#pragma unroll
            for (int k = 0; k < 8; ++k) { v[k] = o[8 * i + k] * il; sq += v[k] * v[k]; }
            store8_bf16(op + 8 * i, v); }
        sq += __shfl_xor(sq, 1);
        if (hf == 0) ssq[(rb + t) * 8 + h] = sq;
    }
}
__device__ __forceinline__ void sgu_simple(Frame& F, int l) {
    F.refresh();
    const bf16* U = (const bf16*)(F.ws + WS_QKVUV) + (size_t)3 * M * 512; const bf16* SV = U + (size_t)M * 512;
    bf16* MG = (bf16*)(F.ws + WS_MG); float* ssq = (float*)(F.ws + WS_SSQS);
    LAS float* st = (LAS float*)F.lds;
    LAS float* vn = (LAS float*)(F.lds + 1024);
    LAS float* wl = (LAS float*)(F.lds + 1024 + 128 * 65 * 4);
    const float* gv = F.in[I_GV] + l * AW;
    for (int un = F.vcu; un < NB * 16 * 8; un += F.G) {
        const int g = un & 7, ch = (un >> 3) & 15, b = un >> 7; const size_t rb = (size_t)b * SEQ + ch * 128;
        __syncthreads();
        for (int r = F.wave * 16; r < F.wave * 16 + 16; ++r) {
            const u32x4 w = *((const u32x4*)(SV + (rb + r) * 512) + F.lane); float x[8];
#pragma unroll
            for (int k = 0; k < 4; ++k) { x[2 * k] = __uint_as_float(w[k] << 16); x[2 * k + 1] = __uint_as_float(w[k] & 0xffff0000u); }
            float s = 0.f;
#pragma unroll
            for (int k = 0; k < 8; ++k) s += x[k];
            const float mean = wave_sum(s) * (1.f / 512.f); float q = 0.f;
#pragma unroll
            for (int k = 0; k < 8; ++k) { const float d = x[k] - mean; q += d * d; }
            const float rstd = 1.0f / sqrtf(wave_sum(q) * (1.f / 512.f) + EPS);
            if (F.lane == 0) { st[2 * r] = mean; st[2 * r + 1] = rstd; }
        }
        const float* W = F.in[I_WSP] + ((size_t)l * 8 + g) * 128 * 128;
        for (int i = F.tid; i < 128 * 128; i += NTHREADS) { const int t = i >> 7, s = i & 127; wl[t * 129 + s] = (s <= t) ? W[i] : 0.f; }
        __syncthreads();
        for (int i = F.tid; i < 128 * 64; i += NTHREADS) { const int s = i >> 6, d = i & 63; vn[s * 65 + d] = (bf2f(SV[(rb + s) * 512 + g * 64 + d]) - st[2 * s]) * st[2 * s + 1] * gv[g * 64 + d]; }
        __syncthreads();
        const int t = F.tid >> 2, dq = F.tid & 3;
        float acc[16];
#pragma unroll
        for (int i = 0; i < 16; ++i) acc[i] = 0.f;
        for (int s = 0; s <= t; ++s) { const float w = wl[t * 129 + s];
#pragma unroll
            for (int i = 0; i < 16; ++i) acc[i] += w * vn[s * 65 + dq * 16 + i]; }
        const float bs = F.in[I_BSP][((size_t)l * 8 + g) * 128 + t]; float sq = 0.f;
        const bf16* up = U + (rb + t) * 512 + g * 64 + dq * 16; bf16* op = MG + (rb + t) * DM + AW + g * 64 + dq * 16;
#pragma unroll
        for (int i = 0; i < 2; ++i) { float v[8];
#pragma unroll
            for (int k = 0; k < 8; ++k) { v[k] = bf2f(up[8 * i + k]) * (acc[8 * i + k] + bs); sq += v[k] * v[k]; }
            store8_bf16(op + 8 * i, v); }
        sq += __shfl_xor(sq, 1); sq += __shfl_xor(sq, 2);
        if (dq == 0) { ssq[(rb + t) * 16 + 2 * g] = sq; ssq[(rb + t) * 16 + 2 * g + 1] = 0.f; }
    }
    __syncthreads();
}

#include <hip/hip_bf16.h>
#include <cmath>
namespace attn_body {
typedef float f32x4_t __attribute__((ext_vector_type(4)));
using bf16=__hip_bfloat16;
using bf16x8=__attribute__((ext_vector_type(8)))short;
using s16x4=__attribute__((ext_vector_type(4)))short;
using f32x16=__attribute__((ext_vector_type(16)))float;
using u32x4=__attribute__((ext_vector_type(4)))unsigned;
constexpr int BATCH=8,NHEAD=8,SEQ=2048,D=64,DM=NHEAD*D,OP=1024;
constexpr int NW=8,QBLK=32,QB=QBLK*NW,KVBLK=64,NQB=SEQ/QB;
constexpr int ATTN_PITCH=DM, ATTN_UNIT_ROWS=QB;
__device__ __forceinline__ int crow(int r,int hi){return (r&3)+8*(r>>2)+4*hi;}
#define SBAR() __builtin_amdgcn_sched_barrier(0)
__device__ __forceinline__ void cmask(f32x16&p0,f32x16&p1,int jb,int qrel,int hi){
  const float NEG=-INFINITY; int kb=64*jb+4*hi;
  #pragma unroll
  for(int r=0;r<16;++r){int kv=kb+(r&3)+8*(r>>2); if(kv>qrel)p0[r]=NEG; if(kv+32>qrel)p1[r]=NEG;}
}

constexpr int NSLOT=3, SLOTB=8192;
constexpr int LDS_K=0, LDS_V=NSLOT*SLOTB, LDS_WS=2*NSLOT*SLOTB, LDS_OST=LDS_WS+NW*64*4, LDS_BIAS=LDS_OST+NW*4096, LDS_BYTES=LDS_BIAS+SEQ*4;
constexpr float C2=0.125f*1.4426950408889634f;
__device__ __forceinline__ void glds16(const void*gsrc,unsigned lds_dst){unsigned keep;
  asm volatile("s_mov_b32 %0, m0\n\ts_mov_b32 m0, %2\n\ts_nop 0\n\tglobal_load_lds_dwordx4 %1, off\n\ts_mov_b32 m0, %0":"=&s"(keep):"v"(gsrc),"s"(lds_dst):"memory");}
__device__ __forceinline__ float max3f(float a,float b,float c){float r;asm("v_max3_f32 %0, %1, %2, %3":"=v"(r):"v"(a),"v"(b),"v"(c));return r;}
__device__ __forceinline__ float max2f(float a,float b){float r;asm("v_max_f32_e32 %0, %1, %2":"=v"(r):"v"(a),"v"(b));return r;}
__device__ __forceinline__ float fadd_s(float a,float b){float r;asm("v_add_f32_e32 %0, %1, %2":"=v"(r):"v"(a),"v"(b));return r;}
__device__ __forceinline__ float fsub_s(float a,float b){float r;asm("v_sub_f32_e32 %0, %1, %2":"=v"(r):"v"(a),"v"(b));return r;}
typedef float f32x2_t __attribute__((ext_vector_type(2))); typedef __bf16 bf16x2_t __attribute__((ext_vector_type(2)));
__device__ __forceinline__ unsigned cvtpk_s(float lo,float hi){f32x2_t v={lo,hi};bf16x2_t b=__builtin_convertvector(v,bf16x2_t);return __builtin_bit_cast(unsigned,b);}
#define WAIT_BAR(N) asm volatile("s_waitcnt vmcnt(" #N ") lgkmcnt(0)\n\ts_barrier":::"memory")

__device__ __forceinline__ void qkt(f32x16&p0,f32x16&p1,const char*Kslot,const bf16x8*qr,int r32,int hi){
  const char*kb=Kslot+hi*1024+r32*16;
  #pragma unroll
  for(int d0=0;d0<4;++d0){
    const bf16x8 b0=*reinterpret_cast<const bf16x8*>(kb+d0*2048);
    const bf16x8 b1=*reinterpret_cast<const bf16x8*>(kb+d0*2048+512);
    {p0=__builtin_amdgcn_mfma_f32_32x32x16_bf16(b0,qr[d0],p0,0,0,0);p1=__builtin_amdgcn_mfma_f32_32x32x16_bf16(b1,qr[d0],p1,0,0,0);}}
}
typedef __attribute__((address_space(3))) const char* lds_cptr;
typedef short v4i16_t __attribute__((ext_vector_type(4)));
__device__ __forceinline__ void kload8(bf16x8*kf,lds_cptr kp){
  kf[0]=*(const __attribute__((address_space(3))) bf16x8*)(kp);      kf[1]=*(const __attribute__((address_space(3))) bf16x8*)(kp+512);
  kf[2]=*(const __attribute__((address_space(3))) bf16x8*)(kp+2048); kf[3]=*(const __attribute__((address_space(3))) bf16x8*)(kp+2560);
  kf[4]=*(const __attribute__((address_space(3))) bf16x8*)(kp+4096); kf[5]=*(const __attribute__((address_space(3))) bf16x8*)(kp+4608);
  kf[6]=*(const __attribute__((address_space(3))) bf16x8*)(kp+6144); kf[7]=*(const __attribute__((address_space(3))) bf16x8*)(kp+6656);
}
__device__ __forceinline__ void kload2(bf16x8*kf,lds_cptr kp,int j){ kf[2*j]=*(const __attribute__((address_space(3))) bf16x8*)(kp+j*2048); kf[2*j+1]=*(const __attribute__((address_space(3))) bf16x8*)(kp+j*2048+512); }
__device__ __forceinline__ s16x4 vtr(lds_cptr p){ return __builtin_bit_cast(s16x4,__builtin_amdgcn_ds_read_tr16_b64_v4i16((__attribute__((address_space(3))) v4i16_t*)p)); }
__device__ __forceinline__ float rowmax(const f32x16&p0,const f32x16&p1){
  float a=max3f(p0[0],p0[1],p1[0]),b=max3f(p0[2],p0[3],p1[1]);a=max3f(a,p1[2],p1[3]);
  #pragma unroll
  for(int r=4;r<16;r+=4){a=max3f(a,p0[r],p0[r+1]);b=max3f(b,p0[r+2],p0[r+3]);a=max3f(a,p1[r],p1[r+1]);b=max3f(b,p1[r+2],p1[r+3]);}
  const float m=max2f(a,b);
  auto rr=__builtin_amdgcn_permlane32_swap(__float_as_uint(m),__float_as_uint(m),false,false);
  return max2f(__uint_as_float(rr[0]),__uint_as_float(rr[1]));
}
__device__ __forceinline__ void pv(f32x16*o,int vb,bf16x8 pa0,bf16x8 pa1,bf16x8 pa2,bf16x8 pa3){
  #pragma unroll
  for(int d0=0;d0<2;++d0){s16x4 lo[4],hi[4];
    #pragma unroll
    for(int ks=0;ks<4;++ks){
      asm volatile("ds_read_b64_tr_b16 %0,%1 offset:%c2":"=&v"(lo[ks]):"v"(vb),"i"(d0*4096+ks*1024):"memory");
      asm volatile("ds_read_b64_tr_b16 %0,%1 offset:%c2":"=&v"(hi[ks]):"v"(vb),"i"(d0*4096+ks*1024+512):"memory");}
    asm volatile("s_waitcnt lgkmcnt(0)":::"memory");SBAR();
    #define PK(k) (bf16x8){lo[k][0],lo[k][1],lo[k][2],lo[k][3],hi[k][0],hi[k][1],hi[k][2],hi[k][3]}
    o[d0]=__builtin_amdgcn_mfma_f32_32x32x16_bf16(pa0,PK(0),o[d0],0,0,0);
    o[d0]=__builtin_amdgcn_mfma_f32_32x32x16_bf16(pa1,PK(1),o[d0],0,0,0);
    o[d0]=__builtin_amdgcn_mfma_f32_32x32x16_bf16(pa2,PK(2),o[d0],0,0,0);
    o[d0]=__builtin_amdgcn_mfma_f32_32x32x16_bf16(pa3,PK(3),o[d0],0,0,0);
    #undef PK
  }
}

#ifndef ATTN_STORE16
#define ATTN_STORE16(p,v) (*(u32x4*)(p)=(v))
#endif
template<int THRL> __device__ __forceinline__ void attn_unit(int b,int h,int qb,const bf16*Q,const bf16*__restrict__ K,const bf16*__restrict__ V,bf16*O,float*SSQ,char*shm,const int wid){
  const int lane=fresh_lane(),r32=lane&31,hi=lane>>5;
  const long rowbase=(long)b*SEQ; const int q0=qb*QB;
  const bf16*Qw=Q+(rowbase+q0+wid*QBLK)*DM+h*D;
  const bf16*Kh=K+rowbase*DM+h*D,*Vh=V+rowbase*DM+h*D;
  const unsigned lds0=(unsigned)(uintptr_t)shm;
  float*wsf=(float*)(shm+LDS_WS)+wid*64;
  const bf16*ksrc=Kh+(long)lane*DM+wid*8;
  const bf16*vsrc=Vh+(long)(16*(wid&3)+(lane>>2))*DM+(wid>>2)*32+(lane&3)*8;
  const unsigned kdst=lds0+LDS_K+wid*1024, vdst=lds0+LDS_V+wid*1024;
  #define DMA_K(t,slot) glds16(ksrc+(long)(t)*KVBLK*DM,(unsigned)__builtin_amdgcn_readfirstlane(kdst+(slot)))
  #define DMA_V(t,slot) glds16(vsrc+(long)(t)*KVBLK*DM,(unsigned)__builtin_amdgcn_readfirstlane(vdst+(slot)))
  const char*Kbase=shm+LDS_K; bf16x8 kf[8];
  const lds_cptr shm3=(lds_cptr)shm; const lds_cptr kp0=shm3+LDS_K+hi*1024+r32*16; const lds_cptr vp0=shm3+LDS_V+((lane>>4)&1)*32+(lane&3)*8+(4*hi+((lane&15)>>2))*64;
  const __attribute__((address_space(3))) float* biasp=(const __attribute__((address_space(3))) float*)(shm3+LDS_BIAS)+4*hi;
  #define CINIT(P0,P1,t) do{ const __attribute__((address_space(3))) float* bp_=biasp+64*(t); _Pragma("unroll") for(int j_=0;j_<4;++j_){ const f32x4_t b0_=*(const __attribute__((address_space(3))) f32x4_t*)(bp_+8*j_), b1_=*(const __attribute__((address_space(3))) f32x4_t*)(bp_+32+8*j_); _Pragma("unroll") for(int k_=0;k_<4;++k_){ P0[4*j_+k_]=b0_[k_]-mhat; P1[4*j_+k_]=b1_[k_]-mhat; } } }while(0)
  const int NT=(q0+QB)/KVBLK;
  DMA_K(0,0);DMA_V(0,0);DMA_K(1,SLOTB);
  bf16x8 qr[4];
  #pragma unroll
  for(int d0=0;d0<4;++d0)qr[d0]=*reinterpret_cast<const bf16x8*>(&Qw[(long)r32*DM+d0*16+hi*8]);
  float mhat=0.f,l_reg=0.f;f32x16 o[2];o[0]=f32x16{};o[1]=f32x16{};
  const int qrel=wid*QBLK+r32;
  #define CMASK(P0,P1,t) do{int jb_=(t)-(NT-4); if(jb_>=0)cmask(P0,P1,jb_,qrel,hi);}while(0)
  bool resc=false;
  #define START(P0,P1) do{ const float rm=rowmax(P0,P1); resc=false; \
    { const float dl=rm; mhat=fadd_s(mhat,dl); \
      _Pragma("unroll") for(int r=0;r<16;++r){P0[r]=fsub_s(P0[r],dl);P1[r]=fsub_s(P1[r],dl);} \
      } \
    _Pragma("unroll") for(int r=0;r<16;++r)P0[r]=__builtin_amdgcn_exp2f(P0[r]); }while(0)
  #define RESC() do{ if(resc){ asm volatile("s_waitcnt lgkmcnt(0)":::"memory"); \
      _Pragma("unroll") for(int d_=0;d_<2;++d_) _Pragma("unroll") for(int r=0;r<16;++r)o[d_][r]*=wsf[crow(r,hi)]; } }while(0)
  f32x16 pA0,pA1,pB0,pB1;
  int sl_prev=0,sl_cur=0,sl_next=SLOTB;
  #define ROT() do{sl_prev=sl_cur;sl_cur=sl_next;sl_next=(sl_next==(NSLOT-1)*SLOTB)?0:sl_next+SLOTB;}while(0)
  DMA_K(2,2*SLOTB);
  WAIT_BAR(3);
  CINIT(pA0,pA1,0);qkt(pA0,pA1,Kbase,qr,r32,hi);asm volatile("s_nop 15\n\ts_nop 7":"+v"(pA0),"+v"(pA1));CMASK(pA0,pA1,0);
  START(pA0,pA1);
  _Pragma("unroll") for(int r=0;r<16;++r)pA1[r]=__builtin_amdgcn_exp2f(pA1[r]);
  WAIT_BAR(0);
  DMA_K(3,0);DMA_V(1,SLOTB);
  ROT();
  kload8(kf,kp0+sl_cur);
  WAIT_BAR(2);
  s16x4 vlo[8],vhi[8]; u32x4 pw0,pw1,pw2,pw3;
  #define PKW(P,B) cvtpk_s(P[B],P[B+1])
  #define PAF(k) __builtin_bit_cast(bf16x8,pw##k)
  #define VFR(i) (bf16x8){vlo[i][0],vlo[i][1],vlo[i][2],vlo[i][3],vhi[i][0],vhi[i][1],vhi[i][2],vhi[i][3]}
  #define PIN(x) asm volatile("":"+v"(x))
  #define MX3(a,b,c) __builtin_fmaxf(__builtin_fmaxf((a),(b)),(c))
  #define GAPA(MF,A0,A1,A2,A3,W0,W1,PW) do{ MF; sacc+=A0; sacc+=A1; sacc+=A2; sacc+=A3; PIN(sacc); W0; W1; PIN(PW); SBAR(); }while(0)
  #define EX(v) __builtin_amdgcn_exp2f(v)
  #define GAPB(MF,X,B) do{ MF; X[B]=EX(X[B]); X[B+1]=EX(X[B+1]); X[B+2]=EX(X[B+2]); X[B+3]=EX(X[B+3]); PIN(X); SBAR(); }while(0)
  #define VRD(i) do{ vlo[i]=vtr(vp_+(((i)>>2)*4096+((i)&3)*1024)); vhi[i]=vtr(vp_+(((i)>>2)*4096+((i)&3)*1024+512)); }while(0)
  #define KRD(G,j) do{ if(G){ kload2(kf,kp0+sl_next,j); SBAR(); } }while(0)
  #define STEP(C0,C1,P0,P1,t,GK,GV,GL) do{ SBAR(); CINIT(C0,C1,t); SBAR(); \
    const lds_cptr vp_=vp0+sl_prev; \
    VRD(0); SBAR(); float sacc=(P0[0]+P0[1]); \
    GAPA(C0=__builtin_amdgcn_mfma_f32_32x32x16_bf16(kf[0],qr[0],C0,0,0,0), P0[2],P0[3],P0[4],P0[5],     pw0[0]=PKW(P0,0), pw0[1]=PKW(P0,2), pw0); \
    VRD(4); SBAR(); GAPA(C1=__builtin_amdgcn_mfma_f32_32x32x16_bf16(kf[1],qr[0],C1,0,0,0), P0[6],P0[7],P0[8],P0[9],     pw0[2]=PKW(P0,4), pw0[3]=PKW(P0,6), pw0); \
    VRD(1); SBAR(); GAPA(C0=__builtin_amdgcn_mfma_f32_32x32x16_bf16(kf[2],qr[1],C0,0,0,0),   P0[10],P0[11],P0[12],P0[13], pw1[0]=PKW(P0,8), pw1[1]=PKW(P0,10), pw1); \
    VRD(5); SBAR(); GAPA(C1=__builtin_amdgcn_mfma_f32_32x32x16_bf16(kf[3],qr[1],C1,0,0,0),   P0[14],P0[15],P1[0],P1[1],   pw1[2]=PKW(P0,12),pw1[3]=PKW(P0,14), pw1); \
    VRD(2); SBAR(); GAPA(C0=__builtin_amdgcn_mfma_f32_32x32x16_bf16(kf[4],qr[2],C0,0,0,0),   P1[2],P1[3],P1[4],P1[5],     pw2[0]=PKW(P1,0), pw2[1]=PKW(P1,2), pw2); \
    VRD(6); SBAR(); GAPA(C1=__builtin_amdgcn_mfma_f32_32x32x16_bf16(kf[5],qr[2],C1,0,0,0),   P1[6],P1[7],P1[8],P1[9],     pw2[2]=PKW(P1,4), pw2[3]=PKW(P1,6), pw2); \
    VRD(3); SBAR(); GAPA(C0=__builtin_amdgcn_mfma_f32_32x32x16_bf16(kf[6],qr[3],C0,0,0,0),   P1[10],P1[11],P1[12],P1[13], pw3[0]=PKW(P1,8), pw3[1]=PKW(P1,10), pw3); \
    VRD(7); SBAR(); GAPA(C1=__builtin_amdgcn_mfma_f32_32x32x16_bf16(kf[7],qr[3],C1,0,0,0),   P1[14],P1[15],0.f,0.f,       pw3[2]=PKW(P1,12),pw3[3]=PKW(P1,14), pw3); \
    l_reg+=sacc; \
    if(GK){DMA_K((t)+3,sl_cur);} if(GV){DMA_V((t)+1,sl_next);} \
    CMASK(C0,C1,t); \
    { float a=MX3(C0[0],C0[1],C1[0]),b=MX3(C0[2],C0[3],C1[1]); a=MX3(a,C1[2],C1[3]); \
      _Pragma("unroll") for(int r=4;r<16;r+=4){a=MX3(a,C0[r],C0[r+1]);b=MX3(b,C0[r+2],C0[r+3]);a=MX3(a,C1[r],C1[r+1]);b=MX3(b,C1[r+2],C1[r+3]);} \
      float rm=__builtin_fmaxf(a,b); { auto rr=__builtin_amdgcn_permlane32_swap(__float_as_uint(rm),__float_as_uint(rm),false,false); rm=__builtin_fmaxf(__uint_as_float(rr[0]),__uint_as_float(rr[1])); } \
      resc=false; \
      if(__builtin_expect(__any(rm>(float)THRL),0)){ const float dl=__builtin_fmaxf(rm,0.f); mhat+=dl; \
        _Pragma("unroll") for(int r=0;r<16;++r){C0[r]-=dl;C1[r]-=dl;} \
        const float f=__builtin_amdgcn_exp2f(-dl); l_reg*=f; if(hi==0)wsf[r32]=f; resc=true; } } \
    SBAR(); \
    GAPB(o[0]=__builtin_amdgcn_mfma_f32_32x32x16_bf16(PAF(0),VFR(0),o[0],0,0,0), C0,0); \
    GAPB(o[1]=__builtin_amdgcn_mfma_f32_32x32x16_bf16(PAF(0),VFR(4),o[1],0,0,0), C0,4); \
    KRD(GL,0); GAPB(o[0]=__builtin_amdgcn_mfma_f32_32x32x16_bf16(PAF(1),VFR(1),o[0],0,0,0), C0,8); \
    KRD(GL,1); GAPB(o[1]=__builtin_amdgcn_mfma_f32_32x32x16_bf16(PAF(1),VFR(5),o[1],0,0,0), C0,12); \
    KRD(GL,2); GAPB(o[0]=__builtin_amdgcn_mfma_f32_32x32x16_bf16(PAF(2),VFR(2),o[0],0,0,0), C1,0); \
    KRD(GL,3); GAPB(o[1]=__builtin_amdgcn_mfma_f32_32x32x16_bf16(PAF(2),VFR(6),o[1],0,0,0), C1,4); \
    GAPB(o[0]=__builtin_amdgcn_mfma_f32_32x32x16_bf16(PAF(3),VFR(3),o[0],0,0,0), C1,8); \
    GAPB(o[1]=__builtin_amdgcn_mfma_f32_32x32x16_bf16(PAF(3),VFR(7),o[1],0,0,0), C1,12); \
    }while(0)
  int t=1;
  #undef CMASK
  #define CMASK(P0,P1,t) do{}while(0)
  for(;t+5<NT;t+=2){
    STEP(pB0,pB1,pA0,pA1,t,true,true,true);     WAIT_BAR(2); RESC(); ROT();
    STEP(pA0,pA1,pB0,pB1,t+1,true,true,true);   WAIT_BAR(2); RESC(); ROT();
  }
  #undef CMASK
  #define CMASK(P0,P1,t) do{int jb_=(t)-(NT-4); if(jb_>=0)cmask(P0,P1,jb_,qrel,hi);}while(0)
  #define ENDW(tt) do{ if((tt)+3<NT){WAIT_BAR(2);} else if((tt)+2<NT){WAIT_BAR(1);} else {WAIT_BAR(0);} }while(0)
  for(;t+1<NT;t+=2){
    STEP(pB0,pB1,pA0,pA1,t,(t+3<NT),(t+1<NT),(t+1<NT));       ENDW(t);   RESC(); ROT();
    STEP(pA0,pA1,pB0,pB1,t+1,(t+4<NT),(t+2<NT),(t+2<NT));     ENDW(t+1); RESC(); ROT();
  }
  STEP(pB0,pB1,pA0,pA1,NT-1,false,false,false); RESC();
  { float sacc=pB0[0]+pB0[1]; _Pragma("unroll") for(int r=2;r<16;++r)sacc+=pB0[r]; _Pragma("unroll") for(int r=0;r<16;++r)sacc+=pB1[r]; l_reg+=sacc;
    pw0=(u32x4){PKW(pB0,0),PKW(pB0,2),PKW(pB0,4),PKW(pB0,6)};pw1=(u32x4){PKW(pB0,8),PKW(pB0,10),PKW(pB0,12),PKW(pB0,14)};pw2=(u32x4){PKW(pB1,0),PKW(pB1,2),PKW(pB1,4),PKW(pB1,6)};pw3=(u32x4){PKW(pB1,8),PKW(pB1,10),PKW(pB1,12),PKW(pB1,14)};
    SBAR(); pv(o,(int)(uintptr_t)vp0+sl_cur,PAF(0),PAF(1),PAF(2),PAF(3)); }
  #undef PKW
  #undef PAF
  #undef VFR
  #undef PIN
  #undef MX3
  #undef GAPA
  #undef GAPB
  #undef EX
  #undef VRD
  #undef KRD
  #undef STEP
  #undef ENDW
  {auto rr=__builtin_amdgcn_permlane32_swap(__float_as_uint(l_reg),__float_as_uint(l_reg),false,false);l_reg=__uint_as_float(rr[0])+__uint_as_float(rr[1]);}
  if(hi==0)wsf[32+r32]=l_reg;asm volatile("s_waitcnt lgkmcnt(0)":::"memory");
  float rli[16];
  #pragma unroll
  for(int r=0;r<16;++r)rli[r]=__builtin_amdgcn_rcpf(wsf[32+crow(r,hi)]);
  bf16*Ow=O+(rowbase+q0+wid*QBLK)*OP+h*D; float*Sw=SSQ+(rowbase+q0+wid*QBLK)*8+h;
  { bf16*stg=(bf16*)(shm+LDS_OST)+wid*2048;
    #pragma unroll
    for(int r=0;r<16;++r){const int orow=crow(r,hi);
      #pragma unroll
      for(int d0=0;d0<2;++d0)stg[orow*64+d0*32+r32]=__float2bfloat16(o[d0][r]*rli[r]);}
    asm volatile("s_waitcnt lgkmcnt(0)":::"memory");
    #pragma unroll
    for(int i=0;i<4;++i){const int row=i*8+(lane>>3),ch=lane&7; const u32x4 v=*(const u32x4*)(stg+row*64+ch*8); ATTN_STORE16(Ow+(long)row*OP+ch*8,v);
      float sq=0.f; _Pragma("unroll") for(int k_=0;k_<4;++k_){ const float a_=__uint_as_float(v[k_]<<16), b_=__uint_as_float(v[k_]&0xffff0000u); sq+=a_*a_+b_*b_; }
      sq+=__shfl_xor(sq,1); sq+=__shfl_xor(sq,2); sq+=__shfl_xor(sq,4); if(ch==0)Sw[(long)row*8]=sq; } }
  asm volatile("s_waitcnt lgkmcnt(0)\n\ts_barrier":::"memory");
  #undef DMA_K
  #undef DMA_V
  #undef CMASK
  #undef CINIT
  #undef START
  #undef RESC
  #undef ROT
}
constexpr int ATTN_LDS_BYTES=LDS_BYTES;
#undef SBAR
#undef WAIT_BAR
}

__device__ __forceinline__ void attn_fast(Frame& F) {
    F.refresh();
    const attn_body::bf16* Q = (const attn_body::bf16*)(F.ws + WS_QKVUV); const attn_body::bf16* Kb = Q + (size_t)M * 512; const attn_body::bf16* Vb = Kb + (size_t)M * 512;
    attn_body::bf16* O = (attn_body::bf16*)(F.ws + WS_MG); float* SSQ = (float*)(F.ws + WS_SSQA); const float* logf = (const float*)(F.ws + WS_LOGF);
    LAS float* bias = (LAS float*)(F.lds + attn_body::LDS_BIAS); LAS float* wsum = (LAS float*)(F.lds + attn_body::LDS_WS);
    for (int it = 0;; ++it) {
        const int pr = F.vcu + (it >> 1) * F.G; if (pr >= NB * NH * 4) break;
        const int bh = pr >> 2, sidx = pr & 3;
        if (!(it & 1)) {
            const f32x4 v = *(const f32x4*)(logf + (size_t)bh * SEQ + 4 * F.tid);
            const float a0 = v.x, a1 = a0 + v.y, a2 = a1 + v.z, a3 = a2 + v.w; float run = a3;
#pragma unroll
            for (int o = 1; o < 64; o <<= 1) { const float t = __shfl_up(run, o); if (F.lane >= o) run += t; }
            if (F.lane == 63) wsum[F.wave] = run;
            __syncthreads();
            float base = run - a3;
#pragma unroll
            for (int w = 0; w < 8; ++w) if (w < F.wave) base += wsum[w];
            *(LAS f32x4*)(bias + 4 * F.tid) = (f32x4){-(base + a0) * LOG2E, -(base + a1) * LOG2E, -(base + a2) * LOG2E, -(base + a3) * LOG2E};
            __syncthreads();
        }
        attn_body::attn_unit<8>(bh / NH, bh % NH, (it & 1) ? 7 - sidx : sidx, Q, Kb, Vb, O, SSQ, (char*)F.lds, F.wave);
    }
}
typedef float f32x16 __attribute__((ext_vector_type(16)));
__device__ __forceinline__ void sgu_fast(Frame& F, int l) {
    const bf16* U = (const bf16*)(F.ws + WS_QKVUV) + (size_t)3 * M * 512; const bf16* SV = U + (size_t)M * 512;
    bf16* MG = (bf16*)(F.ws + WS_MG); float* ssq = (float*)(F.ws + WS_SSQS);
    LAS float* st = (LAS float*)F.lds;
    LAS unsigned char* vnT = F.lds + 1024;
    const float* gv = F.in[I_GV] + l * AW;
    F.refresh();
    const int lane = F.lane, wave = F.wave, r32 = lane & 31, hi = lane >> 5, gl = wave >> 1, dh = wave & 1;
    for (int un = F.vcu; un < NB * 16 * 2; un += F.G) {
        const int gh = un & 1, ch = (un >> 1) & 15, b = un >> 5; const size_t rb = (size_t)b * SEQ + ch * 128;
        __syncthreads();
        for (int r = wave * 16; r < wave * 16 + 16; ++r) {
            const u32x4 w = *((const u32x4*)(SV + (rb + r) * 512) + lane); float x[8];
#pragma unroll
            for (int k = 0; k < 4; ++k) { x[2 * k] = __uint_as_float(w[k] << 16); x[2 * k + 1] = __uint_as_float(w[k] & 0xffff0000u); }
            float sm = 0.f;
#pragma unroll
            for (int k = 0; k < 8; ++k) sm += x[k];
            const float mean = wave_sum(sm) * (1.f / 512.f); float q = 0.f;
#pragma unroll
            for (int k = 0; k < 8; ++k) { const float d = x[k] - mean; q += d * d; }
            const float rstd = 1.0f / sqrtf(wave_sum(q) * (1.f / 512.f) + EPS);
            if (lane == 0) { st[2 * r] = mean; st[2 * r + 1] = rstd; }
        }
        __syncthreads();
#pragma unroll
        for (int k = 0; k < 4; ++k) {
            const int c = wave + 8 * k, s0 = 2 * lane; const int col = gh * 256 + 8 * c;
            const u32x4 w0 = *(const u32x4*)(SV + (rb + s0) * 512 + col), w1 = *(const u32x4*)(SV + (rb + s0 + 1) * 512 + col);
            const f32x4 g0 = *(const f32x4*)(gv + col), g1 = *(const f32x4*)(gv + col + 4);
            const float m0 = st[2 * s0], r0 = st[2 * s0 + 1], m1 = st[2 * s0 + 2], r1 = st[2 * s0 + 3];
#pragma unroll
            for (int j = 0; j < 8; ++j) { const float gj = j < 4 ? g0[j] : g1[j - 4];
                const float x0 = (j & 1) ? __uint_as_float(w0[j >> 1] & 0xffff0000u) : __uint_as_float(w0[j >> 1] << 16);
                const float x1 = (j & 1) ? __uint_as_float(w1[j >> 1] & 0xffff0000u) : __uint_as_float(w1[j >> 1] << 16);
                *(LAS unsigned*)(vnT + (size_t)(8 * c + j) * 272 + 2 * s0) = pk2((x0 - m0) * r0 * gj, (x1 - m1) * r1 * gj); }
        }
        __syncthreads();
        const int g = gh * 4 + gl;
        f32x16 acc[4];
#pragma unroll
        for (int tt = 0; tt < 4; ++tt) acc[tt] = (f32x16){};
        const float* Wg = F.in[I_WSP] + ((size_t)l * 8 + g) * 128 * 128;
#pragma unroll
        for (int kk = 0; kk < 8; ++kk) {
            const bf16x8 bfrag = *(const LAS bf16x8*)(vnT + (size_t)(gl * 64 + dh * 32 + r32) * 272 + (16 * kk + 8 * hi) * 2);
#pragma unroll
            for (int tt = 0; tt < 4; ++tt) if (kk < 2 * (tt + 1)) {
                const int t = 32 * tt + r32, s0 = 16 * kk + 8 * hi;
                const f32x4 w0 = *(const f32x4*)(Wg + t * 128 + s0), w1 = *(const f32x4*)(Wg + t * 128 + s0 + 4);
                float wv[8] = {w0[0], w0[1], w0[2], w0[3], w1[0], w1[1], w1[2], w1[3]};
#pragma unroll
                for (int j = 0; j < 8; ++j) if (s0 + j > t) wv[j] = 0.f;
                u32x4 pa; pa.x = pk2(wv[0], wv[1]); pa.y = pk2(wv[2], wv[3]); pa.z = pk2(wv[4], wv[5]); pa.w = pk2(wv[6], wv[7]);
                acc[tt] = __builtin_amdgcn_mfma_f32_32x32x16_bf16(__builtin_bit_cast(bf16x8, pa), bfrag, acc[tt], 0, 0, 0);
            }
        }
        __syncthreads();
        LAS float* stg = (LAS float*)(vnT + wave * 8192);
        const float* bsp = F.in[I_BSP] + ((size_t)l * 8 + g) * 128;
#pragma unroll
        for (int rnd = 0; rnd < 2; ++rnd) {
#pragma unroll
            for (int t2 = 0; t2 < 2; ++t2)
#pragma unroll
                for (int r = 0; r < 16; ++r) stg[(t2 * 32 + (r & 3) + 8 * (r >> 2) + 4 * hi) * 32 + r32] = acc[2 * rnd + t2][r];
            asm volatile("s_waitcnt lgkmcnt(0)" ::: "memory");
#pragma unroll
            for (int k = 0; k < 4; ++k) {
                const int row = (lane >> 2) + 16 * k, c4 = lane & 3, t = 64 * rnd + row;
                const f32x4 m0 = *(const LAS f32x4*)(stg + row * 32 + 8 * c4), m1 = *(const LAS f32x4*)(stg + row * 32 + 8 * c4 + 4);
                const int col = g * 64 + dh * 32 + 8 * c4; const float bs = bsp[t];
                const u32x4 uw = *(const u32x4*)(U + (rb + t) * 512 + col);
                float o[8]; float sq = 0.f;
#pragma unroll
                for (int j = 0; j < 8; ++j) { const float uu = (j & 1) ? __uint_as_float(uw[j >> 1] & 0xffff0000u) : __uint_as_float(uw[j >> 1] << 16);
                    o[j] = uu * ((j < 4 ? m0[j] : m1[j - 4]) + bs); sq += o[j] * o[j]; }
                store8_bf16(MG + (rb + t) * DM + AW + col, o);
                sq += __shfl_xor(sq, 1); sq += __shfl_xor(sq, 2);
                if (c4 == 0) ssq[(rb + t) * 16 + g * 2 + dh] = sq;
            }
            asm volatile("s_waitcnt lgkmcnt(0)" ::: "memory");
        }
    }
    __syncthreads();
}
#define XB_TMO      128
#define XB_XCNT(j)  (256  + 64 * (j))
#define XB_XSUB(j)  (1280 + 64 * (j))
#define XB_XGEN(j)  (2304 + 64 * (j))
#define XB_TOP      3328
#define XB_TOPGEN   3392
#define XCD_BAR_WORDS 3456
#define XB_SPIN_CAP (1u << 18)

__device__ __forceinline__ unsigned xb_ld(unsigned* p)              { return __hip_atomic_load(p, __ATOMIC_RELAXED, __HIP_MEMORY_SCOPE_AGENT); }
__device__ __forceinline__ unsigned xb_add(unsigned* p, unsigned v) { return __hip_atomic_fetch_add(p, v, __ATOMIC_RELAXED, __HIP_MEMORY_SCOPE_AGENT); }
__device__ __forceinline__ unsigned xb_xcc_id() { return (unsigned)__builtin_amdgcn_s_getreg((3 << 11) | 20) & 0xFu; }
#define XB_SPIN(cond, bar) do { unsigned _sp = 0; while (cond) { __builtin_amdgcn_s_sleep(1); \
    if ((++_sp & 255u) == 0u) { if (xb_ld(&(bar)[XB_TMO])) break; if (_sp > XB_SPIN_CAP) { atomicAdd(&(bar)[XB_TMO], 1u); break; } } } } while (0)

struct XcdBarrier {
    unsigned* bar; unsigned x;
    volatile LAS unsigned* st;
};

__device__ __forceinline__ XcdBarrier xcd_barrier_post(unsigned* bar, volatile LAS unsigned* st, const bool leader) {
    XcdBarrier b; b.bar = bar; b.x = xb_xcc_id(); b.st = st;
    if (leader) (void)xb_add(&bar[XB_XCNT(b.x)], 1u);
    return b;
}
__device__ __forceinline__ void xcd_barrier_complete(unsigned* bar, unsigned x, unsigned& nloc, unsigned& nx) {
    const unsigned G = gridDim.x * gridDim.y * gridDim.z;
    unsigned sum, cnt, mine, sp = 0u;
    for (;;) {
        sum = 0u; cnt = 0u; mine = 0u;
#pragma unroll
        for (unsigned j = 0; j < 16; ++j) { const unsigned c = xb_ld(&bar[XB_XCNT(j)]); sum += c; cnt += (c > 0u) ? 1u : 0u; mine = (j == x) ? c : mine; }
        if (sum == G) break;
        __builtin_amdgcn_s_sleep(1);
        if ((++sp & 255u) == 0u) { if (xb_ld(&bar[XB_TMO])) break; if (sp > XB_SPIN_CAP) { atomicAdd(&bar[XB_TMO], 1u); break; } }
    }
    nloc = mine > 0u ? mine : 1u; nx = cnt > 0u ? cnt : 1u;
}

__device__ __forceinline__ void xcd_barrier(const XcdBarrier& b, const bool leader) {
    asm volatile("s_waitcnt vmcnt(0)" ::: "memory");
    __syncthreads();
    if (leader) {
        unsigned* bar = b.bar;
        __builtin_amdgcn_s_waitcnt(0);
        unsigned nloc = b.st[0], nx = b.st[1];
        if (nloc == 0u) { xcd_barrier_complete(bar, b.x, nloc, nx); b.st[0] = nloc; b.st[1] = nx; }
        const unsigned old = xb_add(&bar[XB_XSUB(b.x)], 1u);
        const unsigned gen = old / nloc;
        if (old + 1u == (gen + 1u) * nloc) {
            __builtin_amdgcn_fence(__ATOMIC_RELEASE, "agent");
            asm volatile("s_waitcnt vmcnt(0)" ::: "memory");
            const unsigned og = xb_add(&bar[XB_TOP], 1u);
            const unsigned tg = og / nx;
            if (og + 1u == (tg + 1u) * nx) xb_add(&bar[XB_TOPGEN], 1u);
            else XB_SPIN(xb_ld(&bar[XB_TOPGEN]) == tg, bar);
            __builtin_amdgcn_fence(__ATOMIC_ACQUIRE, "agent");
            xb_add(&bar[XB_XGEN(b.x)], 1u);
            asm volatile("s_waitcnt vmcnt(0)" ::: "memory");
        } else {
            XB_SPIN(xb_ld(&bar[XB_XGEN(b.x)]) == gen, bar);
            __builtin_amdgcn_fence(__ATOMIC_ACQUIRE, "agent");
            asm volatile("s_waitcnt vmcnt(0)" ::: "memory");
        }
    }
    __syncthreads();
}

template <int L> __device__ __forceinline__ void layer_phases(Frame& F, const int lo, const int hi, const XcdBarrier& bar) {
#define IN(k) (lo <= (k) && (k) < hi)
#define SEAM(k) do { if (IN(k) && IN((k) + 1)) { xcd_barrier(bar, F.wave == 0 && fresh_lane() == 0); } } while (0)

        constexpr int l = L, pb = 2 + 9 * L; constexpr bool moe = (L & 1) != 0;
        if (IN(pb + 0)) {
            StaticOrder S; S.init(M, NIN, F.G, (int)blockIdx.x, DM); EpiInproj E{(bf16*)(F.ws + WS_QKVUV)};
            gemm_run<FAST_INPROJ>(F, (const bf16*)(F.ws + WS_H), (const bf16*)(F.ws + WS_WIN) + (size_t)l * NIN * DM, DM, S, E);
        }
        SEAM(pb + 0);
        if (IN(pb + 1)) {
#if FAST_ATTN
            attn_fast(F);
#else
            attn_simple(F);
#endif
#if FAST_SGU
            sgu_fast(F, l);
#else
            sgu_simple(F, l);
#endif
        }
        SEAM(pb + 1);
        if (IN(pb + 2)) phase_merge_norm(F);
        SEAM(pb + 2);
        if (IN(pb + 3)) {
            StaticOrder S; S.init(M, DM, F.G, (int)blockIdx.x, DM); EpiF32 E{(float*)(F.ws + WS_Y), DM, 4, nullptr};
            gemm_run<FAST_OUTPROJ>(F, (const bf16*)(F.ws + WS_MG2), (const bf16*)(F.ws + WS_WOUT) + (size_t)l * DM * DM, DM, S, E);
        }
        SEAM(pb + 3);
        if (IN(pb + 4)) phase_postmix(F, l, l == 0 ? F.in[I_X] : F.out, moe);
        if (moe) { SEAM(pb + 4); if (IN(pb + 5)) phase_scatter(F); SEAM(pb + 5); }
        else { if (IN(pb + 4) && IN(pb + 6)) xcd_barrier(bar, F.wave == 0 && fresh_lane() == 0); }
        if (IN(pb + 6)) {
            if (!moe) { StaticOrder S; S.init(M, 2 * DFF, F.G, (int)blockIdx.x, DM); EpiSwiglu E{(bf16*)(F.ws + WS_ACT), DFF, 2 * DFF / 256};
                gemm_run<FAST_FFN1D>(F, (const bf16*)(F.ws + WS_H), (const bf16*)(F.ws + WS_WGU), DM, S, E); }
            else { MoeOrder S; S.init(F.ctl + CW_CNT, 2 * EFF / 256, F.G, (int)blockIdx.x, DM, false); EpiSwiglu E{(bf16*)(F.ws + WS_ACT), EFF, 2 * EFF / 256};
                gemm_run<FAST_FFN1E>(F, (const bf16*)(F.ws + WS_HS), (const bf16*)(F.ws + WS_EGU), DM, S, E); }
        }
        SEAM(pb + 6);
        if (IN(pb + 7)) {
            if (!moe) { StaticOrder S; S.init(M, DM, F.G, (int)blockIdx.x, DFF); EpiF32 E{(float*)(F.ws + WS_Y), DM, 4, nullptr};
                gemm_run<FAST_FFN2D>(F, (const bf16*)(F.ws + WS_ACT), (const bf16*)(F.ws + WS_WD), DFF, S, E); }
            else { MoeOrder S; S.init(F.ctl + CW_CNT, DM / 256, F.G, (int)blockIdx.x, EFF, true); EpiF32 E{(float*)(F.ws + WS_YS), DM, 4, (float*)(F.ws + WS_PART)};
                gemm_run<FAST_FFN2E>(F, (const bf16*)(F.ws + WS_ACT), (const bf16*)(F.ws + WS_ED), EFF, S, E); }
        }
        SEAM(pb + 7);
        if (IN(pb + 8)) phase_final(F, l, moe);
        SEAM(pb + 8);
#undef SEAM
#undef IN
}
struct Args { const float* in[21]; float* out; unsigned char* ws; int ph_lo, ph_hi, li, pad; };
constexpr int NPHASES = 20;
__global__ void __launch_bounds__(NTHREADS, 2) fwd(Args args) {
    extern __shared__ __attribute__((aligned(16))) unsigned char lds[];
    Frame F;
    F.lds = (LAS unsigned char*)lds; F.wave = __builtin_amdgcn_readfirstlane((int)threadIdx.x >> 6); F.refresh();
    F.G = gridDim.x; { const int bx = blockIdx.x; F.vcu = (F.G % 8 == 0) ? (bx % 8) * (F.G / 8) + bx / 8 : bx; }
    F.ws = args.ws; F.ctl = (unsigned*)(args.ws + WS_CTL); F.out = args.out;
#pragma unroll
    for (int i = 0; i < 21; ++i) F.in[i] = args.in[i];
    const int lo = args.ph_lo, hi = args.ph_hi;
    volatile LAS unsigned* MISC = (volatile LAS unsigned*)(F.lds + MISC_OFF);
    if (F.tid < 32) MISC[F.tid] = 0u;
    __syncthreads();
    const XcdBarrier bar = xcd_barrier_post(F.ctl + CW_BAR + args.li * XCD_BAR_WORDS, MISC + 8, F.tid == 0);
#define IN(k) (lo <= (k) && (k) < hi)
    if (IN(0)) p0_prologue(F);
    if (IN(0) && IN(1)) xcd_barrier(bar, F.wave == 0 && fresh_lane() == 0);
    if (IN(1)) phase_premix(F, 0, F.in[I_X]);
    if (IN(1) && IN(2)) xcd_barrier(bar, F.wave == 0 && fresh_lane() == 0);
    layer_phases<0>(F, lo, hi, bar);
    layer_phases<1>(F, lo, hi, bar);
#undef IN
}

extern "C" void kernel_launch(void* const* d_in, const int* in_sizes, int n_in, void* d_out, int out_size, void* d_ws, size_t ws_size, hipStream_t stream) {
    static int grid = 0;
    if (grid == 0) {
        if (n_in != 21 || out_size != M * DM || ws_size < WS_END) { fprintf(stderr, "kernel_launch: unexpected problem (n_in %d out %d ws %zu)\n", n_in, out_size, ws_size); grid = -1; return; }
        int dev = 0, cus = 0;
        if (hipGetDevice(&dev) != hipSuccess || hipDeviceGetAttribute(&cus, hipDeviceAttributeMultiprocessorCount, dev) != hipSuccess) { grid = -1; return; }
        if (hipFuncSetAttribute((const void*)fwd, hipFuncAttributeMaxDynamicSharedMemorySize, LDS_BYTES) != hipSuccess) { grid = -1; return; }
        grid = cus;
    }
    if (grid < 0) return;
    (void)hipMemsetAsync((char*)d_ws + WS_CTL, 0, CTL_ZERO_BYTES, stream);
    Args a{};
    for (int i = 0; i < 21; ++i) a.in[i] = (const float*)d_in[i];
    a.out = (float*)d_out; a.ws = (unsigned char*)d_ws;
#ifndef N_LAUNCH
#define N_LAUNCH 1
#endif
#if N_LAUNCH == 1
    a.ph_lo = 0; a.ph_hi = NPHASES; a.li = 0;
    hipLaunchKernelGGL(fwd, dim3(grid), dim3(NTHREADS), LDS_BYTES, stream, a);
#else
    for (int p = 0; p < NPHASES; ++p) {
        if (p == 2 + 5) continue;
        a.ph_lo = p; a.ph_hi = p + 1; a.li = 0;
        hipLaunchKernelGGL(fwd, dim3(grid), dim3(NTHREADS), LDS_BYTES, stream, a);
    }
#endif
}
```

```cpp
#include <hip/hip_runtime.h>
#include <cstdio>
#include <cstdint>

#define GAS __attribute__((address_space(1)))
#define LAS __attribute__((address_space(3)))
typedef unsigned short bf16;
typedef float f32x4 __attribute__((ext_vector_type(4)));
typedef float f32x2 __attribute__((ext_vector_type(2)));
typedef unsigned u32x4 __attribute__((ext_vector_type(4)));
typedef unsigned u32x2 __attribute__((ext_vector_type(2)));
typedef unsigned long long u64;

constexpr int NB = 8, SEQ = 2048, DM = 1024, M = NB * SEQ, NL = 2;
constexpr int AW = 512, NH = 8, HD = 64, NIN = 2560, INC = 2568, DFF = 2816, EFF = 3584, NE = 8, NMOD = 6;
constexpr int CAPROWS = 2 * M + NE * 256;
constexpr float EPS = 1e-6f;
constexpr float LOG2E = 1.4426950408889634f;
constexpr float C2 = 0.125f * LOG2E;
constexpr int NWAVES = 8, NTHREADS = 512;

constexpr size_t MiB = 1u << 20;
constexpr size_t WS_CTL = 0, CTL_ZERO_BYTES = 64 * 1024;
constexpr size_t WS_MOD = 1 * MiB;
constexpr size_t WS_WF = 1 * MiB + 512 * 1024;
constexpr size_t WS_WR = WS_WF + 64 * 1024;
constexpr size_t WS_LOGF = 2 * MiB;
constexpr size_t WS_SSQA = 2 * MiB + 512 * 1024;
constexpr size_t WS_SSQS = 3 * MiB;
constexpr size_t WS_TOK = 512 * 1024;
constexpr size_t WS_WIN = 4 * MiB;
constexpr size_t WS_WOUT = 14 * MiB;
constexpr size_t WS_WGU = 18 * MiB;
constexpr size_t WS_WD = 29 * MiB;
constexpr size_t WS_EGU = 35 * MiB;
constexpr size_t WS_ED = 147 * MiB;
constexpr size_t WS_PART = WS_EGU;
constexpr size_t WS_H = 203 * MiB;
constexpr size_t WS_QKVUV = 235 * MiB;
constexpr size_t WS_MG = 315 * MiB;
constexpr size_t WS_Y = 347 * MiB;
constexpr size_t WS_YS = WS_QKVUV;
constexpr size_t WS_ACT = 411 * MiB;
constexpr size_t WS_HS = 649 * MiB;
constexpr size_t WS_MG2 = WS_HS;
constexpr size_t WS_END = 717 * MiB;
static_assert(WS_YS + (size_t)CAPROWS * DM * 4 <= WS_ACT && WS_ACT + (size_t)CAPROWS * EFF * 2 <= WS_HS && WS_HS + (size_t)CAPROWS * DM * 2 <= WS_END, "ws map");
constexpr int CW_TMO = 0, CW_CODE = 1, CW_BAR = 4096, CW_CNT = 8192;

constexpr int RING_BYTES = 131072, MISC_OFF = RING_BYTES + 320, LDS_BYTES = 147456;

__device__ __forceinline__ float bf2f(bf16 v) { return __uint_as_float((unsigned)v << 16); }
__device__ __forceinline__ unsigned f2bf(float f) { unsigned u = __float_as_uint(f); return (u + 0x7fffu + ((u >> 16) & 1u)) >> 16; }
typedef __bf16 bf16x2_t __attribute__((ext_vector_type(2)));
__device__ __forceinline__ unsigned pk2(float lo, float hi) { const f32x2 v = {lo, hi}; return __builtin_bit_cast(unsigned, __builtin_convertvector(v, bf16x2_t)); }
__device__ __forceinline__ float wave_sum(float v) {
#pragma unroll
    for (int o = 1; o < 64; o <<= 1) v += __shfl_xor(v, o);
    return v;
}
__device__ __forceinline__ float gelu_tanh(float x) {
    const float u = x * (-2.f * 0.7978845608028654f * LOG2E) * (1.f + 0.044715f * x * x);
    return x * __builtin_amdgcn_rcpf(1.f + __builtin_amdgcn_exp2f(u));
}
__device__ __forceinline__ float silu_f(float x) { return x * __builtin_amdgcn_rcpf(1.f + __builtin_amdgcn_exp2f(-LOG2E * x)); }
__device__ __forceinline__ float dot4(f32x4 a, f32x4 b) { return (a.x * b.x + a.y * b.y) + (a.z * b.z + a.w * b.w); }
__device__ __forceinline__ void store8_bf16(bf16* p, const float (&v)[8]) {
    u32x4 w; w.x = pk2(v[0], v[1]); w.y = pk2(v[2], v[3]); w.z = pk2(v[4], v[5]); w.w = pk2(v[6], v[7]); *(u32x4*)p = w;
}
__device__ __forceinline__ void store8_f32(float* p, const float (&v)[8]) {
    *(f32x4*)p = (f32x4){v[0], v[1], v[2], v[3]}; *(f32x4*)(p + 4) = (f32x4){v[4], v[5], v[6], v[7]};
}

__device__ __forceinline__ int fresh_lane() { int l; asm volatile("v_mbcnt_lo_u32_b32 %0, -1, 0\n\tv_mbcnt_hi_u32_b32 %0, -1, %0" : "=v"(l)); return l; }
struct Frame {
    LAS unsigned char* lds;
    unsigned* ctl;
    int tid, lane, wave, vcu, G;
    __device__ __forceinline__ void refresh() { lane = fresh_lane(); tid = wave * 64 + lane; }
    unsigned char* ws;
    const float* in[21];
    float* out;
};
enum { I_X = 0, I_C, I_WADA, I_BADA, I_GPREMIX, I_GPOSTMIX, I_GPREFFN, I_GPOSTFFN, I_WIN, I_BFORGET, I_GV, I_WSP, I_BSP, I_GOA, I_GOS, I_WOUT, I_WGUD, I_WDD, I_WROUTER, I_WGUE, I_WDE };

struct Unit { int pm, pn, kt0, nkt, part; };
struct StaticOrder {
    int nM, nN, nwg, G, c, nkt;
    __device__ void init(int M_, int N_, int G_, int c_, int K_) { nM = M_ / 256; nN = N_ / 256; nwg = nM * nN; G = G_; c = c_; nkt = K_ / 64; }
    __device__ bool next(int i, Unit& u) const {
        const long L = (long)i * G + c; if (L >= nwg) return false;
        int wgid = (int)L; { const int q = nwg / 8, r = nwg % 8, xcd = wgid % 8, off = wgid / 8; wgid = (xcd < r ? xcd * (q + 1) : r * (q + 1) + (xcd - r) * q) + off; }
        const int nig = 8 * nN, gid = wgid / nig, fm = gid * 8, gsz = (nM - fm) < 8 ? (nM - fm) : 8;
        u.pm = fm + ((wgid % nig) % gsz); u.pn = (wgid % nig) / gsz; u.kt0 = 0; u.nkt = nkt; u.part = -1; return true;
    }
    __device__ __forceinline__ void a_ready(const Unit&) const {}
    __device__ __forceinline__ void done(const Unit&) const {}
};
struct MoeLayout {
    int P1, P2, P3, P4, P5, P6, P7, P8;
    __device__ void init(const unsigned* cnt) {
        int c0 = (int)cnt[0], c1 = (int)cnt[64], c2 = (int)cnt[128], c3 = (int)cnt[192], c4 = (int)cnt[256], c5 = (int)cnt[320], c6 = (int)cnt[384], c7 = (int)cnt[448];
        P1 = (c0 + 255) >> 8; P2 = P1 + ((c1 + 255) >> 8); P3 = P2 + ((c2 + 255) >> 8); P4 = P3 + ((c3 + 255) >> 8);
        P5 = P4 + ((c4 + 255) >> 8); P6 = P5 + ((c5 + 255) >> 8); P7 = P6 + ((c6 + 255) >> 8); P8 = P7 + ((c7 + 255) >> 8);
        if (P8 > CAPROWS / 256) P8 = CAPROWS / 256;
    }
    __device__ __forceinline__ int expert_of_panel(int p) const { return (p >= P1) + (p >= P2) + (p >= P3) + (p >= P4) + (p >= P5) + (p >= P6) + (p >= P7); }
    __device__ __forceinline__ int panel_base(int e) const { int b = 0; b = e == 1 ? P1 : b; b = e == 2 ? P2 : b; b = e == 3 ? P3 : b; b = e == 4 ? P4 : b; b = e == 5 ? P5 : b; b = e == 6 ? P6 : b; b = e == 7 ? P7 : b; return b; }
};
struct MoeOrder {
    MoeLayout Lay; int NT, G, c, nkt, U, R, Lf, sp, q0, r0;
    __device__ void init(const unsigned* cnt, int NT_, int G_, int c_, int K_, bool split) {
        Lay.init(cnt); NT = NT_; G = G_; c = c_; nkt = K_ / 64; U = Lay.P8 * NT; R = U / G; Lf = U - R * G; sp = 1; q0 = U / 8; r0 = U % 8;
        if (split && (nkt % 28) == 0) { if (Lf * 2 <= G) sp = 2; if (Lf * 4 <= G) sp = 4; if (Lf * 7 <= G) sp = 7; if (Lf * 14 <= G) sp = 14; }
    }
    __device__ __forceinline__ int remap(int L) const { const int x = L & 7, off = L >> 3; return (x < r0 ? x * (q0 + 1) : r0 * (q0 + 1) + (x - r0) * q0) + off; }
    __device__ __forceinline__ int unmap(int W) const { const int t = W - r0 * (q0 + 1); return t < 0 ? (W % (q0 + 1)) * 8 + W / (q0 + 1) : (t % q0) * 8 + r0 + t / q0; }
    __device__ __forceinline__ void decode(int Lin, Unit& u) const {
        const int L = remap(Lin); const int TP = Lay.P8, nig = 8 * NT, gid = L / nig, fm = gid * 8, gsz = (TP - fm) < 8 ? (TP - fm) : 8, r = L % nig;
        const int p = fm + r % gsz, j = r / gsz;
        u.pm = p; u.pn = Lay.expert_of_panel(p) * NT + j;
    }
    __device__ __forceinline__ int unit_index(int p, int j) const {
        const int TP = Lay.P8, gid = p >> 3, fm = gid * 8, gsz = (TP - fm) < 8 ? (TP - fm) : 8;
        return unmap(gid * 8 * NT + j * gsz + (p - fm));
    }
    __device__ bool next(int i, Unit& u) const {
        if (i < R) { decode(i * G + c, u); u.kt0 = 0; u.nkt = nkt; u.part = -1; return true; }
        if (i == R && c < Lf * sp) { const int q = c % Lf, sl = c / Lf; decode(R * G + q, u); u.nkt = nkt / sp; u.kt0 = sl * u.nkt; u.part = sp > 1 ? q * 14 + sl : -1; return true; }
        return false;
    }
    __device__ __forceinline__ void a_ready(const Unit&) const {}
    __device__ __forceinline__ void done(const Unit&) const {}
};

struct EpiInproj {
    bf16* base;
    __device__ __forceinline__ void pair8(const Unit& u, int row, int c, const float (&lo)[8], const float (&hi)[8]) const {
        const int t = u.pn >> 1; bf16* dst = base + (size_t)t * M * 512 + (size_t)row * 512 + (u.pn & 1) * 256 + c;
        float a[8], b[8];
#pragma unroll
        for (int i = 0; i < 8; ++i) { float x = lo[i], y = hi[i]; if (t == 0) { x *= C2; y *= C2; } else if (t >= 3) { x = gelu_tanh(x); y = gelu_tanh(y); } a[i] = x; b[i] = y; }
        store8_bf16(dst, a); store8_bf16(dst + 128, b);
    }
};
struct EpiF32 {
    float* O; int ldc, ntn; float* part;
    __device__ __forceinline__ void pair8(const Unit& u, int row, int c, const float (&lo)[8], const float (&hi)[8]) const {
        const bool sp = u.part >= 0; const int ld = sp ? 256 : ldc;
        float* base = sp ? part + (long)(u.part - u.pm) * 65536 : O + (u.pn % ntn) * 256;
        float* dst = base + (size_t)row * ld + c; store8_f32(dst, lo); store8_f32(dst + 128, hi);
    }
};
struct EpiSwiglu {
    bf16* O; int ldc, ntn;
    __device__ __forceinline__ void pair8(const Unit& u, int row, int c, const float (&lo)[8], const float (&hi)[8]) const {
        float a[8];
#pragma unroll
        for (int i = 0; i < 8; ++i) a[i] = silu_f(lo[i]) * hi[i];
        store8_bf16(O + (size_t)row * ldc + (u.pn % ntn) * 128 + c, a);
    }
};

#define PG8_LAS __attribute__((address_space(3)))
typedef short bf16x8 __attribute__((ext_vector_type(8)));
typedef unsigned short bf16_t;
constexpr int BM = 256, BK = 64, HALF = 128, HTB = HALF * BK * 2, STAGE_BYTES = 8 * HTB;
__host__ __device__ __forceinline__ int lds_byte(int r, int c) { const int st = (r >> 4) * 2 + (c >> 5), rr = r & 15, cc = c & 31, ob = rr * 64 + cc * 2; return st * 1024 + (ob ^ (((ob >> 9) & 1) << 5)); }
__host__ __device__ __forceinline__ void stage_rc(int b, int& R, int& C) { const int st = b / 1024, sb = b % 1024, swz = sb ^ (((sb >> 9) & 1) << 5); R = (st >> 1) * 16 + swz / 64; C = (st & 1) * 32 + (swz % 64) / 2; }
__host__ __device__ __forceinline__ int perm32(int rho) { const int n = rho >> 4, i = rho & 15; return 8 * (i >> 2) + 4 * n + (i & 3); }
struct Gemm { const bf16_t* A; const bf16_t* Bt; int M, N, K; };
template <class E> struct EpiWrap {
    static constexpr bool PERM = true, AFTER_DRAIN = false; E e;
    __device__ __forceinline__ void operator()(const f32x4 (&acc)[2][2][4][2], const Unit& u, int wr, int wc, int fr, int fq) const {
#pragma unroll
        for (int ai = 0; ai < 2; ++ai)
#pragma unroll
            for (int m = 0; m < 4; ++m) { const int row = u.pm * BM + ai * HALF + wr * 64 + m * 16 + fr;
                const f32x4 a0 = acc[ai][0][m][0], a1 = acc[ai][0][m][1], b0 = acc[ai][1][m][0], b1 = acc[ai][1][m][1];
                const float lo[8] = {a0[0], a0[1], a0[2], a0[3], a1[0], a1[1], a1[2], a1[3]}, hi[8] = {b0[0], b0[1], b0[2], b0[3], b1[0], b1[1], b1[2], b1[3]};
                e.pair8(u, row, wc * 32 + 8 * fq, lo, hi); }
    }
};
template <class Epi, class Sched, bool ALIGN_EPI = false, bool SP2 = false, bool VARK = false>
__device__ __forceinline__ void gemm_phase(PG8_LAS unsigned char* lds, const Gemm g, const Sched& S, const Epi& E, const int wid) {
    const int lane = fresh_lane(), tid = wid * 64 + lane, wr = wid >> 2, wc = wid & 3, fr = lane & 15, fq = lane >> 4;
    const int K = g.K;
    unsigned voffA[2], voffB[2];
#pragma unroll
    for (int i = 0; i < 2; ++i) { int R, C; stage_rc(tid * 16 + i * 8192, R, C); const int Rb = Epi::PERM ? ((R & ~31) + perm32(R & 31)) : R;
        voffA[i] = (unsigned)(R * K + C) * 2u; voffB[i] = (unsigned)(Rb * K + C) * 2u; }
    const size_t kstep = (size_t)(BK * 2);
    const size_t hstep = (size_t)HALF * K * 2;
    const size_t tstep = 2 * hstep;
    const unsigned ldsw = (unsigned)wid * 1024u;
    const int aoff = lds_byte(wr * 64 + fr, fq * 8), boff = lds_byte(wc * 32 + fr, fq * 8);
#define PG8_SA(b, h) (((b) * 2 + (h)) * HTB)
#define PG8_SB(b, h) ((4 + (b) * 2 + (h)) * HTB)
#define PG8_STAGE(bufoff, gbase, voff) do { _Pragma("unroll") for (int _i = 0; _i < 2; ++_i) \
        __builtin_amdgcn_global_load_lds((const unsigned*)((const char*)(gbase) + (voff)[_i]), (PG8_LAS unsigned*)(lds + (bufoff) + ldsw + _i * 8192), 16, 0, 0); } while (0)
#define PG8_LDA(dst, b, h) do { _Pragma("unroll") for (int m = 0; m < 4; ++m) _Pragma("unroll") for (int k = 0; k < 2; ++k) dst[m][k] = *(const PG8_LAS bf16x8*)(lds + PG8_SA(b, h) + aoff + m * 2048 + k * 1024); } while (0)
#define PG8_LDB(dst, b, h) do { _Pragma("unroll") for (int n = 0; n < 2; ++n) _Pragma("unroll") for (int k = 0; k < 2; ++k) dst[n][k] = *(const PG8_LAS bf16x8*)(lds + PG8_SB(b, h) + boff + n * 2048 + k * 1024); } while (0)
#define PG8_MMA(ai, bj, At, Bt) do { __builtin_amdgcn_s_setprio(1); _Pragma("unroll") for (int m = 0; m < 4; ++m) _Pragma("unroll") for (int n = 0; n < 2; ++n) _Pragma("unroll") for (int k = 0; k < 2; ++k) \
        acc[ai][bj][m][n] = __builtin_amdgcn_mfma_f32_16x16x32_bf16(Bt[n][k], At[m][k], acc[ai][bj][m][n], 0, 0, 0); __builtin_amdgcn_s_setprio(0); } while (0)
#define PG8_WAIT_V(n) asm volatile("s_waitcnt vmcnt(" #n ")" ::: "memory")
#define PG8_WAIT_L(n) asm volatile("s_waitcnt lgkmcnt(" #n ")" ::: "memory")
#define PG8_BAR __builtin_amdgcn_s_barrier()
#define PG8_SCHED __builtin_amdgcn_sched_barrier(0)
    Unit cur, nxt; int ui = 0;
    if (!S.next(0, cur)) return;
    f32x4 acc[2][2][4][2];
#pragma unroll
    for (int a = 0; a < 2; ++a)
#pragma unroll
        for (int b = 0; b < 2; ++b)
#pragma unroll
            for (int m = 0; m < 4; ++m)
#pragma unroll
                for (int n = 0; n < 2; ++n) acc[a][b][m][n] = (f32x4){0.f, 0.f, 0.f, 0.f};
    bf16x8 At[4][2], B0[2][2], B1[2][2];
    const char* cA = (const char*)g.A + (size_t)cur.pm * tstep + (VARK ? (size_t)cur.kt0 * kstep : 0); const char* cB = (const char*)g.Bt + (size_t)cur.pn * tstep + (VARK ? (size_t)cur.kt0 * kstep : 0);
    S.a_ready(cur);
    if constexpr (SP2) {
        PG8_STAGE(PG8_SB(0, 0), cB, voffB); PG8_STAGE(PG8_SB(0, 1), cB + hstep, voffB); PG8_STAGE(PG8_SA(0, 0), cA, voffA); PG8_STAGE(PG8_SA(0, 1), cA + hstep, voffA);
        if (wr == 1) PG8_BAR;
        PG8_WAIT_V(2); PG8_BAR;
        PG8_STAGE(PG8_SB(1, 0), cB + kstep, voffB); PG8_STAGE(PG8_SA(1, 0), cA + kstep, voffA); PG8_STAGE(PG8_SB(1, 1), cB + hstep + kstep, voffB);
        PG8_WAIT_V(6); PG8_BAR;
    } else {
        PG8_STAGE(PG8_SB(0, 0), cB, voffB); PG8_STAGE(PG8_SA(0, 0), cA, voffA); PG8_STAGE(PG8_SB(0, 1), cB + hstep, voffB); PG8_STAGE(PG8_SA(0, 1), cA + hstep, voffA);
        if (wr == 1) PG8_BAR;
        PG8_WAIT_V(4); PG8_BAR;
        PG8_STAGE(PG8_SB(1, 0), cB + kstep, voffB); PG8_STAGE(PG8_SA(1, 0), cA + kstep, voffA); PG8_STAGE(PG8_SB(1, 1), cB + hstep + kstep, voffB);
        PG8_WAIT_V(6); PG8_BAR;
    }
    for (;;) {
        const bool has_next = S.next(ui + 1, nxt);
        const char* nA = has_next ? (const char*)g.A + (size_t)nxt.pm * tstep + (VARK ? (size_t)nxt.kt0 * kstep : 0) : cA; const char* nB = has_next ? (const char*)g.Bt + (size_t)nxt.pn * tstep + (VARK ? (size_t)nxt.kt0 * kstep : 0) : cB;
        const int nt = VARK ? cur.nkt : K / BK;
        for (int t = 0; t < nt; t += 2) {
            const bool last = (t == nt - 2);
            const char* a1 = cA + (size_t)(t + 1) * kstep;
            const char* a2 = last ? nA : cA + (size_t)(t + 2) * kstep; const char* b2 = last ? nB : cB + (size_t)(t + 2) * kstep;
            const char* a3 = a2 + kstep; const char* b3 = b2 + kstep;
            if (last && has_next) S.a_ready(nxt);
            if constexpr (SP2) {
            PG8_LDB(B0, 0, 0); PG8_LDB(B1, 0, 1); PG8_SCHED; PG8_LDA(At, 0, 0); PG8_STAGE(PG8_SA(1, 1), a1 + hstep, voffA);
            PG8_WAIT_V(8); PG8_WAIT_L(0); PG8_BAR; PG8_MMA(0, 0, At, B0); PG8_MMA(0, 1, At, B1); PG8_BAR; PG8_SCHED;
            PG8_LDA(At, 0, 1); PG8_STAGE(PG8_SB(0, 0), b2, voffB); PG8_STAGE(PG8_SB(0, 1), b2 + hstep, voffB); PG8_STAGE(PG8_SA(0, 0), a2, voffA);
            PG8_WAIT_V(8); PG8_WAIT_L(0); PG8_BAR; PG8_MMA(1, 0, At, B0); PG8_MMA(1, 1, At, B1); PG8_BAR; PG8_SCHED;
            PG8_LDB(B0, 1, 0); PG8_LDB(B1, 1, 1); PG8_SCHED; PG8_LDA(At, 1, 0); PG8_STAGE(PG8_SA(0, 1), a2 + hstep, voffA);
            PG8_WAIT_V(8); PG8_WAIT_L(0); PG8_BAR; PG8_MMA(0, 0, At, B0); PG8_MMA(0, 1, At, B1); PG8_BAR; PG8_SCHED;
            PG8_LDA(At, 1, 1); PG8_STAGE(PG8_SB(1, 0), b3, voffB); PG8_STAGE(PG8_SB(1, 1), b3 + hstep, voffB); PG8_STAGE(PG8_SA(1, 0), a3, voffA);
            PG8_WAIT_V(8); PG8_WAIT_L(0); PG8_BAR; PG8_MMA(1, 0, At, B0); PG8_MMA(1, 1, At, B1); PG8_BAR; PG8_SCHED;
            } else {
            PG8_LDB(B0, 0, 0); PG8_SCHED; PG8_LDA(At, 0, 0); PG8_STAGE(PG8_SA(1, 1), a1 + hstep, voffA);
            PG8_WAIT_L(8); PG8_BAR; PG8_WAIT_L(0); PG8_MMA(0, 0, At, B0); PG8_BAR; PG8_SCHED;
            PG8_LDB(B1, 0, 1); PG8_STAGE(PG8_SB(0, 0), b2, voffB);
            PG8_BAR; PG8_WAIT_L(0); PG8_MMA(0, 1, At, B1); PG8_BAR;
            PG8_LDA(At, 0, 1); PG8_STAGE(PG8_SA(0, 0), a2, voffA);
            PG8_BAR; PG8_WAIT_L(0); PG8_MMA(1, 0, At, B0); PG8_BAR; PG8_SCHED;
            PG8_STAGE(PG8_SB(0, 1), b2 + hstep, voffB);
            PG8_WAIT_V(6); PG8_BAR; PG8_MMA(1, 1, At, B1); PG8_BAR;
            PG8_LDB(B0, 1, 0); PG8_SCHED; PG8_LDA(At, 1, 0); PG8_STAGE(PG8_SA(0, 1), a2 + hstep, voffA);
            PG8_WAIT_L(8); PG8_BAR; PG8_WAIT_L(0); PG8_MMA(0, 0, At, B0); PG8_BAR; PG8_SCHED;
            PG8_LDB(B1, 1, 1); PG8_STAGE(PG8_SB(1, 0), b3, voffB);
            PG8_BAR; PG8_WAIT_L(0); PG8_MMA(0, 1, At, B1); PG8_BAR;
            PG8_LDA(At, 1, 1); PG8_STAGE(PG8_SA(1, 0), a3, voffA);
            PG8_BAR; PG8_WAIT_L(0); PG8_MMA(1, 0, At, B0); PG8_BAR; PG8_SCHED;
            PG8_STAGE(PG8_SB(1, 1), b3 + hstep, voffB);
            PG8_WAIT_V(6); PG8_BAR; PG8_MMA(1, 1, At, B1); PG8_BAR;
            }
        }
        if constexpr (ALIGN_EPI) { if (wr == 0) PG8_BAR; }
        if constexpr (!Epi::AFTER_DRAIN) { E(acc, cur, wr, wc, fr, fq); S.done(cur); }
        if (!has_next) break;
#pragma unroll
        for (int a = 0; a < 2; ++a)
#pragma unroll
            for (int b = 0; b < 2; ++b)
#pragma unroll
                for (int m = 0; m < 4; ++m)
#pragma unroll
                    for (int n = 0; n < 2; ++n) acc[a][b][m][n] = (f32x4){0.f, 0.f, 0.f, 0.f};
        cur = nxt; cA = nA; cB = nB; ++ui;
        if constexpr (ALIGN_EPI) { if (wr == 1) PG8_BAR; }
    }
    PG8_WAIT_V(0);
    if constexpr (!ALIGN_EPI) { if (wr == 0) PG8_BAR; }
    PG8_BAR;
    if constexpr (Epi::AFTER_DRAIN) { E.fused(acc, cur, wr, wc, fr, fq, lds, wid, lane); S.done(cur); }
#undef PG8_SA
#undef PG8_SB
#undef PG8_STAGE
#undef PG8_LDA
#undef PG8_LDB
#undef PG8_MMA
#undef PG8_WAIT_V
#undef PG8_WAIT_L
#undef PG8_BAR
#undef PG8_SCHED
}

template <class Epi, class Sched>
__device__ __forceinline__ void gemm_simple(Frame& F, const bf16* A, const bf16* Bt, int K, const Sched& S, const Epi& E) {
    LAS float* As = (LAS float*)F.lds;
    LAS float* Bs = (LAS float*)(F.lds + 16 * 132 * 4);
    const int tid = F.tid, ty = tid >> 4, tx = tid & 15;
    Unit u;
    for (int i = 0; S.next(i, u); ++i) {
        for (int half = 0; half < 2; ++half) {
            const bf16* Ab = A + (size_t)(u.pm * 256 + half * 128) * K; const bf16* Bb = Bt + (size_t)u.pn * 256 * K;
            float acc[4][16];
#pragma unroll
            for (int r = 0; r < 4; ++r)
#pragma unroll
                for (int q = 0; q < 16; ++q) acc[r][q] = 0.f;
            for (int k0 = u.kt0 * 64; k0 < (u.kt0 + u.nkt) * 64; k0 += 16) {
                __syncthreads();
                { const int r = tid >> 1, kh = tid & 1;
                  if (tid < 256) { const u32x4 w = *(const u32x4*)(Ab + (size_t)r * K + k0 + kh * 8);
#pragma unroll
                      for (int q = 0; q < 4; ++q) { As[(kh * 8 + 2 * q) * 132 + r] = __uint_as_float(w[q] << 16); As[(kh * 8 + 2 * q + 1) * 132 + r] = __uint_as_float(w[q] & 0xffff0000u); } }
                  const u32x4 w = *(const u32x4*)(Bb + (size_t)r * K + k0 + kh * 8);
#pragma unroll
                  for (int q = 0; q < 4; ++q) { Bs[(kh * 8 + 2 * q) * 260 + r] = __uint_as_float(w[q] << 16); Bs[(kh * 8 + 2 * q + 1) * 260 + r] = __uint_as_float(w[q] & 0xffff0000u); } }
                __syncthreads();
#pragma unroll 4
                for (int k = 0; k < 16; ++k) {
                    const f32x4 a = *(const LAS f32x4*)(As + k * 132 + 4 * ty);
                    const f32x4 b0 = *(const LAS f32x4*)(Bs + k * 260 + 8 * tx), b1 = *(const LAS f32x4*)(Bs + k * 260 + 8 * tx + 4);
                    const f32x4 b2 = *(const LAS f32x4*)(Bs + k * 260 + 128 + 8 * tx), b3 = *(const LAS f32x4*)(Bs + k * 260 + 128 + 8 * tx + 4);
#pragma unroll
                    for (int r = 0; r < 4; ++r) {
#pragma unroll
                        for (int q = 0; q < 4; ++q) { acc[r][q] += a[r] * b0[q]; acc[r][4 + q] += a[r] * b1[q]; acc[r][8 + q] += a[r] * b2[q]; acc[r][12 + q] += a[r] * b3[q]; }
                    }
                }
            }
#pragma unroll
            for (int r = 0; r < 4; ++r) {
                float lo[8], hi[8];
#pragma unroll
                for (int q = 0; q < 8; ++q) { lo[q] = acc[r][q]; hi[q] = acc[r][8 + q]; }
                E.pair8(u, u.pm * 256 + half * 128 + 4 * ty + r, 8 * tx, lo, hi);
            }
        }
    }
    __syncthreads();
}

template <bool FAST, bool VARK = false, class Epi, class Sched>
__device__ __forceinline__ void gemm_run(Frame& F, const bf16* A, const bf16* Bt, int K, const Sched& S, const Epi& E) {
    if constexpr (FAST) { const Gemm g{A, Bt, 0, 0, K}; const EpiWrap<Epi> W{E}; gemm_phase<EpiWrap<Epi>, Sched, true, true, VARK>(F.lds, g, S, W, F.wave); }
    else { F.refresh(); gemm_simple(F, A, Bt, K, S, E); }
}
#ifndef FAST_ATTN
#define FAST_ATTN 1
#endif
#ifndef FAST_SGU
#define FAST_SGU 1
#endif
#ifndef FAST_INPROJ
#define FAST_INPROJ true
#endif
#ifndef FAST_OUTPROJ
#define FAST_OUTPROJ true
#endif
#ifndef FAST_FFN1D
#define FAST_FFN1D true
#endif
#ifndef FAST_FFN2D
#define FAST_FFN2D true
#endif
#ifndef FAST_FFN1E
#define FAST_FFN1E true
#endif
#ifndef FAST_FFN2E
#define FAST_FFN2E true
#endif
__device__ __forceinline__ void tr_item(const float* W, int ldw, int k0, int srcCol0, bf16* WT, int Kd, int dstRow0, const float* scaleK, LAS float* scr, int lane) {
    const int kr = lane >> 4, nc = (lane & 15) * 4, c4 = lane & 3;
#pragma unroll
    for (int ps = 0; ps < 2; ++ps) {
        f32x4 v[8];
#pragma unroll
        for (int i = 0; i < 8; ++i) v[i] = *(const f32x4*)(W + (size_t)(k0 + 32 * ps + 4 * i + kr) * ldw + srcCol0 + nc);
        if (scaleK) {
#pragma unroll
            for (int i = 0; i < 8; ++i) v[i] = v[i] * scaleK[k0 + 32 * ps + 4 * i + kr];
        }
#pragma unroll
        for (int i = 0; i < 8; ++i)
#pragma unroll
            for (int q = 0; q < 4; ++q) scr[(4 * i + kr) * 65 + nc + q] = v[i][q];
        asm volatile("s_waitcnt lgkmcnt(0)" ::: "memory");
#pragma unroll
        for (int j = 0; j < 4; ++j) { const int n = (lane >> 2) + 16 * j; const LAS float* sp = scr + (8 * c4) * 65 + n;
            u32x4 o; o.x = pk2(sp[0], sp[65]); o.y = pk2(sp[2 * 65], sp[3 * 65]); o.z = pk2(sp[4 * 65], sp[5 * 65]); o.w = pk2(sp[6 * 65], sp[7 * 65]);
            *(u32x4*)(WT + (size_t)(dstRow0 + n) * Kd + k0 + 32 * ps + 8 * c4) = o; }
        asm volatile("s_waitcnt lgkmcnt(0)" ::: "memory");
    }
}
__device__ __forceinline__ void p0_prologue(Frame& F) {
    F.refresh();
    {
        LAS float* cact = (LAS float*)F.lds;
        LAS float* red = (LAS float*)(F.lds + 32768);
        const float* c = F.in[I_C];
        for (int i = F.tid; i < NB * DM; i += NTHREADS) cact[i] = silu_f(c[i]);
        __syncthreads();
        float* mod = (float*)(F.ws + WS_MOD);
        for (int it = F.vcu; it < NL * (NMOD * DM / 64); it += F.G) {
            const int l = it / (NMOD * DM / 64), j0 = (it % (NMOD * DM / 64)) * 64;
            const float* W = F.in[I_WADA] + (size_t)l * DM * (NMOD * DM) + j0 + F.lane;
            float acc[8];
#pragma unroll
            for (int b = 0; b < 8; ++b) acc[b] = 0.f;
            const int d0 = F.wave * 128;
#pragma unroll 8
            for (int d = 0; d < 128; ++d) { const float w = W[(size_t)(d0 + d) * (NMOD * DM)];
#pragma unroll
                for (int b = 0; b < 8; ++b) acc[b] += cact[b * DM + d0 + d] * w; }
#pragma unroll
            for (int b = 0; b < 8; ++b) red[(F.wave * 8 + b) * 64 + F.lane] = acc[b];
            __syncthreads();
            { const int b = F.tid >> 6, ln = F.tid & 63; float s = 0.f;
#pragma unroll
              for (int w = 0; w < 8; ++w) s += red[(w * 8 + b) * 64 + ln];
              mod[((size_t)l * NB + b) * (NMOD * DM) + j0 + ln] = s + F.in[I_BADA][(size_t)l * (NMOD * DM) + j0 + ln]; }
            __syncthreads();
        }
    }
    {
        float* wf = (float*)(F.ws + WS_WF); float* wr = (float*)(F.ws + WS_WR);
        const int gt = F.vcu * NTHREADS + F.tid, GT = F.G * NTHREADS;
        for (int i = gt; i < NL * 8 * DM; i += GT) { const int l = i / (8 * DM), j = (i / DM) % 8, d = i % DM; wf[i] = F.in[I_WIN][((size_t)l * DM + d) * INC + 3 * AW + j]; }
        for (int i = gt; i < 8 * DM; i += GT) { const int j = i / DM, d = i % DM; wr[i] = F.in[I_WROUTER][(size_t)d * NE + j]; }
    }
    {
        LAS float* scr = (LAS float*)(F.lds + F.wave * 8320);
        const int gw = F.vcu * NWAVES + F.wave, NGW = F.G * NWAVES;
        constexpr int N_IN = NL * (NIN / 64) * (DM / 64);
        constexpr int N_OUT = NL * (DM / 64) * (DM / 64);
        constexpr int N_GU = (2 * DFF / 64) * (DM / 64);
        constexpr int N_D = (DM / 64) * (DFF / 64);
        constexpr int N_EGU = NE * (2 * EFF / 64) * (DM / 64);
        constexpr int N_ED = NE * (DM / 64) * (EFF / 64);
        constexpr int NITEMS = N_IN + N_OUT + N_GU + N_D + N_EGU + N_ED;
        for (int it = gw; it < NITEMS; it += NGW) {
            int r = it;
            if (r < N_IN) {
                const int l = r / (40 * 16), nb = (r / 16) % 40, kb = r % 16; const int dr = nb * 64, sc = dr < 1536 ? dr : dr + 8;
                tr_item(F.in[I_WIN] + (size_t)l * DM * INC, INC, kb * 64, sc, (bf16*)(F.ws + WS_WIN) + (size_t)l * NIN * DM, DM, dr, nullptr, scr, F.lane); continue; }
            r -= N_IN;
            if (r < N_OUT) {
                const int l = r / 256, nb = (r / 16) % 16, kb = r % 16; const float* g = kb < 8 ? F.in[I_GOA] + l * AW : F.in[I_GOS] + l * AW - AW;
                tr_item(F.in[I_WOUT] + (size_t)l * DM * DM, DM, kb * 64, nb * 64, (bf16*)(F.ws + WS_WOUT) + (size_t)l * DM * DM, DM, nb * 64, g, scr, F.lane); continue; }
            r -= N_OUT;
            if (r < N_GU) {
                const int nb = r / 16, kb = r % 16; const int dr = nb * 64, t = dr >> 8, w = dr & 255; const int sc = (w < 128) ? (128 * t + w) : (DFF + 128 * t + (w - 128));
                tr_item(F.in[I_WGUD], 2 * DFF, kb * 64, sc, (bf16*)(F.ws + WS_WGU), DM, dr, nullptr, scr, F.lane); continue; }
            r -= N_GU;
            if (r < N_D) {
                const int nb = r / 44, kb = r % 44;
                tr_item(F.in[I_WDD], DM, kb * 64, nb * 64, (bf16*)(F.ws + WS_WD), DFF, nb * 64, nullptr, scr, F.lane); continue; }
            r -= N_D;
            if (r < N_EGU) {
                const int e = r / (112 * 16), nb = (r / 16) % 112, kb = r % 16; const int dr = nb * 64, t = dr >> 8, w = dr & 255; const int sc = (w < 128) ? (128 * t + w) : (EFF + 128 * t + (w - 128));
                tr_item(F.in[I_WGUE] + (size_t)e * DM * 2 * EFF, 2 * EFF, kb * 64, sc, (bf16*)(F.ws + WS_EGU) + (size_t)e * 2 * EFF * DM, DM, dr, nullptr, scr, F.lane); continue; }
            r -= N_EGU;
            {
                const int e = r / (16 * 56), nb = (r / 56) % 16, kb = r % 56;
                tr_item(F.in[I_WDE] + (size_t)e * EFF * DM, DM, kb * 64, nb * 64, (bf16*)(F.ws + WS_ED) + (size_t)e * DM * EFF, EFF, nb * 64, nullptr, scr, F.lane); }
        }
    }
}

__device__ __forceinline__ f32x4 ld4(const float* p, int j, int lane) { return *((const f32x4*)p + 64 * j + lane); }
__device__ __forceinline__ float log_sigmoid_f(float a) { return fminf(a, 0.f) - log1pf(__expf(-fabsf(a))); }
__device__ __forceinline__ void ada_norm_row(f32x4 (&v)[4], const float* g, const float* sc, const float* sh, bf16* hrow, int lane) {
    float ss = 0.f;
#pragma unroll
    for (int j = 0; j < 4; ++j) ss += dot4(v[j], v[j]);
    const float rstd = 1.0f / sqrtf(wave_sum(ss) * (1.f / DM) + EPS);
#pragma unroll
    for (int j = 0; j < 4; ++j) { const f32x4 gg = ld4(g, j, lane), s1 = ld4(sc, j, lane), s0 = ld4(sh, j, lane); v[j] = v[j] * rstd * gg * (1.f + s1) + s0;
        *((u64*)hrow + 64 * j + lane) = (u64)pk2(v[j].x, v[j].y) | ((u64)pk2(v[j].z, v[j].w) << 32); }
}
__device__ __forceinline__ void forget_row(Frame& F, const f32x4 (&h)[4], const LAS float* wf  , const float* bf, int b, int s) {
    float z = 0.f;
#pragma unroll
    for (int jj = 0; jj < 8; ++jj) { float p = 0.f;
#pragma unroll
        for (int j = 0; j < 4; ++j) p += dot4(h[j], *((const LAS f32x4*)(wf + jj * DM) + 64 * j + F.lane));
        p = wave_sum(p); if (F.lane == jj) z = p; }
    if (F.lane < 8) ((float*)(F.ws + WS_LOGF))[((size_t)b * NH + F.lane) * SEQ + s] = log_sigmoid_f(z + bf[F.lane]);
}
__device__ __forceinline__ void stage_lds_f32(Frame& F, LAS float* dst, const float* src, int n) {
    for (int i = F.tid * 4; i < n; i += NTHREADS * 4) *(LAS f32x4*)(dst + i) = *(const f32x4*)(src + i);
    __syncthreads();
}
__device__ __forceinline__ void phase_premix(Frame& F, int l, const float* xsrc) {
    F.refresh();
    LAS float* wf = (LAS float*)F.lds; stage_lds_f32(F, wf, (const float*)(F.ws + WS_WF) + (size_t)l * 8 * DM, 8 * DM);
    const int gw = F.vcu * NWAVES + F.wave, NGW = F.G * NWAVES; const float* mod = (const float*)(F.ws + WS_MOD);
    for (int row = gw; row < M; row += NGW) {
        const int b = row / SEQ, s = row % SEQ; const float* mb = mod + ((size_t)l * NB + b) * (NMOD * DM);
        f32x4 v[4];
#pragma unroll
        for (int j = 0; j < 4; ++j) v[j] = ld4(xsrc + (size_t)row * DM, j, F.lane);
        ada_norm_row(v, F.in[I_GPREMIX] + l * DM, mb + 1 * DM, mb + 0 * DM, (bf16*)(F.ws + WS_H) + (size_t)row * DM, F.lane);
        forget_row(F, v, wf, F.in[I_BFORGET] + l * NH, b, s);
    }
    __syncthreads();
}
__device__ __forceinline__ void phase_merge_norm(Frame& F) {
    F.refresh();
    const int gw = F.vcu * NWAVES + F.wave, NGW = F.G * NWAVES;
    const float* sa = (const float*)(F.ws + WS_SSQA); const float* ss = (const float*)(F.ws + WS_SSQS);
    for (int row = gw; row < M; row += NGW) {
        const f32x4 a0 = *(const f32x4*)(sa + (size_t)row * 8), a1 = *(const f32x4*)(sa + (size_t)row * 8 + 4);
        const f32x4 s0 = *(const f32x4*)(ss + (size_t)row * 16) + *(const f32x4*)(ss + (size_t)row * 16 + 8), s1 = *(const f32x4*)(ss + (size_t)row * 16 + 4) + *(const f32x4*)(ss + (size_t)row * 16 + 12);
        const float ra = 1.0f / sqrtf(((a0.x + a0.y) + (a0.z + a0.w) + (a1.x + a1.y) + (a1.z + a1.w)) * (1.f / AW) + EPS);
        const float rs = 1.0f / sqrtf(((s0.x + s0.y) + (s0.z + s0.w) + (s1.x + s1.y) + (s1.z + s1.w)) * (1.f / AW) + EPS);
        const u32x4* p = (const u32x4*)((const bf16*)(F.ws + WS_MG) + (size_t)row * DM); u32x4* po = (u32x4*)((bf16*)(F.ws + WS_MG2) + (size_t)row * DM);
#pragma unroll
        for (int j = 0; j < 2; ++j) { u32x4 w = p[64 * j + F.lane]; const float r = j == 0 ? ra : rs;
#pragma unroll
            for (int q = 0; q < 4; ++q) w[q] = pk2(__uint_as_float(w[q] << 16) * r, __uint_as_float(w[q] & 0xffff0000u) * r);
            po[64 * j + F.lane] = w; }
    }
}
__device__ __forceinline__ void phase_postmix(Frame& F, int l, const float* xsrc, bool moe) {
    F.refresh();
    LAS float* wr = (LAS float*)F.lds; LAS unsigned* lcnt = (LAS unsigned*)(F.lds + 32768); LAS unsigned* lbase = lcnt + 8;
    if (moe) { if (F.tid < 16) lcnt[F.tid] = 0u; stage_lds_f32(F, wr, (const float*)(F.ws + WS_WR), 8 * DM); }
    const int gw = F.vcu * NWAVES + F.wave, NGW = F.G * NWAVES; const float* mod = (const float*)(F.ws + WS_MOD);
    const float* Y = (const float*)(F.ws + WS_Y); unsigned* tok = (unsigned*)(F.ws + WS_TOK);
    for (int row = gw; row < M; row += NGW) {
        const int b = row / SEQ; const float* mb = mod + ((size_t)l * NB + b) * (NMOD * DM);
        f32x4 y[4], v[4]; float ss = 0.f;
#pragma unroll
        for (int j = 0; j < 4; ++j) { y[j] = ld4(Y + (size_t)row * DM, j, F.lane); v[j] = ld4(xsrc + (size_t)row * DM, j, F.lane); ss += dot4(y[j], y[j]); }
        const float rstd = 1.0f / sqrtf(wave_sum(ss) * (1.f / DM) + EPS);
#pragma unroll
        for (int j = 0; j < 4; ++j) { const f32x4 g = ld4(F.in[I_GPOSTMIX] + l * DM, j, F.lane), gt = ld4(mb + 2 * DM, j, F.lane); v[j] = v[j] + (1.f + gt) * (y[j] * rstd * g);
            *((f32x4*)(F.out + (size_t)row * DM) + 64 * j + F.lane) = v[j]; }
        ada_norm_row(v, F.in[I_GPREFFN] + l * DM, mb + 4 * DM, mb + 3 * DM, (bf16*)(F.ws + WS_H) + (size_t)row * DM, F.lane);
        if (moe) {
            float lg[8];
#pragma unroll
            for (int jj = 0; jj < 8; ++jj) { float p = 0.f;
#pragma unroll
                for (int j = 0; j < 4; ++j) p += dot4(v[j], *((const LAS f32x4*)(wr + jj * DM) + 64 * j + F.lane));
                lg[jj] = wave_sum(p); }
            int e0 = 0; float v0 = lg[0];
#pragma unroll
            for (int jj = 1; jj < 8; ++jj) if (lg[jj] > v0) { v0 = lg[jj]; e0 = jj; }
            int e1 = -1; float v1 = -INFINITY;
#pragma unroll
            for (int jj = 0; jj < 8; ++jj) if (jj != e0 && lg[jj] > v1) { v1 = lg[jj]; e1 = jj; }
            if (e1 < 0) e1 = (e0 + 1) & 7;
            if (F.lane == 0) {
                const float w1 = 1.f / (1.f + __expf(v0 - v1)), w0 = 1.f - w1;
                const unsigned r0 = __hip_atomic_fetch_add(&lcnt[e0], 1u, __ATOMIC_RELAXED, __HIP_MEMORY_SCOPE_WORKGROUP), r1 = __hip_atomic_fetch_add(&lcnt[e1], 1u, __ATOMIC_RELAXED, __HIP_MEMORY_SCOPE_WORKGROUP);
                u32x4 a; a.x = (unsigned)e0; a.y = (unsigned)e1; a.z = r0; a.w = r1; *(u32x4*)(tok + (size_t)row * 8) = a;
                u32x2 w; w.x = __float_as_uint(w0); w.y = __float_as_uint(w1); *(u32x2*)(tok + (size_t)row * 8 + 4) = w;
            }
        }
    }
    if (moe) {
        __syncthreads();
        if (F.tid < 8) lbase[F.tid] = __hip_atomic_fetch_add(F.ctl + CW_CNT + 64 * F.tid, lcnt[F.tid], __ATOMIC_RELAXED, __HIP_MEMORY_SCOPE_AGENT);
        __syncthreads();
        if (F.lane == 0) for (int row = gw; row < M; row += NGW) { u32x4 a = *(u32x4*)(tok + (size_t)row * 8); a.z += lbase[a.x]; a.w += lbase[a.y]; *(u32x4*)(tok + (size_t)row * 8) = a; }
    }
    __syncthreads();
}
__device__ __forceinline__ void phase_scatter(Frame& F) {
    F.refresh();
    MoeLayout Lay; Lay.init(F.ctl + CW_CNT);
    const int gw = F.vcu * NWAVES + F.wave, NGW = F.G * NWAVES; const unsigned* tok = (const unsigned*)(F.ws + WS_TOK);
    const bf16* H = (const bf16*)(F.ws + WS_H); bf16* HS = (bf16*)(F.ws + WS_HS);
    for (int row = gw; row < M; row += NGW) {
        const u32x4 a = *(const u32x4*)(tok + (size_t)row * 8);
        const int s0 = Lay.panel_base((int)a.x) * 256 + (int)a.z, s1 = Lay.panel_base((int)a.y) * 256 + (int)a.w;
        const u32x4* src = (const u32x4*)(H + (size_t)row * DM); u32x4* d0 = (u32x4*)(HS + (size_t)s0 * DM); u32x4* d1 = (u32x4*)(HS + (size_t)s1 * DM);
#pragma unroll
        for (int j = 0; j < 2; ++j) { const u32x4 w = src[64 * j + F.lane]; if (s0 < CAPROWS) d0[64 * j + F.lane] = w; if (s1 < CAPROWS) d1[64 * j + F.lane] = w; }
    }
}
__device__ __forceinline__ void phase_final(Frame& F, int l, bool moe) {
    F.refresh();
    const bool nxt = (l + 1 < NL);
    LAS float* wf = (LAS float*)F.lds; if (nxt) stage_lds_f32(F, wf, (const float*)(F.ws + WS_WF) + (size_t)(l + 1) * 8 * DM, 8 * DM);
    MoeOrder MO; if (moe) MO.init(F.ctl + CW_CNT, DM / 256, F.G, 0, EFF, true);
    const MoeLayout& Lay = MO.Lay; const float* PART = (const float*)(F.ws + WS_PART);
    const int gw = F.vcu * NWAVES + F.wave, NGW = F.G * NWAVES; const float* mod = (const float*)(F.ws + WS_MOD);
    const float* Y = (const float*)(F.ws + WS_Y); const float* YS = (const float*)(F.ws + WS_YS); const unsigned* tok = (const unsigned*)(F.ws + WS_TOK);
    for (int row = gw; row < M; row += NGW) {
        const int b = row / SEQ, s = row % SEQ; const float* mb = mod + ((size_t)l * NB + b) * (NMOD * DM);
        f32x4 y[4], v[4]; float ss = 0.f;
        if (moe) {
            const u32x4 a = *(const u32x4*)(tok + (size_t)row * 8); const u32x2 ww = *(const u32x2*)(tok + (size_t)row * 8 + 4);
            int s0 = Lay.panel_base((int)a.x) * 256 + (int)a.z, s1 = Lay.panel_base((int)a.y) * 256 + (int)a.w; if (s0 >= CAPROWS) s0 = 0; if (s1 >= CAPROWS) s1 = 0;
            const float w0 = __uint_as_float(ww.x), w1 = __uint_as_float(ww.y);
#pragma unroll
            for (int j = 0; j < 4; ++j) {
                f32x4 ya, yb;
                { const int q = MO.unit_index(s0 >> 8, j) - MO.R * MO.G;
                  if (MO.sp > 1 && q >= 0) { const f32x4* pp = (const f32x4*)(PART + ((size_t)(q * 14) * 256 + (s0 & 255)) * 256) + F.lane; f32x4 t[14];
#pragma unroll
                      for (int sl = 0; sl < 14; ++sl) t[sl] = pp[(size_t)(sl < MO.sp ? sl : MO.sp - 1) * 16384];
                      ya = t[0];
#pragma unroll
                      for (int sl = 1; sl < 14; ++sl) ya += (sl < MO.sp) ? t[sl] : (f32x4){0.f, 0.f, 0.f, 0.f}; }
                  else ya = ld4(YS + (size_t)s0 * DM, j, F.lane); }
                { const int q = MO.unit_index(s1 >> 8, j) - MO.R * MO.G;
                  if (MO.sp > 1 && q >= 0) { const f32x4* pp = (const f32x4*)(PART + ((size_t)(q * 14) * 256 + (s1 & 255)) * 256) + F.lane; f32x4 t[14];
#pragma unroll
                      for (int sl = 0; sl < 14; ++sl) t[sl] = pp[(size_t)(sl < MO.sp ? sl : MO.sp - 1) * 16384];
                      yb = t[0];
#pragma unroll
                      for (int sl = 1; sl < 14; ++sl) yb += (sl < MO.sp) ? t[sl] : (f32x4){0.f, 0.f, 0.f, 0.f}; }
                  else yb = ld4(YS + (size_t)s1 * DM, j, F.lane); }
                y[j] = w0 * ya + w1 * yb;
            }
        } else {
#pragma unroll
            for (int j = 0; j < 4; ++j) y[j] = ld4(Y + (size_t)row * DM, j, F.lane);
        }
#pragma unroll
        for (int j = 0; j < 4; ++j) { v[j] = ld4(F.out + (size_t)row * DM, j, F.lane); ss += dot4(y[j], y[j]); }
        const float rstd = 1.0f / sqrtf(wave_sum(ss) * (1.f / DM) + EPS);
#pragma unroll
        for (int j = 0; j < 4; ++j) { const f32x4 g = ld4(F.in[I_GPOSTFFN] + l * DM, j, F.lane), gt = ld4(mb + 5 * DM, j, F.lane); v[j] = v[j] + (1.f + gt) * (y[j] * rstd * g);
            *((f32x4*)(F.out + (size_t)row * DM) + 64 * j + F.lane) = v[j]; }
        if (nxt) {
            const float* mn = mod + ((size_t)(l + 1) * NB + b) * (NMOD * DM);
            ada_norm_row(v, F.in[I_GPREMIX] + (l + 1) * DM, mn + 1 * DM, mn + 0 * DM, (bf16*)(F.ws + WS_H) + (size_t)row * DM, F.lane);
            forget_row(F, v, wf, F.in[I_BFORGET] + (l + 1) * NH, b, s);
        }
    }
    __syncthreads();
}

__device__ __forceinline__ void attn_simple(Frame& F) {
    F.refresh();
    const bf16* Q = (const bf16*)(F.ws + WS_QKVUV); const bf16* Kb = Q + (size_t)M * 512; const bf16* Vb = Kb + (size_t)M * 512;
    const float* logf = (const float*)(F.ws + WS_LOGF); bf16* MG = (bf16*)(F.ws + WS_MG); float* ssq = (float*)(F.ws + WS_SSQA);
    for (int g2 = F.vcu * NTHREADS + F.tid; g2 < NB * NH * SEQ * 2; g2 += F.G * NTHREADS) {
        const int gt = g2 >> 1, hf = g2 & 1;
        const int bh = gt / SEQ, t = gt % SEQ, b = bh / NH, h = bh % NH; const size_t rb = (size_t)b * SEQ;
        float q[32], o[32];
        { const u32x4* qp = (const u32x4*)(Q + (rb + t) * 512 + h * 64 + hf * 32);
#pragma unroll
          for (int i = 0; i < 4; ++i) { const u32x4 w = qp[i];
#pragma unroll
              for (int k = 0; k < 4; ++k) { q[8 * i + 2 * k] = __uint_as_float(w[k] << 16); q[8 * i + 2 * k + 1] = __uint_as_float(w[k] & 0xffff0000u); } } }
#pragma unroll
        for (int d = 0; d < 32; ++d) o[d] = 0.f;
        float m = -INFINITY, lsum = 0.f, Lrun = 0.f;
        const int tmax = __builtin_amdgcn_readfirstlane(t | 31);
        for (int s = 0; s <= tmax; ++s) {
            Lrun += logf[(size_t)bh * SEQ + s];
            const u32x4* kp = (const u32x4*)(Kb + (rb + s) * 512 + h * 64 + hf * 32); float dot = 0.f;
#pragma unroll
            for (int i = 0; i < 4; ++i) { const u32x4 w = kp[i];
#pragma unroll
                for (int k = 0; k < 4; ++k) dot += q[8 * i + 2 * k] * __uint_as_float(w[k] << 16) + q[8 * i + 2 * k + 1] * __uint_as_float(w[k] & 0xffff0000u); }
            dot += __shfl_xor(dot, 1);
            if (s <= t) {
                const float sc = dot - Lrun * LOG2E, mn = fmaxf(m, sc), al = exp2f(m - mn), p = exp2f(sc - mn);
                lsum = lsum * al + p; m = mn;
                const u32x4* vp = (const u32x4*)(Vb + (rb + s) * 512 + h * 64 + hf * 32);
#pragma unroll
                for (int i = 0; i < 4; ++i) { const u32x4 w = vp[i];
#pragma unroll
                    for (int k = 0; k < 4; ++k) { o[8 * i + 2 * k] = o[8 * i + 2 * k] * al + p * __uint_as_float(w[k] << 16); o[8 * i + 2 * k + 1] = o[8 * i + 2 * k + 1] * al + p * __uint_as_float(w[k] & 0xffff0000u); } }
            }
        }
        const float il = 1.f / lsum; float sq = 0.f;
        bf16* op = MG + (rb + t) * DM + h * 64 + hf * 32;
#pragma unroll
        for (int i = 0; i < 4; ++i) { float v[8];
#pragma unroll
            for (int k = 0; k < 8; ++k) { v[k] = o[8 * i + k] * il; sq += v[k] * v[k]; }
            store8_bf16(op + 8 * i, v); }
        sq += __shfl_xor(sq, 1);
        if (hf == 0) ssq[(rb + t) * 8 + h] = sq;
    }
}
__device__ __forceinline__ void sgu_simple(Frame& F, int l) {
    F.refresh();
    const bf16* U = (const bf16*)(F.ws + WS_QKVUV) + (size_t)3 * M * 512; const bf16* SV = U + (size_t)M * 512;
    bf16* MG = (bf16*)(F.ws + WS_MG); float* ssq = (float*)(F.ws + WS_SSQS);
    LAS float* st = (LAS float*)F.lds;
    LAS float* vn = (LAS float*)(F.lds + 1024);
    LAS float* wl = (LAS float*)(F.lds + 1024 + 128 * 65 * 4);
    const float* gv = F.in[I_GV] + l * AW;
    for (int un = F.vcu; un < NB * 16 * 8; un += F.G) {
        const int g = un & 7, ch = (un >> 3) & 15, b = un >> 7; const size_t rb = (size_t)b * SEQ + ch * 128;
        __syncthreads();
        for (int r = F.wave * 16; r < F.wave * 16 + 16; ++r) {
            const u32x4 w = *((const u32x4*)(SV + (rb + r) * 512) + F.lane); float x[8];
#pragma unroll
            for (int k = 0; k < 4; ++k) { x[2 * k] = __uint_as_float(w[k] << 16); x[2 * k + 1] = __uint_as_float(w[k] & 0xffff0000u); }
            float s = 0.f;
#pragma unroll
            for (int k = 0; k < 8; ++k) s += x[k];
            const float mean = wave_sum(s) * (1.f / 512.f); float q = 0.f;
#pragma unroll
            for (int k = 0; k < 8; ++k) { const float d = x[k] - mean; q += d * d; }
            const float rstd = 1.0f / sqrtf(wave_sum(q) * (1.f / 512.f) + EPS);
            if (F.lane == 0) { st[2 * r] = mean; st[2 * r + 1] = rstd; }
        }
        const float* W = F.in[I_WSP] + ((size_t)l * 8 + g) * 128 * 128;
        for (int i = F.tid; i < 128 * 128; i += NTHREADS) { const int t = i >> 7, s = i & 127; wl[t * 129 + s] = (s <= t) ? W[i] : 0.f; }
        __syncthreads();
        for (int i = F.tid; i < 128 * 64; i += NTHREADS) { const int s = i >> 6, d = i & 63; vn[s * 65 + d] = (bf2f(SV[(rb + s) * 512 + g * 64 + d]) - st[2 * s]) * st[2 * s + 1] * gv[g * 64 + d]; }
        __syncthreads();
        const int t = F.tid >> 2, dq = F.tid & 3;
        float acc[16];
#pragma unroll
        for (int i = 0; i < 16; ++i) acc[i] = 0.f;
        for (int s = 0; s <= t; ++s) { const float w = wl[t * 129 + s];
#pragma unroll
            for (int i = 0; i < 16; ++i) acc[i] += w * vn[s * 65 + dq * 16 + i]; }
        const float bs = F.in[I_BSP][((size_t)l * 8 + g) * 128 + t]; float sq = 0.f;
        const bf16* up = U + (rb + t) * 512 + g * 64 + dq * 16; bf16* op = MG + (rb + t) * DM + AW + g * 64 + dq * 16;
#pragma unroll
        for (int i = 0; i < 2; ++i) { float v[8];
#pragma unroll
            for (int k = 0; k < 8; ++k) { v[k] = bf2f(up[8 * i + k]) * (acc[8 * i + k] + bs); sq += v[k] * v[k]; }
            store8_bf16(op + 8 * i, v); }
        sq += __shfl_xor(sq, 1); sq += __shfl_xor(sq, 2);
        if (dq == 0) { ssq[(rb + t) * 16 + 2 * g] = sq; ssq[(rb + t) * 16 + 2 * g + 1] = 0.f; }
    }
    __syncthreads();
}

#include <hip/hip_bf16.h>
#include <cmath>
namespace attn_body {
typedef float f32x4_t __attribute__((ext_vector_type(4)));
using bf16=__hip_bfloat16;
using bf16x8=__attribute__((ext_vector_type(8)))short;
using s16x4=__attribute__((ext_vector_type(4)))short;
using f32x16=__attribute__((ext_vector_type(16)))float;
using u32x4=__attribute__((ext_vector_type(4)))unsigned;
constexpr int BATCH=8,NHEAD=8,SEQ=2048,D=64,DM=NHEAD*D,OP=1024;
constexpr int NW=8,QBLK=32,QB=QBLK*NW,KVBLK=64,NQB=SEQ/QB;
constexpr int ATTN_PITCH=DM, ATTN_UNIT_ROWS=QB;
__device__ __forceinline__ int crow(int r,int hi){return (r&3)+8*(r>>2)+4*hi;}
#define SBAR() __builtin_amdgcn_sched_barrier(0)
__device__ __forceinline__ void cmask(f32x16&p0,f32x16&p1,int jb,int qrel,int hi){
  const float NEG=-INFINITY; int kb=64*jb+4*hi;
  #pragma unroll
  for(int r=0;r<16;++r){int kv=kb+(r&3)+8*(r>>2); if(kv>qrel)p0[r]=NEG; if(kv+32>qrel)p1[r]=NEG;}
}

constexpr int NSLOT=3, SLOTB=8192;
constexpr int LDS_K=0, LDS_V=NSLOT*SLOTB, LDS_WS=2*NSLOT*SLOTB, LDS_OST=LDS_WS+NW*64*4, LDS_BIAS=LDS_OST+NW*4096, LDS_BYTES=LDS_BIAS+SEQ*4;
constexpr float C2=0.125f*1.4426950408889634f;
__device__ __forceinline__ void glds16(const void*gsrc,unsigned lds_dst){unsigned keep;
  asm volatile("s_mov_b32 %0, m0\n\ts_mov_b32 m0, %2\n\ts_nop 0\n\tglobal_load_lds_dwordx4 %1, off\n\ts_mov_b32 m0, %0":"=&s"(keep):"v"(gsrc),"s"(lds_dst):"memory");}
__device__ __forceinline__ float max3f(float a,float b,float c){float r;asm("v_max3_f32 %0, %1, %2, %3":"=v"(r):"v"(a),"v"(b),"v"(c));return r;}
__device__ __forceinline__ float max2f(float a,float b){float r;asm("v_max_f32_e32 %0, %1, %2":"=v"(r):"v"(a),"v"(b));return r;}
__device__ __forceinline__ float fadd_s(float a,float b){float r;asm("v_add_f32_e32 %0, %1, %2":"=v"(r):"v"(a),"v"(b));return r;}
__device__ __forceinline__ float fsub_s(float a,float b){float r;asm("v_sub_f32_e32 %0, %1, %2":"=v"(r):"v"(a),"v"(b));return r;}
typedef float f32x2_t __attribute__((ext_vector_type(2))); typedef __bf16 bf16x2_t __attribute__((ext_vector_type(2)));
__device__ __forceinline__ unsigned cvtpk_s(float lo,float hi){f32x2_t v={lo,hi};bf16x2_t b=__builtin_convertvector(v,bf16x2_t);return __builtin_bit_cast(unsigned,b);}
#define WAIT_BAR(N) asm volatile("s_waitcnt vmcnt(" #N ") lgkmcnt(0)\n\ts_barrier":::"memory")

__device__ __forceinline__ void qkt(f32x16&p0,f32x16&p1,const char*Kslot,const bf16x8*qr,int r32,int hi){
  const char*kb=Kslot+hi*1024+r32*16;
  #pragma unroll
  for(int d0=0;d0<4;++d0){
    const bf16x8 b0=*reinterpret_cast<const bf16x8*>(kb+d0*2048);
    const bf16x8 b1=*reinterpret_cast<const bf16x8*>(kb+d0*2048+512);
    {p0=__builtin_amdgcn_mfma_f32_32x32x16_bf16(b0,qr[d0],p0,0,0,0);p1=__builtin_amdgcn_mfma_f32_32x32x16_bf16(b1,qr[d0],p1,0,0,0);}}
}
typedef __attribute__((address_space(3))) const char* lds_cptr;
typedef short v4i16_t __attribute__((ext_vector_type(4)));
__device__ __forceinline__ void kload8(bf16x8*kf,lds_cptr kp){
  kf[0]=*(const __attribute__((address_space(3))) bf16x8*)(kp);      kf[1]=*(const __attribute__((address_space(3))) bf16x8*)(kp+512);
  kf[2]=*(const __attribute__((address_space(3))) bf16x8*)(kp+2048); kf[3]=*(const __attribute__((address_space(3))) bf16x8*)(kp+2560);
  kf[4]=*(const __attribute__((address_space(3))) bf16x8*)(kp+4096); kf[5]=*(const __attribute__((address_space(3))) bf16x8*)(kp+4608);
  kf[6]=*(const __attribute__((address_space(3))) bf16x8*)(kp+6144); kf[7]=*(const __attribute__((address_space(3))) bf16x8*)(kp+6656);
}
__device__ __forceinline__ void kload2(bf16x8*kf,lds_cptr kp,int j){ kf[2*j]=*(const __attribute__((address_space(3))) bf16x8*)(kp+j*2048); kf[2*j+1]=*(const __attribute__((address_space(3))) bf16x8*)(kp+j*2048+512); }
__device__ __forceinline__ s16x4 vtr(lds_cptr p){ return __builtin_bit_cast(s16x4,__builtin_amdgcn_ds_read_tr16_b64_v4i16((__attribute__((address_space(3))) v4i16_t*)p)); }
__device__ __forceinline__ float rowmax(const f32x16&p0,const f32x16&p1){
  float a=max3f(p0[0],p0[1],p1[0]),b=max3f(p0[2],p0[3],p1[1]);a=max3f(a,p1[2],p1[3]);
  #pragma unroll
  for(int r=4;r<16;r+=4){a=max3f(a,p0[r],p0[r+1]);b=max3f(b,p0[r+2],p0[r+3]);a=max3f(a,p1[r],p1[r+1]);b=max3f(b,p1[r+2],p1[r+3]);}
  const float m=max2f(a,b);
  auto rr=__builtin_amdgcn_permlane32_swap(__float_as_uint(m),__float_as_uint(m),false,false);
  return max2f(__uint_as_float(rr[0]),__uint_as_float(rr[1]));
}
__device__ __forceinline__ void pv(f32x16*o,int vb,bf16x8 pa0,bf16x8 pa1,bf16x8 pa2,bf16x8 pa3){
  #pragma unroll
  for(int d0=0;d0<2;++d0){s16x4 lo[4],hi[4];
    #pragma unroll
    for(int ks=0;ks<4;++ks){
      asm volatile("ds_read_b64_tr_b16 %0,%1 offset:%c2":"=&v"(lo[ks]):"v"(vb),"i"(d0*4096+ks*1024):"memory");
      asm volatile("ds_read_b64_tr_b16 %0,%1 offset:%c2":"=&v"(hi[ks]):"v"(vb),"i"(d0*4096+ks*1024+512):"memory");}
    asm volatile("s_waitcnt lgkmcnt(0)":::"memory");SBAR();
    #define PK(k) (bf16x8){lo[k][0],lo[k][1],lo[k][2],lo[k][3],hi[k][0],hi[k][1],hi[k][2],hi[k][3]}
    o[d0]=__builtin_amdgcn_mfma_f32_32x32x16_bf16(pa0,PK(0),o[d0],0,0,0);
    o[d0]=__builtin_amdgcn_mfma_f32_32x32x16_bf16(pa1,PK(1),o[d0],0,0,0);
    o[d0]=__builtin_amdgcn_mfma_f32_32x32x16_bf16(pa2,PK(2),o[d0],0,0,0);
    o[d0]=__builtin_amdgcn_mfma_f32_32x32x16_bf16(pa3,PK(3),o[d0],0,0,0);
    #undef PK
  }
}

#ifndef ATTN_STORE16
#define ATTN_STORE16(p,v) (*(u32x4*)(p)=(v))
#endif
template<int THRL> __device__ __forceinline__ void attn_unit(int b,int h,int qb,const bf16*Q,const bf16*__restrict__ K,const bf16*__restrict__ V,bf16*O,float*SSQ,char*shm,const int wid){
  const int lane=fresh_lane(),r32=lane&31,hi=lane>>5;
  const long rowbase=(long)b*SEQ; const int q0=qb*QB;
  const bf16*Qw=Q+(rowbase+q0+wid*QBLK)*DM+h*D;
  const bf16*Kh=K+rowbase*DM+h*D,*Vh=V+rowbase*DM+h*D;
  const unsigned lds0=(unsigned)(uintptr_t)shm;
  float*wsf=(float*)(shm+LDS_WS)+wid*64;
  const bf16*ksrc=Kh+(long)lane*DM+wid*8;
  const bf16*vsrc=Vh+(long)(16*(wid&3)+(lane>>2))*DM+(wid>>2)*32+(lane&3)*8;
  const unsigned kdst=lds0+LDS_K+wid*1024, vdst=lds0+LDS_V+wid*1024;
  #define DMA_K(t,slot) glds16(ksrc+(long)(t)*KVBLK*DM,(unsigned)__builtin_amdgcn_readfirstlane(kdst+(slot)))
  #define DMA_V(t,slot) glds16(vsrc+(long)(t)*KVBLK*DM,(unsigned)__builtin_amdgcn_readfirstlane(vdst+(slot)))
  const char*Kbase=shm+LDS_K; bf16x8 kf[8];
  const lds_cptr shm3=(lds_cptr)shm; const lds_cptr kp0=shm3+LDS_K+hi*1024+r32*16; const lds_cptr vp0=shm3+LDS_V+((lane>>4)&1)*32+(lane&3)*8+(4*hi+((lane&15)>>2))*64;
  const __attribute__((address_space(3))) float* biasp=(const __attribute__((address_space(3))) float*)(shm3+LDS_BIAS)+4*hi;
  #define CINIT(P0,P1,t) do{ const __attribute__((address_space(3))) float* bp_=biasp+64*(t); _Pragma("unroll") for(int j_=0;j_<4;++j_){ const f32x4_t b0_=*(const __attribute__((address_space(3))) f32x4_t*)(bp_+8*j_), b1_=*(const __attribute__((address_space(3))) f32x4_t*)(bp_+32+8*j_); _Pragma("unroll") for(int k_=0;k_<4;++k_){ P0[4*j_+k_]=b0_[k_]-mhat; P1[4*j_+k_]=b1_[k_]-mhat; } } }while(0)
  const int NT=(q0+QB)/KVBLK;
  DMA_K(0,0);DMA_V(0,0);DMA_K(1,SLOTB);
  bf16x8 qr[4];
  #pragma unroll
  for(int d0=0;d0<4;++d0)qr[d0]=*reinterpret_cast<const bf16x8*>(&Qw[(long)r32*DM+d0*16+hi*8]);
  float mhat=0.f,l_reg=0.f;f32x16 o[2];o[0]=f32x16{};o[1]=f32x16{};
  const int qrel=wid*QBLK+r32;
  #define CMASK(P0,P1,t) do{int jb_=(t)-(NT-4); if(jb_>=0)cmask(P0,P1,jb_,qrel,hi);}while(0)
  bool resc=false;
  #define START(P0,P1) do{ const float rm=rowmax(P0,P1); resc=false; \
    { const float dl=rm; mhat=fadd_s(mhat,dl); \
      _Pragma("unroll") for(int r=0;r<16;++r){P0[r]=fsub_s(P0[r],dl);P1[r]=fsub_s(P1[r],dl);} \
      } \
    _Pragma("unroll") for(int r=0;r<16;++r)P0[r]=__builtin_amdgcn_exp2f(P0[r]); }while(0)
  #define RESC() do{ if(resc){ asm volatile("s_waitcnt lgkmcnt(0)":::"memory"); \
      _Pragma("unroll") for(int d_=0;d_<2;++d_) _Pragma("unroll") for(int r=0;r<16;++r)o[d_][r]*=wsf[crow(r,hi)]; } }while(0)
  f32x16 pA0,pA1,pB0,pB1;
  int sl_prev=0,sl_cur=0,sl_next=SLOTB;
  #define ROT() do{sl_prev=sl_cur;sl_cur=sl_next;sl_next=(sl_next==(NSLOT-1)*SLOTB)?0:sl_next+SLOTB;}while(0)
  DMA_K(2,2*SLOTB);
  WAIT_BAR(3);
  CINIT(pA0,pA1,0);qkt(pA0,pA1,Kbase,qr,r32,hi);asm volatile("s_nop 15\n\ts_nop 7":"+v"(pA0),"+v"(pA1));CMASK(pA0,pA1,0);
  START(pA0,pA1);
  _Pragma("unroll") for(int r=0;r<16;++r)pA1[r]=__builtin_amdgcn_exp2f(pA1[r]);
  WAIT_BAR(0);
  DMA_K(3,0);DMA_V(1,SLOTB);
  ROT();
  kload8(kf,kp0+sl_cur);
  WAIT_BAR(2);
  s16x4 vlo[8],vhi[8]; u32x4 pw0,pw1,pw2,pw3;
  #define PKW(P,B) cvtpk_s(P[B],P[B+1])
  #define PAF(k) __builtin_bit_cast(bf16x8,pw##k)
  #define VFR(i) (bf16x8){vlo[i][0],vlo[i][1],vlo[i][2],vlo[i][3],vhi[i][0],vhi[i][1],vhi[i][2],vhi[i][3]}
  #define PIN(x) asm volatile("":"+v"(x))
  #define MX3(a,b,c) __builtin_fmaxf(__builtin_fmaxf((a),(b)),(c))
  #define GAPA(MF,A0,A1,A2,A3,W0,W1,PW) do{ MF; sacc+=A0; sacc+=A1; sacc+=A2; sacc+=A3; PIN(sacc); W0; W1; PIN(PW); SBAR(); }while(0)
  #define EX(v) __builtin_amdgcn_exp2f(v)
  #define GAPB(MF,X,B) do{ MF; X[B]=EX(X[B]); X[B+1]=EX(X[B+1]); X[B+2]=EX(X[B+2]); X[B+3]=EX(X[B+3]); PIN(X); SBAR(); }while(0)
  #define VRD(i) do{ vlo[i]=vtr(vp_+(((i)>>2)*4096+((i)&3)*1024)); vhi[i]=vtr(vp_+(((i)>>2)*4096+((i)&3)*1024+512)); }while(0)
  #define KRD(G,j) do{ if(G){ kload2(kf,kp0+sl_next,j); SBAR(); } }while(0)
  #define STEP(C0,C1,P0,P1,t,GK,GV,GL) do{ SBAR(); CINIT(C0,C1,t); SBAR(); \
    const lds_cptr vp_=vp0+sl_prev; \
    VRD(0); SBAR(); float sacc=(P0[0]+P0[1]); \
    GAPA(C0=__builtin_amdgcn_mfma_f32_32x32x16_bf16(kf[0],qr[0],C0,0,0,0), P0[2],P0[3],P0[4],P0[5],     pw0[0]=PKW(P0,0), pw0[1]=PKW(P0,2), pw0); \
    VRD(4); SBAR(); GAPA(C1=__builtin_amdgcn_mfma_f32_32x32x16_bf16(kf[1],qr[0],C1,0,0,0), P0[6],P0[7],P0[8],P0[9],     pw0[2]=PKW(P0,4), pw0[3]=PKW(P0,6), pw0); \
    VRD(1); SBAR(); GAPA(C0=__builtin_amdgcn_mfma_f32_32x32x16_bf16(kf[2],qr[1],C0,0,0,0),   P0[10],P0[11],P0[12],P0[13], pw1[0]=PKW(P0,8), pw1[1]=PKW(P0,10), pw1); \
    VRD(5); SBAR(); GAPA(C1=__builtin_amdgcn_mfma_f32_32x32x16_bf16(kf[3],qr[1],C1,0,0,0),   P0[14],P0[15],P1[0],P1[1],   pw1[2]=PKW(P0,12),pw1[3]=PKW(P0,14), pw1); \
    VRD(2); SBAR(); GAPA(C0=__builtin_amdgcn_mfma_f32_32x32x16_bf16(kf[4],qr[2],C0,0,0,0),   P1[2],P1[3],P1[4],P1[5],     pw2[0]=PKW(P1,0), pw2[1]=PKW(P1,2), pw2); \
    VRD(6); SBAR(); GAPA(C1=__builtin_amdgcn_mfma_f32_32x32x16_bf16(kf[5],qr[2],C1,0,0,0),   P1[6],P1[7],P1[8],P1[9],     pw2[2]=PKW(P1,4), pw2[3]=PKW(P1,6), pw2); \
    VRD(3); SBAR(); GAPA(C0=__builtin_amdgcn_mfma_f32_32x32x16_bf16(kf[6],qr[3],C0,0,0,0),   P1[10],P1[11],P1[12],P1[13], pw3[0]=PKW(P1,8), pw3[1]=PKW(P1,10), pw3); \
    VRD(7); SBAR(); GAPA(C1=__builtin_amdgcn_mfma_f32_32x32x16_bf16(kf[7],qr[3],C1,0,0,0),   P1[14],P1[15],0.f,0.f,       pw3[2]=PKW(P1,12),pw3[3]=PKW(P1,14), pw3); \
    l_reg+=sacc; \
    if(GK){DMA_K((t)+3,sl_cur);} if(GV){DMA_V((t)+1,sl_next);} \
    CMASK(C0,C1,t); \
    { float a=MX3(C0[0],C0[1],C1[0]),b=MX3(C0[2],C0[3],C1[1]); a=MX3(a,C1[2],C1[3]); \
      _Pragma("unroll") for(int r=4;r<16;r+=4){a=MX3(a,C0[r],C0[r+1]);b=MX3(b,C0[r+2],C0[r+3]);a=MX3(a,C1[r],C1[r+1]);b=MX3(b,C1[r+2],C1[r+3]);} \
      float rm=__builtin_fmaxf(a,b); { auto rr=__builtin_amdgcn_permlane32_swap(__float_as_uint(rm),__float_as_uint(rm),false,false); rm=__builtin_fmaxf(__uint_as_float(rr[0]),__uint_as_float(rr[1])); } \
      resc=false; \
      if(__builtin_expect(__any(rm>(float)THRL),0)){ const float dl=__builtin_fmaxf(rm,0.f); mhat+=dl; \
        _Pragma("unroll") for(int r=0;r<16;++r){C0[r]-=dl;C1[r]-=dl;} \
        const float f=__builtin_amdgcn_exp2f(-dl); l_reg*=f; if(hi==0)wsf[r32]=f; resc=true; } } \
    SBAR(); \
    GAPB(o[0]=__builtin_amdgcn_mfma_f32_32x32x16_bf16(PAF(0),VFR(0),o[0],0,0,0), C0,0); \
    GAPB(o[1]=__builtin_amdgcn_mfma_f32_32x32x16_bf16(PAF(0),VFR(4),o[1],0,0,0), C0,4); \
    KRD(GL,0); GAPB(o[0]=__builtin_amdgcn_mfma_f32_32x32x16_bf16(PAF(1),VFR(1),o[0],0,0,0), C0,8); \
    KRD(GL,1); GAPB(o[1]=__builtin_amdgcn_mfma_f32_32x32x16_bf16(PAF(1),VFR(5),o[1],0,0,0), C0,12); \
    KRD(GL,2); GAPB(o[0]=__builtin_amdgcn_mfma_f32_32x32x16_bf16(PAF(2),VFR(2),o[0],0,0,0), C1,0); \
    KRD(GL,3); GAPB(o[1]=__builtin_amdgcn_mfma_f32_32x32x16_bf16(PAF(2),VFR(6),o[1],0,0,0), C1,4); \
    GAPB(o[0]=__builtin_amdgcn_mfma_f32_32x32x16_bf16(PAF(3),VFR(3),o[0],0,0,0), C1,8); \
    GAPB(o[1]=__builtin_amdgcn_mfma_f32_32x32x16_bf16(PAF(3),VFR(7),o[1],0,0,0), C1,12); \
    }while(0)
  int t=1;
  #undef CMASK
  #define CMASK(P0,P1,t) do{}while(0)
  for(;t+5<NT;t+=2){
    STEP(pB0,pB1,pA0,pA1,t,true,true,true);     WAIT_BAR(2); RESC(); ROT();
    STEP(pA0,pA1,pB0,pB1,t+1,true,true,true);   WAIT_BAR(2); RESC(); ROT();
  }
  #undef CMASK
  #define CMASK(P0,P1,t) do{int jb_=(t)-(NT-4); if(jb_>=0)cmask(P0,P1,jb_,qrel,hi);}while(0)
  #define ENDW(tt) do{ if((tt)+3<NT){WAIT_BAR(2);} else if((tt)+2<NT){WAIT_BAR(1);} else {WAIT_BAR(0);} }while(0)
  for(;t+1<NT;t+=2){
    STEP(pB0,pB1,pA0,pA1,t,(t+3<NT),(t+1<NT),(t+1<NT));       ENDW(t);   RESC(); ROT();
    STEP(pA0,pA1,pB0,pB1,t+1,(t+4<NT),(t+2<NT),(t+2<NT));     ENDW(t+1); RESC(); ROT();
  }
  STEP(pB0,pB1,pA0,pA1,NT-1,false,false,false); RESC();
  { float sacc=pB0[0]+pB0[1]; _Pragma("unroll") for(int r=2;r<16;++r)sacc+=pB0[r]; _Pragma("unroll") for(int r=0;r<16;++r)sacc+=pB1[r]; l_reg+=sacc;
    pw0=(u32x4){PKW(pB0,0),PKW(pB0,2),PKW(pB0,4),PKW(pB0,6)};pw1=(u32x4){PKW(pB0,8),PKW(pB0,10),PKW(pB0,12),PKW(pB0,14)};pw2=(u32x4){PKW(pB1,0),PKW(pB1,2),PKW(pB1,4),PKW(pB1,6)};pw3=(u32x4){PKW(pB1,8),PKW(pB1,10),PKW(pB1,12),PKW(pB1,14)};
    SBAR(); pv(o,(int)(uintptr_t)vp0+sl_cur,PAF(0),PAF(1),PAF(2),PAF(3)); }
  #undef PKW
  #undef PAF
  #undef VFR
  #undef PIN
  #undef MX3
  #undef GAPA
  #undef GAPB
  #undef EX
  #undef VRD
  #undef KRD
  #undef STEP
  #undef ENDW
  {auto rr=__builtin_amdgcn_permlane32_swap(__float_as_uint(l_reg),__float_as_uint(l_reg),false,false);l_reg=__uint_as_float(rr[0])+__uint_as_float(rr[1]);}
  if(hi==0)wsf[32+r32]=l_reg;asm volatile("s_waitcnt lgkmcnt(0)":::"memory");
  float rli[16];
  #pragma unroll
  for(int r=0;r<16;++r)rli[r]=__builtin_amdgcn_rcpf(wsf[32+crow(r,hi)]);
  bf16*Ow=O+(rowbase+q0+wid*QBLK)*OP+h*D; float*Sw=SSQ+(rowbase+q0+wid*QBLK)*8+h;
  { bf16*stg=(bf16*)(shm+LDS_OST)+wid*2048;
    #pragma unroll
    for(int r=0;r<16;++r){const int orow=crow(r,hi);
      #pragma unroll
      for(int d0=0;d0<2;++d0)stg[orow*64+d0*32+r32]=__float2bfloat16(o[d0][r]*rli[r]);}
    asm volatile("s_waitcnt lgkmcnt(0)":::"memory");
    #pragma unroll
    for(int i=0;i<4;++i){const int row=i*8+(lane>>3),ch=lane&7; const u32x4 v=*(const u32x4*)(stg+row*64+ch*8); ATTN_STORE16(Ow+(long)row*OP+ch*8,v);
      float sq=0.f; _Pragma("unroll") for(int k_=0;k_<4;++k_){ const float a_=__uint_as_float(v[k_]<<16), b_=__uint_as_float(v[k_]&0xffff0000u); sq+=a_*a_+b_*b_; }
      sq+=__shfl_xor(sq,1); sq+=__shfl_xor(sq,2); sq+=__shfl_xor(sq,4); if(ch==0)Sw[(long)row*8]=sq; } }
  asm volatile("s_waitcnt lgkmcnt(0)\n\ts_barrier":::"memory");
  #undef DMA_K
  #undef DMA_V
  #undef CMASK
  #undef CINIT
  #undef START
  #undef RESC
  #undef ROT
}
constexpr int ATTN_LDS_BYTES=LDS_BYTES;
#undef SBAR
#undef WAIT_BAR
}

__device__ __forceinline__ void attn_fast(Frame& F) {
    F.refresh();
    const attn_body::bf16* Q = (const attn_body::bf16*)(F.ws + WS_QKVUV); const attn_body::bf16* Kb = Q + (size_t)M * 512; const attn_body::bf16* Vb = Kb + (size_t)M * 512;
    attn_body::bf16* O = (attn_body::bf16*)(F.ws + WS_MG); float* SSQ = (float*)(F.ws + WS_SSQA); const float* logf = (const float*)(F.ws + WS_LOGF);
    LAS float* bias = (LAS float*)(F.lds + attn_body::LDS_BIAS); LAS float* wsum = (LAS float*)(F.lds + attn_body::LDS_WS);
    for (int it = 0;; ++it) {
        const int pr = F.vcu + (it >> 1) * F.G; if (pr >= NB * NH * 4) break;
        const int bh = pr >> 2, sidx = pr & 3;
        if (!(it & 1)) {
            const f32x4 v = *(const f32x4*)(logf + (size_t)bh * SEQ + 4 * F.tid);
            const float a0 = v.x, a1 = a0 + v.y, a2 = a1 + v.z, a3 = a2 + v.w; float run = a3;
#pragma unroll
            for (int o = 1; o < 64; o <<= 1) { const float t = __shfl_up(run, o); if (F.lane >= o) run += t; }
            if (F.lane == 63) wsum[F.wave] = run;
            __syncthreads();
            float base = run - a3;
#pragma unroll
            for (int w = 0; w < 8; ++w) if (w < F.wave) base += wsum[w];
            *(LAS f32x4*)(bias + 4 * F.tid) = (f32x4){-(base + a0) * LOG2E, -(base + a1) * LOG2E, -(base + a2) * LOG2E, -(base + a3) * LOG2E};
            __syncthreads();
        }
        attn_body::attn_unit<8>(bh / NH, bh % NH, (it & 1) ? 7 - sidx : sidx, Q, Kb, Vb, O, SSQ, (char*)F.lds, F.wave);
    }
}
typedef float f32x16 __attribute__((ext_vector_type(16)));
__device__ __forceinline__ void sgu_fast(Frame& F, int l) {
    const bf16* U = (const bf16*)(F.ws + WS_QKVUV) + (size_t)3 * M * 512; const bf16* SV = U + (size_t)M * 512;
    bf16* MG = (bf16*)(F.ws + WS_MG); float* ssq = (float*)(F.ws + WS_SSQS);
    LAS float* st = (LAS float*)F.lds;
    LAS unsigned char* vnT = F.lds + 1024;
    const float* gv = F.in[I_GV] + l * AW;
    F.refresh();
    const int lane = F.lane, wave = F.wave, r32 = lane & 31, hi = lane >> 5, gl = wave >> 1, dh = wave & 1;
    for (int un = F.vcu; un < NB * 16 * 2; un += F.G) {
        const int gh = un & 1, ch = (un >> 1) & 15, b = un >> 5; const size_t rb = (size_t)b * SEQ + ch * 128;
        __syncthreads();
        for (int r = wave * 16; r < wave * 16 + 16; ++r) {
            const u32x4 w = *((const u32x4*)(SV + (rb + r) * 512) + lane); float x[8];
#pragma unroll
            for (int k = 0; k < 4; ++k) { x[2 * k] = __uint_as_float(w[k] << 16); x[2 * k + 1] = __uint_as_float(w[k] & 0xffff0000u); }
            float sm = 0.f;
#pragma unroll
            for (int k = 0; k < 8; ++k) sm += x[k];
            const float mean = wave_sum(sm) * (1.f / 512.f); float q = 0.f;
#pragma unroll
            for (int k = 0; k < 8; ++k) { const float d = x[k] - mean; q += d * d; }
            const float rstd = 1.0f / sqrtf(wave_sum(q) * (1.f / 512.f) + EPS);
            if (lane == 0) { st[2 * r] = mean; st[2 * r + 1] = rstd; }
        }
        __syncthreads();
#pragma unroll
        for (int k = 0; k < 4; ++k) {
            const int c = wave + 8 * k, s0 = 2 * lane; const int col = gh * 256 + 8 * c;
            const u32x4 w0 = *(const u32x4*)(SV + (rb + s0) * 512 + col), w1 = *(const u32x4*)(SV + (rb + s0 + 1) * 512 + col);
            const f32x4 g0 = *(const f32x4*)(gv + col), g1 = *(const f32x4*)(gv + col + 4);
            const float m0 = st[2 * s0], r0 = st[2 * s0 + 1], m1 = st[2 * s0 + 2], r1 = st[2 * s0 + 3];
#pragma unroll
            for (int j = 0; j < 8; ++j) { const float gj = j < 4 ? g0[j] : g1[j - 4];
                const float x0 = (j & 1) ? __uint_as_float(w0[j >> 1] & 0xffff0000u) : __uint_as_float(w0[j >> 1] << 16);
                const float x1 = (j & 1) ? __uint_as_float(w1[j >> 1] & 0xffff0000u) : __uint_as_float(w1[j >> 1] << 16);
                *(LAS unsigned*)(vnT + (size_t)(8 * c + j) * 272 + 2 * s0) = pk2((x0 - m0) * r0 * gj, (x1 - m1) * r1 * gj); }
        }
        __syncthreads();
        const int g = gh * 4 + gl;
        f32x16 acc[4];
#pragma unroll
        for (int tt = 0; tt < 4; ++tt) acc[tt] = (f32x16){};
        const float* Wg = F.in[I_WSP] + ((size_t)l * 8 + g) * 128 * 128;
#pragma unroll
        for (int kk = 0; kk < 8; ++kk) {
            const bf16x8 bfrag = *(const LAS bf16x8*)(vnT + (size_t)(gl * 64 + dh * 32 + r32) * 272 + (16 * kk + 8 * hi) * 2);
#pragma unroll
            for (int tt = 0; tt < 4; ++tt) if (kk < 2 * (tt + 1)) {
                const int t = 32 * tt + r32, s0 = 16 * kk + 8 * hi;
                const f32x4 w0 = *(const f32x4*)(Wg + t * 128 + s0), w1 = *(const f32x4*)(Wg + t * 128 + s0 + 4);
                float wv[8] = {w0[0], w0[1], w0[2], w0[3], w1[0], w1[1], w1[2], w1[3]};
#pragma unroll
                for (int j = 0; j < 8; ++j) if (s0 + j > t) wv[j] = 0.f;
                u32x4 pa; pa.x = pk2(wv[0], wv[1]); pa.y = pk2(wv[2], wv[3]); pa.z = pk2(wv[4], wv[5]); pa.w = pk2(wv[6], wv[7]);
                acc[tt] = __builtin_amdgcn_mfma_f32_32x32x16_bf16(__builtin_bit_cast(bf16x8, pa), bfrag, acc[tt], 0, 0, 0);
            }
        }
        __syncthreads();
        LAS float* stg = (LAS float*)(vnT + wave * 8192);
        const float* bsp = F.in[I_BSP] + ((size_t)l * 8 + g) * 128;
#pragma unroll
        for (int rnd = 0; rnd < 2; ++rnd) {
#pragma unroll
            for (int t2 = 0; t2 < 2; ++t2)
#pragma unroll
                for (int r = 0; r < 16; ++r) stg[(t2 * 32 + (r & 3) + 8 * (r >> 2) + 4 * hi) * 32 + r32] = acc[2 * rnd + t2][r];
            asm volatile("s_waitcnt lgkmcnt(0)" ::: "memory");
#pragma unroll
            for (int k = 0; k < 4; ++k) {
                const int row = (lane >> 2) + 16 * k, c4 = lane & 3, t = 64 * rnd + row;
                const f32x4 m0 = *(const LAS f32x4*)(stg + row * 32 + 8 * c4), m1 = *(const LAS f32x4*)(stg + row * 32 + 8 * c4 + 4);
                const int col = g * 64 + dh * 32 + 8 * c4; const float bs = bsp[t];
                const u32x4 uw = *(const u32x4*)(U + (rb + t) * 512 + col);
                float o[8]; float sq = 0.f;
#pragma unroll
                for (int j = 0; j < 8; ++j) { const float uu = (j & 1) ? __uint_as_float(uw[j >> 1] & 0xffff0000u) : __uint_as_float(uw[j >> 1] << 16);
                    o[j] = uu * ((j < 4 ? m0[j] : m1[j - 4]) + bs); sq += o[j] * o[j]; }
                store8_bf16(MG + (rb + t) * DM + AW + col, o);
                sq += __shfl_xor(sq, 1); sq += __shfl_xor(sq, 2);
                if (c4 == 0) ssq[(rb + t) * 16 + g * 2 + dh] = sq;
            }
            asm volatile("s_waitcnt lgkmcnt(0)" ::: "memory");
        }
    }
    __syncthreads();
}
#define XB_TMO      128
#define XB_XCNT(j)  (256  + 64 * (j))
#define XB_XSUB(j)  (1280 + 64 * (j))
#define XB_XGEN(j)  (2304 + 64 * (j))
#define XB_TOP      3328
#define XB_TOPGEN   3392
#define XCD_BAR_WORDS 3456
#define XB_SPIN_CAP (1u << 18)

__device__ __forceinline__ unsigned xb_ld(unsigned* p)              { return __hip_atomic_load(p, __ATOMIC_RELAXED, __HIP_MEMORY_SCOPE_AGENT); }
__device__ __forceinline__ unsigned xb_add(unsigned* p, unsigned v) { return __hip_atomic_fetch_add(p, v, __ATOMIC_RELAXED, __HIP_MEMORY_SCOPE_AGENT); }
__device__ __forceinline__ unsigned xb_xcc_id() { return (unsigned)__builtin_amdgcn_s_getreg((3 << 11) | 20) & 0xFu; }
#define XB_SPIN(cond, bar) do { unsigned _sp = 0; while (cond) { __builtin_amdgcn_s_sleep(1); \
    if ((++_sp & 255u) == 0u) { if (xb_ld(&(bar)[XB_TMO])) break; if (_sp > XB_SPIN_CAP) { atomicAdd(&(bar)[XB_TMO], 1u); break; } } } } while (0)

struct XcdBarrier {
    unsigned* bar; unsigned x;
    volatile LAS unsigned* st;
};

__device__ __forceinline__ XcdBarrier xcd_barrier_post(unsigned* bar, volatile LAS unsigned* st, const bool leader) {
    XcdBarrier b; b.bar = bar; b.x = xb_xcc_id(); b.st = st;
    if (leader) (void)xb_add(&bar[XB_XCNT(b.x)], 1u);
    return b;
}
__device__ __forceinline__ void xcd_barrier_complete(unsigned* bar, unsigned x, unsigned& nloc, unsigned& nx) {
    const unsigned G = gridDim.x * gridDim.y * gridDim.z;
    unsigned sum, cnt, mine, sp = 0u;
    for (;;) {
        sum = 0u; cnt = 0u; mine = 0u;
#pragma unroll
        for (unsigned j = 0; j < 16; ++j) { const unsigned c = xb_ld(&bar[XB_XCNT(j)]); sum += c; cnt += (c > 0u) ? 1u : 0u; mine = (j == x) ? c : mine; }
        if (sum == G) break;
        __builtin_amdgcn_s_sleep(1);
        if ((++sp & 255u) == 0u) { if (xb_ld(&bar[XB_TMO])) break; if (sp > XB_SPIN_CAP) { atomicAdd(&bar[XB_TMO], 1u); break; } }
    }
    nloc = mine > 0u ? mine : 1u; nx = cnt > 0u ? cnt : 1u;
}

__device__ __forceinline__ void xcd_barrier(const XcdBarrier& b, const bool leader) {
    asm volatile("s_waitcnt vmcnt(0)" ::: "memory");
    __syncthreads();
    if (leader) {
        unsigned* bar = b.bar;
        __builtin_amdgcn_s_waitcnt(0);
        unsigned nloc = b.st[0], nx = b.st[1];
        if (nloc == 0u) { xcd_barrier_complete(bar, b.x, nloc, nx); b.st[0] = nloc; b.st[1] = nx; }
        const unsigned old = xb_add(&bar[XB_XSUB(b.x)], 1u);
        const unsigned gen = old / nloc;
        if (old + 1u == (gen + 1u) * nloc) {
            __builtin_amdgcn_fence(__ATOMIC_RELEASE, "agent");
            asm volatile("s_waitcnt vmcnt(0)" ::: "memory");
            const unsigned og = xb_add(&bar[XB_TOP], 1u);
            const unsigned tg = og / nx;
            if (og + 1u == (tg + 1u) * nx) xb_add(&bar[XB_TOPGEN], 1u);
            else XB_SPIN(xb_ld(&bar[XB_TOPGEN]) == tg, bar);
            __builtin_amdgcn_fence(__ATOMIC_ACQUIRE, "agent");
            xb_add(&bar[XB_XGEN(b.x)], 1u);
            asm volatile("s_waitcnt vmcnt(0)" ::: "memory");
        } else {
            XB_SPIN(xb_ld(&bar[XB_XGEN(b.x)]) == gen, bar);
            __builtin_amdgcn_fence(__ATOMIC_ACQUIRE, "agent");
            asm volatile("s_waitcnt vmcnt(0)" ::: "memory");
        }
    }
    __syncthreads();
}

template <int L> __device__ __forceinline__ void layer_phases(Frame& F, const int lo, const int hi, const XcdBarrier& bar) {
#define IN(k) (lo <= (k) && (k) < hi)
#define SEAM(k) do { if (IN(k) && IN((k) + 1)) { xcd_barrier(bar, F.wave == 0 && fresh_lane() == 0); } } while (0)

        constexpr int l = L, pb = 2 + 9 * L; constexpr bool moe = (L & 1) != 0;
        if (IN(pb + 0)) {
            StaticOrder S; S.init(M, NIN, F.G, (int)blockIdx.x, DM); EpiInproj E{(bf16*)(F.ws + WS_QKVUV)};
            gemm_run<FAST_INPROJ>(F, (const bf16*)(F.ws + WS_H), (const bf16*)(F.ws + WS_WIN) + (size_t)l * NIN * DM, DM, S, E);
        }
        SEAM(pb + 0);
        if (IN(pb + 1)) {
#if FAST_ATTN
            attn_fast(F);
#else
            attn_simple(F);
#endif
#if FAST_SGU
            sgu_fast(F, l);
#else
            sgu_simple(F, l);
#endif
        }
        SEAM(pb + 1);
        if (IN(pb + 2)) phase_merge_norm(F);
        SEAM(pb + 2);
        if (IN(pb + 3)) {
            StaticOrder S; S.init(M, DM, F.G, (int)blockIdx.x, DM); EpiF32 E{(float*)(F.ws + WS_Y), DM, 4, nullptr};
            gemm_run<FAST_OUTPROJ>(F, (const bf16*)(F.ws + WS_MG2), (const bf16*)(F.ws + WS_WOUT) + (size_t)l * DM * DM, DM, S, E);
        }
        SEAM(pb + 3);
        if (IN(pb + 4)) phase_postmix(F, l, l == 0 ? F.in[I_X] : F.out, moe);
        if (moe) { SEAM(pb + 4); if (IN(pb + 5)) phase_scatter(F); SEAM(pb + 5); }
        else { if (IN(pb + 4) && IN(pb + 6)) xcd_barrier(bar, F.wave == 0 && fresh_lane() == 0); }
        if (IN(pb + 6)) {
            if (!moe) { StaticOrder S; S.init(M, 2 * DFF, F.G, (int)blockIdx.x, DM); EpiSwiglu E{(bf16*)(F.ws + WS_ACT), DFF, 2 * DFF / 256};
                gemm_run<FAST_FFN1D>(F, (const bf16*)(F.ws + WS_H), (const bf16*)(F.ws + WS_WGU), DM, S, E); }
            else { MoeOrder S; S.init(F.ctl + CW_CNT, 2 * EFF / 256, F.G, (int)blockIdx.x, DM, false); EpiSwiglu E{(bf16*)(F.ws + WS_ACT), EFF, 2 * EFF / 256};
                gemm_run<FAST_FFN1E>(F, (const bf16*)(F.ws + WS_HS), (const bf16*)(F.ws + WS_EGU), DM, S, E); }
        }
        SEAM(pb + 6);
        if (IN(pb + 7)) {
            if (!moe) { StaticOrder S; S.init(M, DM, F.G, (int)blockIdx.x, DFF); EpiF32 E{(float*)(F.ws + WS_Y), DM, 4, nullptr};
                gemm_run<FAST_FFN2D>(F, (const bf16*)(F.ws + WS_ACT), (const bf16*)(F.ws + WS_WD), DFF, S, E); }
            else { MoeOrder S; S.init(F.ctl + CW_CNT, DM / 256, F.G, (int)blockIdx.x, EFF, true); EpiF32 E{(float*)(F.ws + WS_YS), DM, 4, (float*)(F.ws + WS_PART)};
                gemm_run<FAST_FFN2E, true>(F, (const bf16*)(F.ws + WS_ACT), (const bf16*)(F.ws + WS_ED), EFF, S, E); }
        }
        SEAM(pb + 7);
        if (IN(pb + 8)) phase_final(F, l, moe);
        SEAM(pb + 8);
#undef SEAM
#undef IN
}
struct Args { const float* in[21]; float* out; unsigned char* ws; int ph_lo, ph_hi, li, pad; };
constexpr int NPHASES = 20;
__global__ void __launch_bounds__(NTHREADS, 2) fwd(Args args) {
    extern __shared__ __attribute__((aligned(16))) unsigned char lds[];
    Frame F;
    F.lds = (LAS unsigned char*)lds; F.wave = __builtin_amdgcn_readfirstlane((int)threadIdx.x >> 6); F.refresh();
    F.G = gridDim.x; { const int bx = blockIdx.x; F.vcu = (F.G % 8 == 0) ? (bx % 8) * (F.G / 8) + bx / 8 : bx; }
    F.ws = args.ws; F.ctl = (unsigned*)(args.ws + WS_CTL); F.out = args.out;
#pragma unroll
    for (int i = 0; i < 21; ++i) F.in[i] = args.in[i];
    const int lo = args.ph_lo, hi = args.ph_hi;
    volatile LAS unsigned* MISC = (volatile LAS unsigned*)(F.lds + MISC_OFF);
    if (F.tid < 32) MISC[F.tid] = 0u;
    __syncthreads();
    const XcdBarrier bar = xcd_barrier_post(F.ctl + CW_BAR + args.li * XCD_BAR_WORDS, MISC + 8, F.tid == 0);
#define IN(k) (lo <= (k) && (k) < hi)
    if (IN(0)) p0_prologue(F);
    if (IN(0) && IN(1)) xcd_barrier(bar, F.wave == 0 && fresh_lane() == 0);
    if (IN(1)) phase_premix(F, 0, F.in[I_X]);
    if (IN(1) && IN(2)) xcd_barrier(bar, F.wave == 0 && fresh_lane() == 0);
    layer_phases<0>(F, lo, hi, bar);
    layer_phases<1>(F, lo, hi, bar);
#undef IN
}

extern "C" void kernel_launch(void* const* d_in, const int* in_sizes, int n_in, void* d_out, int out_size, void* d_ws, size_t ws_size, hipStream_t stream) {
    static int grid = 0;
    if (grid == 0) {
        if (n_in != 21 || out_size != M * DM || ws_size < WS_END) { fprintf(stderr, "kernel_launch: unexpected problem (n_in %d out %d ws %zu)\n", n_in, out_size, ws_size); grid = -1; return; }
        int dev = 0, cus = 0;
        if (hipGetDevice(&dev) != hipSuccess || hipDeviceGetAttribute(&cus, hipDeviceAttributeMultiprocessorCount, dev) != hipSuccess) { grid = -1; return; }
        if (hipFuncSetAttribute((const void*)fwd, hipFuncAttributeMaxDynamicSharedMemorySize, LDS_BYTES) != hipSuccess) { grid = -1; return; }
        grid = cus;
    }
    if (grid < 0) return;
    (void)hipMemsetAsync((char*)d_ws + WS_CTL, 0, CTL_ZERO_BYTES, stream);
    Args a{};
    for (int i = 0; i < 21; ++i) a.in[i] = (const float*)d_in[i];
    a.out = (float*)d_out; a.ws = (unsigned char*)d_ws;
#ifndef N_LAUNCH
#define N_LAUNCH 1
#endif
#if N_LAUNCH == 1
    a.ph_lo = 0; a.ph_hi = NPHASES; a.li = 0;
    hipLaunchKernelGGL(fwd, dim3(grid), dim3(NTHREADS), LDS_BYTES, stream, a);
#else
    for (int p = 0; p < NPHASES; ++p) {
        if (p == 2 + 5) continue;
        a.ph_lo = p; a.ph_hi = p + 1; a.li = 0;
        hipLaunchKernelGGL(fwd, dim3(grid), dim3(NTHREADS), LDS_BYTES, stream, a);
    }
#endif
}
```

```cpp
#include <hip/hip_runtime.h>
#include <cstdio>
#include <cstdint>

#define GAS __attribute__((address_space(1)))
#define LAS __attribute__((address_space(3)))
typedef unsigned short bf16;
typedef float f32x4 __attribute__((ext_vector_type(4)));
typedef float f32x2 __attribute__((ext_vector_type(2)));
typedef unsigned u32x4 __attribute__((ext_vector_type(4)));
typedef unsigned u32x2 __attribute__((ext_vector_type(2)));
typedef unsigned long long u64;

constexpr int NB = 8, SEQ = 2048, DM = 1024, M = NB * SEQ, NL = 2;
constexpr int AW = 512, NH = 8, HD = 64, NIN = 2560, INC = 2568, DFF = 2816, EFF = 3584, NE = 8, NMOD = 6;
constexpr int CAPROWS = 2 * M + NE * 256;
constexpr float EPS = 1e-6f;
constexpr float LOG2E = 1.4426950408889634f;
constexpr float C2 = 0.125f * LOG2E;
constexpr int NWAVES = 8, NTHREADS = 512;

constexpr size_t MiB = 1u << 20;
constexpr size_t WS_CTL = 0, CTL_ZERO_BYTES = 64 * 1024;
constexpr size_t WS_MOD = 1 * MiB;
constexpr size_t WS_WF = 1 * MiB + 512 * 1024;
constexpr size_t WS_WR = WS_WF + 64 * 1024;
constexpr size_t WS_LOGF = 2 * MiB;
constexpr size_t WS_SSQA = 2 * MiB + 512 * 1024;
constexpr size_t WS_SSQS = 3 * MiB;
constexpr size_t WS_TOK = 512 * 1024;
constexpr size_t WS_WIN = 4 * MiB;
constexpr size_t WS_WOUT = 14 * MiB;
constexpr size_t WS_WGU = 18 * MiB;
constexpr size_t WS_WD = 29 * MiB;
constexpr size_t WS_EGU = 35 * MiB;
constexpr size_t WS_ED = 147 * MiB;
constexpr size_t WS_PART = WS_EGU;
constexpr size_t WS_H = 203 * MiB;
constexpr size_t WS_QKVUV = 235 * MiB;
constexpr size_t WS_MG = 315 * MiB;
constexpr size_t WS_Y = 347 * MiB;
constexpr size_t WS_YS = WS_QKVUV;
constexpr size_t WS_ACT = 411 * MiB;
constexpr size_t WS_HS = 649 * MiB;
constexpr size_t WS_MG2 = WS_HS;
constexpr size_t WS_END = 717 * MiB;
static_assert(WS_YS + (size_t)CAPROWS * DM * 4 <= WS_ACT && WS_ACT + (size_t)CAPROWS * EFF * 2 <= WS_HS && WS_HS + (size_t)CAPROWS * DM * 2 <= WS_END, "ws map");
constexpr int CW_TMO = 0, CW_CODE = 1, CW_BAR = 4096, CW_CNT = 8192;

constexpr int RING_BYTES = 131072, MISC_OFF = RING_BYTES + 320, LDS_BYTES = 147456;

__device__ __forceinline__ float bf2f(bf16 v) { return __uint_as_float((unsigned)v << 16); }
__device__ __forceinline__ unsigned f2bf(float f) { unsigned u = __float_as_uint(f); return (u + 0x7fffu + ((u >> 16) & 1u)) >> 16; }
typedef __bf16 bf16x2_t __attribute__((ext_vector_type(2)));
__device__ __forceinline__ unsigned pk2(float lo, float hi) { const f32x2 v = {lo, hi}; return __builtin_bit_cast(unsigned, __builtin_convertvector(v, bf16x2_t)); }
__device__ __forceinline__ float wave_sum(float v) {
#pragma unroll
    for (int o = 1; o < 64; o <<= 1) v += __shfl_xor(v, o);
    return v;
}
__device__ __forceinline__ float gelu_tanh(float x) {
    const float u = x * (-2.f * 0.7978845608028654f * LOG2E) * (1.f + 0.044715f * x * x);
    return x * __builtin_amdgcn_rcpf(1.f + __builtin_amdgcn_exp2f(u));
}
__device__ __forceinline__ float silu_f(float x) { return x * __builtin_amdgcn_rcpf(1.f + __builtin_amdgcn_exp2f(-LOG2E * x)); }
__device__ __forceinline__ float dot4(f32x4 a, f32x4 b) { return (a.x * b.x + a.y * b.y) + (a.z * b.z + a.w * b.w); }
__device__ __forceinline__ void store8_bf16(bf16* p, const float (&v)[8]) {
    u32x4 w; w.x = pk2(v[0], v[1]); w.y = pk2(v[2], v[3]); w.z = pk2(v[4], v[5]); w.w = pk2(v[6], v[7]); *(u32x4*)p = w;
}
__device__ __forceinline__ void store8_f32(float* p, const float (&v)[8]) {
    *(f32x4*)p = (f32x4){v[0], v[1], v[2], v[3]}; *(f32x4*)(p + 4) = (f32x4){v[4], v[5], v[6], v[7]};
}

__device__ __forceinline__ int fresh_lane() { int l; asm volatile("v_mbcnt_lo_u32_b32 %0, -1, 0\n\tv_mbcnt_hi_u32_b32 %0, -1, %0" : "=v"(l)); return l; }
struct Frame {
    LAS unsigned char* lds;
    unsigned* ctl;
    int tid, lane, wave, vcu, G;
    __device__ __forceinline__ void refresh() { lane = fresh_lane(); tid = wave * 64 + lane; }
    unsigned char* ws;
    const float* in[21];
    float* out;
};
enum { I_X = 0, I_C, I_WADA, I_BADA, I_GPREMIX, I_GPOSTMIX, I_GPREFFN, I_GPOSTFFN, I_WIN, I_BFORGET, I_GV, I_WSP, I_BSP, I_GOA, I_GOS, I_WOUT, I_WGUD, I_WDD, I_WROUTER, I_WGUE, I_WDE };

struct Unit { int pm, pn, kt0, nkt, part; };
struct StaticOrder {
    int nM, nN, nwg, G, c, nkt;
    __device__ void init(int M_, int N_, int G_, int c_, int K_) { nM = M_ / 256; nN = N_ / 256; nwg = nM * nN; G = G_; c = c_; nkt = K_ / 64; }
    __device__ bool next(int i, Unit& u) const {
        const long L = (long)i * G + c; if (L >= nwg) return false;
        int wgid = (int)L; { const int q = nwg / 8, r = nwg % 8, xcd = wgid % 8, off = wgid / 8; wgid = (xcd < r ? xcd * (q + 1) : r * (q + 1) + (xcd - r) * q) + off; }
        const int nig = 8 * nN, gid = wgid / nig, fm = gid * 8, gsz = (nM - fm) < 8 ? (nM - fm) : 8;
        u.pm = fm + ((wgid % nig) % gsz); u.pn = (wgid % nig) / gsz; u.kt0 = 0; u.nkt = nkt; u.part = -1; return true;
    }
    __device__ __forceinline__ void a_ready(const Unit&) const {}
    __device__ __forceinline__ void done(const Unit&) const {}
};
struct MoeLayout {
    int P1, P2, P3, P4, P5, P6, P7, P8;
    __device__ void init(const unsigned* cnt) {
        int c0 = (int)cnt[0], c1 = (int)cnt[64], c2 = (int)cnt[128], c3 = (int)cnt[192], c4 = (int)cnt[256], c5 = (int)cnt[320], c6 = (int)cnt[384], c7 = (int)cnt[448];
        P1 = (c0 + 255) >> 8; P2 = P1 + ((c1 + 255) >> 8); P3 = P2 + ((c2 + 255) >> 8); P4 = P3 + ((c3 + 255) >> 8);
        P5 = P4 + ((c4 + 255) >> 8); P6 = P5 + ((c5 + 255) >> 8); P7 = P6 + ((c6 + 255) >> 8); P8 = P7 + ((c7 + 255) >> 8);
        if (P8 > CAPROWS / 256) P8 = CAPROWS / 256;
    }
    __device__ __forceinline__ int expert_of_panel(int p) const { return (p >= P1) + (p >= P2) + (p >= P3) + (p >= P4) + (p >= P5) + (p >= P6) + (p >= P7); }
    __device__ __forceinline__ int panel_base(int e) const { int b = 0; b = e == 1 ? P1 : b; b = e == 2 ? P2 : b; b = e == 3 ? P3 : b; b = e == 4 ? P4 : b; b = e == 5 ? P5 : b; b = e == 6 ? P6 : b; b = e == 7 ? P7 : b; return b; }
};
struct MoeOrder {
    MoeLayout Lay; int NT, G, c, nkt, U, R, Lf, sp, q0, r0;
    __device__ void init(const unsigned* cnt, int NT_, int G_, int c_, int K_, bool split) {
        Lay.init(cnt); NT = NT_; G = G_; c = c_; nkt = K_ / 64; U = Lay.P8 * NT; R = U / G; Lf = U - R * G; sp = 1; q0 = U / 8; r0 = U % 8;
        if (split && (nkt % 28) == 0) { if (Lf * 2 <= G) sp = 2; if (Lf * 4 <= G) sp = 4; if (Lf * 7 <= G) sp = 7; if (Lf * 14 <= G) sp = 14; }
    }
    __device__ __forceinline__ int remap(int L) const { const int x = L & 7, off = L >> 3; return (x < r0 ? x * (q0 + 1) : r0 * (q0 + 1) + (x - r0) * q0) + off; }
    __device__ __forceinline__ int unmap(int W) const { const int t = W - r0 * (q0 + 1); return t < 0 ? (W % (q0 + 1)) * 8 + W / (q0 + 1) : (t % q0) * 8 + r0 + t / q0; }
    __device__ __forceinline__ void decode(int Lin, Unit& u) const {
        const int L = remap(Lin); const int TP = Lay.P8, nig = 8 * NT, gid = L / nig, fm = gid * 8, gsz = (TP - fm) < 8 ? (TP - fm) : 8, r = L % nig;
        const int p = fm + r % gsz, j = r / gsz;
        u.pm = p; u.pn = Lay.expert_of_panel(p) * NT + j;
    }
    __device__ __forceinline__ int unit_index(int p, int j) const {
        const int TP = Lay.P8, gid = p >> 3, fm = gid * 8, gsz = (TP - fm) < 8 ? (TP - fm) : 8;
        return unmap(gid * 8 * NT + j * gsz + (p - fm));
    }
    __device__ bool next(int i, Unit& u) const {
        if (i < R) { decode(i * G + c, u); u.kt0 = 0; u.nkt = nkt; u.part = -1; return true; }
        if (i == R && c < Lf * sp) { const int q = c % Lf, sl = c / Lf; decode(R * G + q, u); u.nkt = nkt / sp; u.kt0 = sl * u.nkt; u.part = sp > 1 ? q * 14 + sl : -1; return true; }
        return false;
    }
    __device__ __forceinline__ void a_ready(const Unit&) const {}
    __device__ __forceinline__ void done(const Unit&) const {}
};

struct EpiInproj {
    bf16* base;
    __device__ __forceinline__ void pair8(const Unit& u, int row, int c, const float (&lo)[8], const float (&hi)[8]) const {
        const int t = u.pn >> 1; bf16* dst = base + (size_t)t * M * 512 + (size_t)row * 512 + (u.pn & 1) * 256 + c;
        float a[8], b[8];
#pragma unroll
        for (int i = 0; i < 8; ++i) { float x = lo[i], y = hi[i]; if (t == 0) { x *= C2; y *= C2; } else if (t >= 3) { x = gelu_tanh(x); y = gelu_tanh(y); } a[i] = x; b[i] = y; }
        store8_bf16(dst, a); store8_bf16(dst + 128, b);
    }
};
struct EpiF32 {
    float* O; int ldc, ntn; float* part;
    __device__ __forceinline__ void pair8(const Unit& u, int row, int c, const float (&lo)[8], const float (&hi)[8]) const {
        const bool sp = u.part >= 0; const int ld = sp ? 256 : ldc;
        float* base = sp ? part + (long)(u.part - u.pm) * 65536 : O + (u.pn % ntn) * 256;
        float* dst = base + (size_t)row * ld + c; store8_f32(dst, lo); store8_f32(dst + 128, hi);
    }
};
struct EpiYbf16 {
    bf16* O;
    __device__ __forceinline__ void pair8(const Unit& u, int row, int c, const float (&lo)[8], const float (&hi)[8]) const {
        bf16* dst = O + (size_t)row * DM + (u.pn & 3) * 256 + c; store8_bf16(dst, lo); store8_bf16(dst + 128, hi);
    }
};
constexpr int RTAB_OFF = 132096;
struct EpiYscaled {
    bf16* O; LAS unsigned char* lds;
    __device__ __forceinline__ void pair8(const Unit& u, int row, int c, const float (&lo)[8], const float (&hi)[8]) const {
        const float rs = ((const LAS float*)(lds + RTAB_OFF))[2 * (row & 255) + 1]; float a[8], b[8];
#pragma unroll
        for (int i = 0; i < 8; ++i) { a[i] = lo[i] * rs; b[i] = hi[i] * rs; }
        bf16* dst = O + (size_t)row * DM + (u.pn & 3) * 256 + c; store8_bf16(dst, a); store8_bf16(dst + 128, b);
    }
};
struct SingleOrder {
    Unit u0;
    __device__ __forceinline__ bool next(int i, Unit& u) const { if (i != 0) return false; u = u0; return true; }
    __device__ __forceinline__ void a_ready(const Unit&) const {}
    __device__ __forceinline__ void done(const Unit&) const {}
};
struct EpiSwiglu {
    bf16* O; int ldc, ntn;
    __device__ __forceinline__ void pair8(const Unit& u, int row, int c, const float (&lo)[8], const float (&hi)[8]) const {
        float a[8];
#pragma unroll
        for (int i = 0; i < 8; ++i) a[i] = silu_f(lo[i]) * hi[i];
        store8_bf16(O + (size_t)row * ldc + (u.pn % ntn) * 128 + c, a);
    }
};

#define PG8_LAS __attribute__((address_space(3)))
typedef short bf16x8 __attribute__((ext_vector_type(8)));
typedef unsigned short bf16_t;
constexpr int BM = 256, BK = 64, HALF = 128, HTB = HALF * BK * 2, STAGE_BYTES = 8 * HTB;
__host__ __device__ __forceinline__ int lds_byte(int r, int c) { const int st = (r >> 4) * 2 + (c >> 5), rr = r & 15, cc = c & 31, ob = rr * 64 + cc * 2; return st * 1024 + (ob ^ (((ob >> 9) & 1) << 5)); }
__host__ __device__ __forceinline__ void stage_rc(int b, int& R, int& C) { const int st = b / 1024, sb = b % 1024, swz = sb ^ (((sb >> 9) & 1) << 5); R = (st >> 1) * 16 + swz / 64; C = (st & 1) * 32 + (swz % 64) / 2; }
__host__ __device__ __forceinline__ int perm32(int rho) { const int n = rho >> 4, i = rho & 15; return 8 * (i >> 2) + 4 * n + (i & 3); }
struct Gemm { const bf16_t* A; const bf16_t* Bt; int M, N, K; };
template <class E> struct EpiWrap {
    static constexpr bool PERM = true, AFTER_DRAIN = false; E e;
    __device__ __forceinline__ void operator()(const f32x4 (&acc)[2][2][4][2], const Unit& u, int wr, int wc, int fr, int fq) const {
#pragma unroll
        for (int ai = 0; ai < 2; ++ai)
#pragma unroll
            for (int m = 0; m < 4; ++m) { const int row = u.pm * BM + ai * HALF + wr * 64 + m * 16 + fr;
                const f32x4 a0 = acc[ai][0][m][0], a1 = acc[ai][0][m][1], b0 = acc[ai][1][m][0], b1 = acc[ai][1][m][1];
                const float lo[8] = {a0[0], a0[1], a0[2], a0[3], a1[0], a1[1], a1[2], a1[3]}, hi[8] = {b0[0], b0[1], b0[2], b0[3], b1[0], b1[1], b1[2], b1[3]};
                e.pair8(u, row, wc * 32 + 8 * fq, lo, hi); }
    }
};
template <class Epi, class Sched, bool ALIGN_EPI = false, bool SP2 = false, bool VARK = false, bool MIDSCALE = false>
__device__ __forceinline__ void gemm_phase(PG8_LAS unsigned char* lds, const Gemm g, const Sched& S, const Epi& E, const int wid) {
    const int lane = fresh_lane(), tid = wid * 64 + lane, wr = wid >> 2, wc = wid & 3, fr = lane & 15, fq = lane >> 4;
    const int K = g.K;
    unsigned voffA[2], voffB[2];
#pragma unroll
    for (int i = 0; i < 2; ++i) { int R, C; stage_rc(tid * 16 + i * 8192, R, C); const int Rb = Epi::PERM ? ((R & ~31) + perm32(R & 31)) : R;
        voffA[i] = (unsigned)(R * K + C) * 2u; voffB[i] = (unsigned)(Rb * K + C) * 2u; }
    const size_t kstep = (size_t)(BK * 2);
    const size_t hstep = (size_t)HALF * K * 2;
    const size_t tstep = 2 * hstep;
    const unsigned ldsw = (unsigned)wid * 1024u;
    const int aoff = lds_byte(wr * 64 + fr, fq * 8), boff = lds_byte(wc * 32 + fr, fq * 8);
#define PG8_SA(b, h) (((b) * 2 + (h)) * HTB)
#define PG8_SB(b, h) ((4 + (b) * 2 + (h)) * HTB)
#define PG8_STAGE(bufoff, gbase, voff) do { _Pragma("unroll") for (int _i = 0; _i < 2; ++_i) \
        __builtin_amdgcn_global_load_lds((const unsigned*)((const char*)(gbase) + (voff)[_i]), (PG8_LAS unsigned*)(lds + (bufoff) + ldsw + _i * 8192), 16, 0, 0); } while (0)
#define PG8_LDA(dst, b, h) do { _Pragma("unroll") for (int m = 0; m < 4; ++m) _Pragma("unroll") for (int k = 0; k < 2; ++k) dst[m][k] = *(const PG8_LAS bf16x8*)(lds + PG8_SA(b, h) + aoff + m * 2048 + k * 1024); } while (0)
#define PG8_LDB(dst, b, h) do { _Pragma("unroll") for (int n = 0; n < 2; ++n) _Pragma("unroll") for (int k = 0; k < 2; ++k) dst[n][k] = *(const PG8_LAS bf16x8*)(lds + PG8_SB(b, h) + boff + n * 2048 + k * 1024); } while (0)
#define PG8_MMA(ai, bj, At, Bt) do { __builtin_amdgcn_s_setprio(1); _Pragma("unroll") for (int m = 0; m < 4; ++m) _Pragma("unroll") for (int n = 0; n < 2; ++n) _Pragma("unroll") for (int k = 0; k < 2; ++k) \
        acc[ai][bj][m][n] = __builtin_amdgcn_mfma_f32_16x16x32_bf16(Bt[n][k], At[m][k], acc[ai][bj][m][n], 0, 0, 0); __builtin_amdgcn_s_setprio(0); } while (0)
#define PG8_WAIT_V(n) asm volatile("s_waitcnt vmcnt(" #n ")" ::: "memory")
#define PG8_WAIT_L(n) asm volatile("s_waitcnt lgkmcnt(" #n ")" ::: "memory")
#define PG8_BAR __builtin_amdgcn_s_barrier()
#define PG8_SCHED __builtin_amdgcn_sched_barrier(0)
    Unit cur, nxt; int ui = 0;
    if (!S.next(0, cur)) return;
    f32x4 acc[2][2][4][2];
#pragma unroll
    for (int a = 0; a < 2; ++a)
#pragma unroll
        for (int b = 0; b < 2; ++b)
#pragma unroll
            for (int m = 0; m < 4; ++m)
#pragma unroll
                for (int n = 0; n < 2; ++n) acc[a][b][m][n] = (f32x4){0.f, 0.f, 0.f, 0.f};
    bf16x8 At[4][2], B0[2][2], B1[2][2];
    const char* cA = (const char*)g.A + (size_t)cur.pm * tstep + (VARK ? (size_t)cur.kt0 * kstep : 0); const char* cB = (const char*)g.Bt + (size_t)cur.pn * tstep + (VARK ? (size_t)cur.kt0 * kstep : 0);
    S.a_ready(cur);
    if constexpr (SP2) {
        PG8_STAGE(PG8_SB(0, 0), cB, voffB); PG8_STAGE(PG8_SB(0, 1), cB + hstep, voffB); PG8_STAGE(PG8_SA(0, 0), cA, voffA); PG8_STAGE(PG8_SA(0, 1), cA + hstep, voffA);
        if (wr == 1) PG8_BAR;
        PG8_WAIT_V(2); PG8_BAR;
        PG8_STAGE(PG8_SB(1, 0), cB + kstep, voffB); PG8_STAGE(PG8_SA(1, 0), cA + kstep, voffA); PG8_STAGE(PG8_SB(1, 1), cB + hstep + kstep, voffB);
        PG8_WAIT_V(6); PG8_BAR;
    } else {
        PG8_STAGE(PG8_SB(0, 0), cB, voffB); PG8_STAGE(PG8_SA(0, 0), cA, voffA); PG8_STAGE(PG8_SB(0, 1), cB + hstep, voffB); PG8_STAGE(PG8_SA(0, 1), cA + hstep, voffA);
        if (wr == 1) PG8_BAR;
        PG8_WAIT_V(4); PG8_BAR;
        PG8_STAGE(PG8_SB(1, 0), cB + kstep, voffB); PG8_STAGE(PG8_SA(1, 0), cA + kstep, voffA); PG8_STAGE(PG8_SB(1, 1), cB + hstep + kstep, voffB);
        PG8_WAIT_V(6); PG8_BAR;
    }
    for (;;) {
        const bool has_next = S.next(ui + 1, nxt);
        const char* nA = has_next ? (const char*)g.A + (size_t)nxt.pm * tstep + (VARK ? (size_t)nxt.kt0 * kstep : 0) : cA; const char* nB = has_next ? (const char*)g.Bt + (size_t)nxt.pn * tstep + (VARK ? (size_t)nxt.kt0 * kstep : 0) : cB;
        const int nt = VARK ? cur.nkt : K / BK;
        for (int t = 0; t < nt; t += 2) {
            if constexpr (MIDSCALE) { if (t == nt / 2) {
                const PG8_LAS float* rt = (const PG8_LAS float*)(lds + RTAB_OFF);
                _Pragma("unroll") for (int a = 0; a < 2; ++a) _Pragma("unroll") for (int m = 0; m < 4; ++m) { const float rr = rt[2 * (a * HALF + wr * 64 + m * 16 + fr)];
                    _Pragma("unroll") for (int b = 0; b < 2; ++b) _Pragma("unroll") for (int n = 0; n < 2; ++n) acc[a][b][m][n] = acc[a][b][m][n] * rr; } } }
            const bool last = (t == nt - 2);
            const char* a1 = cA + (size_t)(t + 1) * kstep;
            const char* a2 = last ? nA : cA + (size_t)(t + 2) * kstep; const char* b2 = last ? nB : cB + (size_t)(t + 2) * kstep;
            const char* a3 = a2 + kstep; const char* b3 = b2 + kstep;
            if (last && has_next) S.a_ready(nxt);
            if constexpr (SP2) {
            PG8_LDB(B0, 0, 0); PG8_LDB(B1, 0, 1); PG8_SCHED; PG8_LDA(At, 0, 0); PG8_STAGE(PG8_SA(1, 1), a1 + hstep, voffA);
            PG8_WAIT_V(8); PG8_WAIT_L(0); PG8_BAR; PG8_MMA(0, 0, At, B0); PG8_MMA(0, 1, At, B1); PG8_BAR; PG8_SCHED;
            PG8_LDA(At, 0, 1); PG8_STAGE(PG8_SB(0, 0), b2, voffB); PG8_STAGE(PG8_SB(0, 1), b2 + hstep, voffB); PG8_STAGE(PG8_SA(0, 0), a2, voffA);
            PG8_WAIT_V(8); PG8_WAIT_L(0); PG8_BAR; PG8_MMA(1, 0, At, B0); PG8_MMA(1, 1, At, B1); PG8_BAR; PG8_SCHED;
            PG8_LDB(B0, 1, 0); PG8_LDB(B1, 1, 1); PG8_SCHED; PG8_LDA(At, 1, 0); PG8_STAGE(PG8_SA(0, 1), a2 + hstep, voffA);
            PG8_WAIT_V(8); PG8_WAIT_L(0); PG8_BAR; PG8_MMA(0, 0, At, B0); PG8_MMA(0, 1, At, B1); PG8_BAR; PG8_SCHED;
            PG8_LDA(At, 1, 1); PG8_STAGE(PG8_SB(1, 0), b3, voffB); PG8_STAGE(PG8_SB(1, 1), b3 + hstep, voffB); PG8_STAGE(PG8_SA(1, 0), a3, voffA);
            PG8_WAIT_V(8); PG8_WAIT_L(0); PG8_BAR; PG8_MMA(1, 0, At, B0); PG8_MMA(1, 1, At, B1); PG8_BAR; PG8_SCHED;
            } else {
            PG8_LDB(B0, 0, 0); PG8_SCHED; PG8_LDA(At, 0, 0); PG8_STAGE(PG8_SA(1, 1), a1 + hstep, voffA);
            PG8_WAIT_L(8); PG8_BAR; PG8_WAIT_L(0); PG8_MMA(0, 0, At, B0); PG8_BAR; PG8_SCHED;
            PG8_LDB(B1, 0, 1); PG8_STAGE(PG8_SB(0, 0), b2, voffB);
            PG8_BAR; PG8_WAIT_L(0); PG8_MMA(0, 1, At, B1); PG8_BAR;
            PG8_LDA(At, 0, 1); PG8_STAGE(PG8_SA(0, 0), a2, voffA);
            PG8_BAR; PG8_WAIT_L(0); PG8_MMA(1, 0, At, B0); PG8_BAR; PG8_SCHED;
            PG8_STAGE(PG8_SB(0, 1), b2 + hstep, voffB);
            PG8_WAIT_V(6); PG8_BAR; PG8_MMA(1, 1, At, B1); PG8_BAR;
            PG8_LDB(B0, 1, 0); PG8_SCHED; PG8_LDA(At, 1, 0); PG8_STAGE(PG8_SA(0, 1), a2 + hstep, voffA);
            PG8_WAIT_L(8); PG8_BAR; PG8_WAIT_L(0); PG8_MMA(0, 0, At, B0); PG8_BAR; PG8_SCHED;
            PG8_LDB(B1, 1, 1); PG8_STAGE(PG8_SB(1, 0), b3, voffB);
            PG8_BAR; PG8_WAIT_L(0); PG8_MMA(0, 1, At, B1); PG8_BAR;
            PG8_LDA(At, 1, 1); PG8_STAGE(PG8_SA(1, 0), a3, voffA);
            PG8_BAR; PG8_WAIT_L(0); PG8_MMA(1, 0, At, B0); PG8_BAR; PG8_SCHED;
            PG8_STAGE(PG8_SB(1, 1), b3 + hstep, voffB);
            PG8_WAIT_V(6); PG8_BAR; PG8_MMA(1, 1, At, B1); PG8_BAR;
            }
        }
        if constexpr (ALIGN_EPI) { if (wr == 0) PG8_BAR; }
        if constexpr (!Epi::AFTER_DRAIN) { E(acc, cur, wr, wc, fr, fq); S.done(cur); }
        if (!has_next) break;
#pragma unroll
        for (int a = 0; a < 2; ++a)
#pragma unroll
            for (int b = 0; b < 2; ++b)
#pragma unroll
                for (int m = 0; m < 4; ++m)
#pragma unroll
                    for (int n = 0; n < 2; ++n) acc[a][b][m][n] = (f32x4){0.f, 0.f, 0.f, 0.f};
        cur = nxt; cA = nA; cB = nB; ++ui;
        if constexpr (ALIGN_EPI) { if (wr == 1) PG8_BAR; }
    }
    PG8_WAIT_V(0);
    if constexpr (!ALIGN_EPI) { if (wr == 0) PG8_BAR; }
    PG8_BAR;
    if constexpr (Epi::AFTER_DRAIN) { E.fused(acc, cur, wr, wc, fr, fq, lds, wid, lane); S.done(cur); }
#undef PG8_SA
#undef PG8_SB
#undef PG8_STAGE
#undef PG8_LDA
#undef PG8_LDB
#undef PG8_MMA
#undef PG8_WAIT_V
#undef PG8_WAIT_L
#undef PG8_BAR
#undef PG8_SCHED
}

template <class Epi, class Sched>
__device__ __forceinline__ void gemm_simple(Frame& F, const bf16* A, const bf16* Bt, int K, const Sched& S, const Epi& E) {
    LAS float* As = (LAS float*)F.lds;
    LAS float* Bs = (LAS float*)(F.lds + 16 * 132 * 4);
    const int tid = F.tid, ty = tid >> 4, tx = tid & 15;
    Unit u;
    for (int i = 0; S.next(i, u); ++i) {
        for (int half = 0; half < 2; ++half) {
            const bf16* Ab = A + (size_t)(u.pm * 256 + half * 128) * K; const bf16* Bb = Bt + (size_t)u.pn * 256 * K;
            float acc[4][16];
#pragma unroll
            for (int r = 0; r < 4; ++r)
#pragma unroll
                for (int q = 0; q < 16; ++q) acc[r][q] = 0.f;
            for (int k0 = u.kt0 * 64; k0 < (u.kt0 + u.nkt) * 64; k0 += 16) {
                __syncthreads();
                { const int r = tid >> 1, kh = tid & 1;
                  if (tid < 256) { const u32x4 w = *(const u32x4*)(Ab + (size_t)r * K + k0 + kh * 8);
#pragma unroll
                      for (int q = 0; q < 4; ++q) { As[(kh * 8 + 2 * q) * 132 + r] = __uint_as_float(w[q] << 16); As[(kh * 8 + 2 * q + 1) * 132 + r] = __uint_as_float(w[q] & 0xffff0000u); } }
                  const u32x4 w = *(const u32x4*)(Bb + (size_t)r * K + k0 + kh * 8);
#pragma unroll
                  for (int q = 0; q < 4; ++q) { Bs[(kh * 8 + 2 * q) * 260 + r] = __uint_as_float(w[q] << 16); Bs[(kh * 8 + 2 * q + 1) * 260 + r] = __uint_as_float(w[q] & 0xffff0000u); } }
                __syncthreads();
#pragma unroll 4
                for (int k = 0; k < 16; ++k) {
                    const f32x4 a = *(const LAS f32x4*)(As + k * 132 + 4 * ty);
                    const f32x4 b0 = *(const LAS f32x4*)(Bs + k * 260 + 8 * tx), b1 = *(const LAS f32x4*)(Bs + k * 260 + 8 * tx + 4);
                    const f32x4 b2 = *(const LAS f32x4*)(Bs + k * 260 + 128 + 8 * tx), b3 = *(const LAS f32x4*)(Bs + k * 260 + 128 + 8 * tx + 4);
#pragma unroll
                    for (int r = 0; r < 4; ++r) {
#pragma unroll
                        for (int q = 0; q < 4; ++q) { acc[r][q] += a[r] * b0[q]; acc[r][4 + q] += a[r] * b1[q]; acc[r][8 + q] += a[r] * b2[q]; acc[r][12 + q] += a[r] * b3[q]; }
                    }
                }
            }
#pragma unroll
            for (int r = 0; r < 4; ++r) {
                float lo[8], hi[8];
#pragma unroll
                for (int q = 0; q < 8; ++q) { lo[q] = acc[r][q]; hi[q] = acc[r][8 + q]; }
                E.pair8(u, u.pm * 256 + half * 128 + 4 * ty + r, 8 * tx, lo, hi);
            }
        }
    }
    __syncthreads();
}

template <bool FAST, bool VARK = false, class Epi, class Sched>
__device__ __forceinline__ void gemm_run(Frame& F, const bf16* A, const bf16* Bt, int K, const Sched& S, const Epi& E) {
    if constexpr (FAST) { const Gemm g{A, Bt, 0, 0, K}; const EpiWrap<Epi> W{E}; gemm_phase<EpiWrap<Epi>, Sched, true, true, VARK>(F.lds, g, S, W, F.wave); }
    else { F.refresh(); gemm_simple(F, A, Bt, K, S, E); }
}
#ifndef FUSE_MERGE
#define FUSE_MERGE 1
#endif
#ifndef FAST_ATTN
#define FAST_ATTN 1
#endif
#ifndef FAST_SGU
#define FAST_SGU 1
#endif
#ifndef FAST_INPROJ
#define FAST_INPROJ true
#endif
#ifndef FAST_OUTPROJ
#define FAST_OUTPROJ true
#endif
#ifndef FAST_FFN1D
#define FAST_FFN1D true
#endif
#ifndef FAST_FFN2D
#define FAST_FFN2D true
#endif
#ifndef FAST_FFN1E
#define FAST_FFN1E true
#endif
#ifndef FAST_FFN2E
#define FAST_FFN2E true
#endif
__device__ __forceinline__ void tr_item(const float* W, int ldw, int k0, int srcCol0, bf16* WT, int Kd, int dstRow0, const float* scaleK, LAS float* scr, int lane) {
    const int kr = lane >> 4, nc = (lane & 15) * 4, c4 = lane & 3;
    f32x4 v[16];
#pragma unroll
    for (int i = 0; i < 16; ++i) v[i] = *(const f32x4*)(W + (size_t)(k0 + 4 * i + kr) * ldw + srcCol0 + nc);
    if (scaleK) {
#pragma unroll
        for (int i = 0; i < 16; ++i) v[i] = v[i] * scaleK[k0 + 4 * i + kr];
    }
#pragma unroll
    for (int ps = 0; ps < 2; ++ps) {
#pragma unroll
        for (int i = 0; i < 8; ++i)
#pragma unroll
            for (int q = 0; q < 4; ++q) scr[(4 * i + kr) * 65 + nc + q] = v[8 * ps + i][q];
        asm volatile("s_waitcnt lgkmcnt(0)" ::: "memory");
#pragma unroll
        for (int j = 0; j < 4; ++j) { const int n = (lane >> 2) + 16 * j; const LAS float* sp = scr + (8 * c4) * 65 + n;
            u32x4 o; o.x = pk2(sp[0], sp[65]); o.y = pk2(sp[2 * 65], sp[3 * 65]); o.z = pk2(sp[4 * 65], sp[5 * 65]); o.w = pk2(sp[6 * 65], sp[7 * 65]);
            *(u32x4*)(WT + (size_t)(dstRow0 + n) * Kd + k0 + 32 * ps + 8 * c4) = o; }
        asm volatile("s_waitcnt lgkmcnt(0)" ::: "memory");
    }
}
__device__ __forceinline__ void p0_prologue(Frame& F) {
    F.refresh();
    {
        LAS float* cact = (LAS float*)F.lds;
        LAS float* red = (LAS float*)(F.lds + 32768);
        const float* c = F.in[I_C];
        for (int i = F.tid; i < NB * DM; i += NTHREADS) cact[i] = silu_f(c[i]);
        __syncthreads();
        float* mod = (float*)(F.ws + WS_MOD);
        for (int it = F.vcu; it < NL * (NMOD * DM / 64); it += F.G) {
            const int l = it / (NMOD * DM / 64), j0 = (it % (NMOD * DM / 64)) * 64;
            const float* W = F.in[I_WADA] + (size_t)l * DM * (NMOD * DM) + j0 + F.lane;
            float acc[8];
#pragma unroll
            for (int b = 0; b < 8; ++b) acc[b] = 0.f;
            const int d0 = F.wave * 128;
#pragma unroll 8
            for (int d = 0; d < 128; ++d) { const float w = W[(size_t)(d0 + d) * (NMOD * DM)];
#pragma unroll
                for (int b = 0; b < 8; ++b) acc[b] += cact[b * DM + d0 + d] * w; }
#pragma unroll
            for (int b = 0; b < 8; ++b) red[(F.wave * 8 + b) * 64 + F.lane] = acc[b];
            __syncthreads();
            { const int b = F.tid >> 6, ln = F.tid & 63; float s = 0.f;
#pragma unroll
              for (int w = 0; w < 8; ++w) s += red[(w * 8 + b) * 64 + ln];
              mod[((size_t)l * NB + b) * (NMOD * DM) + j0 + ln] = s + F.in[I_BADA][(size_t)l * (NMOD * DM) + j0 + ln]; }
            __syncthreads();
        }
    }
    {
        float* wf = (float*)(F.ws + WS_WF); float* wr = (float*)(F.ws + WS_WR);
        const int gt = F.vcu * NTHREADS + F.tid, GT = F.G * NTHREADS;
        for (int i = gt; i < NL * 8 * DM; i += GT) { const int l = i / (8 * DM), j = (i / DM) % 8, d = i % DM; wf[i] = F.in[I_WIN][((size_t)l * DM + d) * INC + 3 * AW + j]; }
        for (int i = gt; i < 8 * DM; i += GT) { const int j = i / DM, d = i % DM; wr[i] = F.in[I_WROUTER][(size_t)d * NE + j]; }
    }
    {
        LAS float* scr = (LAS float*)(F.lds + F.wave * 8320);
        const int gw = F.vcu * NWAVES + F.wave, NGW = F.G * NWAVES;
        constexpr int N_IN = NL * (NIN / 64) * (DM / 64);
        constexpr int N_OUT = NL * (DM / 64) * (DM / 64);
        constexpr int N_GU = (2 * DFF / 64) * (DM / 64);
        constexpr int N_D = (DM / 64) * (DFF / 64);
        constexpr int N_EGU = NE * (2 * EFF / 64) * (DM / 64);
        constexpr int N_ED = NE * (DM / 64) * (EFF / 64);
        constexpr int NITEMS = N_IN + N_OUT + N_GU + N_D + N_EGU + N_ED;
        for (int it = gw; it < NITEMS; it += NGW) {
            int r = it;
            if (r < N_IN) {
                const int l = r / (40 * 16), nb = (r / 16) % 40, kb = r % 16; const int dr = nb * 64, sc = dr < 1536 ? dr : dr + 8;
                tr_item(F.in[I_WIN] + (size_t)l * DM * INC, INC, kb * 64, sc, (bf16*)(F.ws + WS_WIN) + (size_t)l * NIN * DM, DM, dr, nullptr, scr, F.lane); continue; }
            r -= N_IN;
            if (r < N_OUT) {
                const int l = r / 256, nb = (r / 16) % 16, kb = r % 16; const float* g = kb < 8 ? F.in[I_GOA] + l * AW : F.in[I_GOS] + l * AW - AW;
                tr_item(F.in[I_WOUT] + (size_t)l * DM * DM, DM, kb * 64, nb * 64, (bf16*)(F.ws + WS_WOUT) + (size_t)l * DM * DM, DM, nb * 64, g, scr, F.lane); continue; }
            r -= N_OUT;
            if (r < N_GU) {
                const int nb = r / 16, kb = r % 16; const int dr = nb * 64, t = dr >> 8, w = dr & 255; const int sc = (w < 128) ? (128 * t + w) : (DFF + 128 * t + (w - 128));
                tr_item(F.in[I_WGUD], 2 * DFF, kb * 64, sc, (bf16*)(F.ws + WS_WGU), DM, dr, nullptr, scr, F.lane); continue; }
            r -= N_GU;
            if (r < N_D) {
                const int nb = r / 44, kb = r % 44;
                tr_item(F.in[I_WDD], DM, kb * 64, nb * 64, (bf16*)(F.ws + WS_WD), DFF, nb * 64, nullptr, scr, F.lane); continue; }
            r -= N_D;
            if (r < N_EGU) {
                const int e = r / (112 * 16), nb = (r / 16) % 112, kb = r % 16; const int dr = nb * 64, t = dr >> 8, w = dr & 255; const int sc = (w < 128) ? (128 * t + w) : (EFF + 128 * t + (w - 128));
                tr_item(F.in[I_WGUE] + (size_t)e * DM * 2 * EFF, 2 * EFF, kb * 64, sc, (bf16*)(F.ws + WS_EGU) + (size_t)e * 2 * EFF * DM, DM, dr, nullptr, scr, F.lane); continue; }
            r -= N_EGU;
            {
                const int e = r / (16 * 56), nb = (r / 56) % 16, kb = r % 56;
                tr_item(F.in[I_WDE] + (size_t)e * EFF * DM, DM, kb * 64, nb * 64, (bf16*)(F.ws + WS_ED) + (size_t)e * DM * EFF, EFF, nb * 64, nullptr, scr, F.lane); }
        }
    }
}

__device__ __forceinline__ f32x4 ld4(const float* p, int j, int lane) { return *((const f32x4*)p + 64 * j + lane); }
__device__ __forceinline__ f32x4 ld4bf(const bf16* p, int j, int lane) { const u32x2 w = *((const u32x2*)p + 64 * j + lane); return (f32x4){__uint_as_float(w.x << 16), __uint_as_float(w.x & 0xffff0000u), __uint_as_float(w.y << 16), __uint_as_float(w.y & 0xffff0000u)}; }
__device__ __forceinline__ float log_sigmoid_f(float a) { return fminf(a, 0.f) - log1pf(__expf(-fabsf(a))); }
__device__ __forceinline__ void ada_norm_row(f32x4 (&v)[4], const float* g, const float* sc, const float* sh, bf16* hrow, int lane) {
    float ss = 0.f;
#pragma unroll
    for (int j = 0; j < 4; ++j) ss += dot4(v[j], v[j]);
    const float rstd = 1.0f / sqrtf(wave_sum(ss) * (1.f / DM) + EPS);
#pragma unroll
    for (int j = 0; j < 4; ++j) { const f32x4 gg = ld4(g, j, lane), s1 = ld4(sc, j, lane), s0 = ld4(sh, j, lane); v[j] = v[j] * rstd * gg * (1.f + s1) + s0;
        *((u64*)hrow + 64 * j + lane) = (u64)pk2(v[j].x, v[j].y) | ((u64)pk2(v[j].z, v[j].w) << 32); }
}
__device__ __forceinline__ void forget_row(Frame& F, const f32x4 (&h)[4], const LAS float* wf  , const float* bf, int b, int s) {
    float z = 0.f;
#pragma unroll
    for (int jj = 0; jj < 8; ++jj) { float p = 0.f;
#pragma unroll
        for (int j = 0; j < 4; ++j) p += dot4(h[j], *((const LAS f32x4*)(wf + jj * DM) + 64 * j + F.lane));
        p = wave_sum(p); if (F.lane == jj) z = p; }
    if (F.lane < 8) ((float*)(F.ws + WS_LOGF))[((size_t)b * NH + F.lane) * SEQ + s] = log_sigmoid_f(z + bf[F.lane]);
}
__device__ __forceinline__ void stage_lds_f32(Frame& F, LAS float* dst, const float* src, int n) {
    for (int i = F.tid * 4; i < n; i += NTHREADS * 4) *(LAS f32x4*)(dst + i) = *(const f32x4*)(src + i);
    __syncthreads();
}
__device__ __forceinline__ void phase_premix(Frame& F, int l, const float* xsrc) {
    F.refresh();
    LAS float* wf = (LAS float*)F.lds; stage_lds_f32(F, wf, (const float*)(F.ws + WS_WF) + (size_t)l * 8 * DM, 8 * DM);
    const int gw = F.vcu * NWAVES + F.wave, NGW = F.G * NWAVES; const float* mod = (const float*)(F.ws + WS_MOD);
    for (int row = gw; row < M; row += NGW) {
        const int b = row / SEQ, s = row % SEQ; const float* mb = mod + ((size_t)l * NB + b) * (NMOD * DM);
        f32x4 v[4];
#pragma unroll
        for (int j = 0; j < 4; ++j) v[j] = ld4(xsrc + (size_t)row * DM, j, F.lane);
        ada_norm_row(v, F.in[I_GPREMIX] + l * DM, mb + 1 * DM, mb + 0 * DM, (bf16*)(F.ws + WS_H) + (size_t)row * DM, F.lane);
        forget_row(F, v, wf, F.in[I_BFORGET] + l * NH, b, s);
    }
    __syncthreads();
}
__device__ __forceinline__ void phase_merge_norm(Frame& F) {
    F.refresh();
    const int gw = F.vcu * NWAVES + F.wave, NGW = F.G * NWAVES;
    const float* sa = (const float*)(F.ws + WS_SSQA); const float* ss = (const float*)(F.ws + WS_SSQS);
    for (int row = gw; row < M; row += NGW) {
        const f32x4 a0 = *(const f32x4*)(sa + (size_t)row * 8), a1 = *(const f32x4*)(sa + (size_t)row * 8 + 4);
        const f32x4 s0 = *(const f32x4*)(ss + (size_t)row * 16) + *(const f32x4*)(ss + (size_t)row * 16 + 8), s1 = *(const f32x4*)(ss + (size_t)row * 16 + 4) + *(const f32x4*)(ss + (size_t)row * 16 + 12);
        const float ra = 1.0f / sqrtf(((a0.x + a0.y) + (a0.z + a0.w) + (a1.x + a1.y) + (a1.z + a1.w)) * (1.f / AW) + EPS);
        const float rs = 1.0f / sqrtf(((s0.x + s0.y) + (s0.z + s0.w) + (s1.x + s1.y) + (s1.z + s1.w)) * (1.f / AW) + EPS);
        const u32x4* p = (const u32x4*)((const bf16*)(F.ws + WS_MG) + (size_t)row * DM); u32x4* po = (u32x4*)((bf16*)(F.ws + WS_MG2) + (size_t)row * DM);
#pragma unroll
        for (int j = 0; j < 2; ++j) { u32x4 w = p[64 * j + F.lane]; const float r = j == 0 ? ra : rs;
#pragma unroll
            for (int q = 0; q < 4; ++q) w[q] = pk2(__uint_as_float(w[q] << 16) * r, __uint_as_float(w[q] & 0xffff0000u) * r);
            po[64 * j + F.lane] = w; }
    }
}
__device__ __forceinline__ void phase_postmix(Frame& F, int l, const float* xsrc, bool moe) {
    F.refresh();
    LAS float* wr = (LAS float*)F.lds; LAS unsigned* lcnt = (LAS unsigned*)(F.lds + 32768); LAS unsigned* lbase = lcnt + 8;
    if (moe) { if (F.tid < 16) lcnt[F.tid] = 0u; stage_lds_f32(F, wr, (const float*)(F.ws + WS_WR), 8 * DM); }
    const int gw = F.vcu * NWAVES + F.wave, NGW = F.G * NWAVES; const float* mod = (const float*)(F.ws + WS_MOD);
    const bf16* Y = (const bf16*)(F.ws + WS_Y); unsigned* tok = (unsigned*)(F.ws + WS_TOK);
    for (int row = gw; row < M; row += NGW) {
        const int b = row / SEQ; const float* mb = mod + ((size_t)l * NB + b) * (NMOD * DM);
        f32x4 y[4], v[4]; float ss = 0.f;
#pragma unroll
        for (int j = 0; j < 4; ++j) { y[j] = ld4bf(Y + (size_t)row * DM, j, F.lane); v[j] = ld4(xsrc + (size_t)row * DM, j, F.lane); ss += dot4(y[j], y[j]); }
        const float rstd = 1.0f / sqrtf(wave_sum(ss) * (1.f / DM) + EPS);
#pragma unroll
        for (int j = 0; j < 4; ++j) { const f32x4 g = ld4(F.in[I_GPOSTMIX] + l * DM, j, F.lane), gt = ld4(mb + 2 * DM, j, F.lane); v[j] = v[j] + (1.f + gt) * (y[j] * rstd * g);
            *((f32x4*)(F.out + (size_t)row * DM) + 64 * j + F.lane) = v[j]; }
        ada_norm_row(v, F.in[I_GPREFFN] + l * DM, mb + 4 * DM, mb + 3 * DM, (bf16*)(F.ws + WS_H) + (size_t)row * DM, F.lane);
        if (moe) {
            float lg[8];
#pragma unroll
            for (int jj = 0; jj < 8; ++jj) { float p = 0.f;
#pragma unroll
                for (int j = 0; j < 4; ++j) p += dot4(v[j], *((const LAS f32x4*)(wr + jj * DM) + 64 * j + F.lane));
                lg[jj] = wave_sum(p); }
            int e0 = 0; float v0 = lg[0];
#pragma unroll
            for (int jj = 1; jj < 8; ++jj) if (lg[jj] > v0) { v0 = lg[jj]; e0 = jj; }
            int e1 = -1; float v1 = -INFINITY;
#pragma unroll
            for (int jj = 0; jj < 8; ++jj) if (jj != e0 && lg[jj] > v1) { v1 = lg[jj]; e1 = jj; }
            if (e1 < 0) e1 = (e0 + 1) & 7;
            if (F.lane == 0) {
                const float w1 = 1.f / (1.f + __expf(v0 - v1)), w0 = 1.f - w1;
                const unsigned r0 = __hip_atomic_fetch_add(&lcnt[e0], 1u, __ATOMIC_RELAXED, __HIP_MEMORY_SCOPE_WORKGROUP), r1 = __hip_atomic_fetch_add(&lcnt[e1], 1u, __ATOMIC_RELAXED, __HIP_MEMORY_SCOPE_WORKGROUP);
                u32x4 a; a.x = (unsigned)e0; a.y = (unsigned)e1; a.z = r0; a.w = r1; *(u32x4*)(tok + (size_t)row * 8) = a;
                u32x2 w; w.x = __float_as_uint(w0); w.y = __float_as_uint(w1); *(u32x2*)(tok + (size_t)row * 8 + 4) = w;
            }
        }
    }
    if (moe) {
        __syncthreads();
        if (F.tid < 8) lbase[F.tid] = __hip_atomic_fetch_add(F.ctl + CW_CNT + 64 * F.tid, lcnt[F.tid], __ATOMIC_RELAXED, __HIP_MEMORY_SCOPE_AGENT);
        __syncthreads();
        if (F.lane == 0) for (int row = gw; row < M; row += NGW) { u32x4 a = *(u32x4*)(tok + (size_t)row * 8); a.z += lbase[a.x]; a.w += lbase[a.y]; *(u32x4*)(tok + (size_t)row * 8) = a; }
    }
    __syncthreads();
}
__device__ __forceinline__ void phase_scatter(Frame& F) {
    F.refresh();
    MoeLayout Lay; Lay.init(F.ctl + CW_CNT);
    const int gw = F.vcu * NWAVES + F.wave, NGW = F.G * NWAVES; const unsigned* tok = (const unsigned*)(F.ws + WS_TOK);
    const bf16* H = (const bf16*)(F.ws + WS_H); bf16* HS = (bf16*)(F.ws + WS_HS);
    for (int row = gw; row < M; row += NGW) {
        const u32x4 a = *(const u32x4*)(tok + (size_t)row * 8);
        const int s0 = Lay.panel_base((int)a.x) * 256 + (int)a.z, s1 = Lay.panel_base((int)a.y) * 256 + (int)a.w;
        const u32x4* src = (const u32x4*)(H + (size_t)row * DM); u32x4* d0 = (u32x4*)(HS + (size_t)s0 * DM); u32x4* d1 = (u32x4*)(HS + (size_t)s1 * DM);
#pragma unroll
        for (int j = 0; j < 2; ++j) { const u32x4 w = src[64 * j + F.lane]; if (s0 < CAPROWS) d0[64 * j + F.lane] = w; if (s1 < CAPROWS) d1[64 * j + F.lane] = w; }
    }
}
__device__ __forceinline__ void phase_final(Frame& F, int l, bool moe) {
    F.refresh();
    const bool nxt = (l + 1 < NL);
    LAS float* wf = (LAS float*)F.lds; if (nxt) stage_lds_f32(F, wf, (const float*)(F.ws + WS_WF) + (size_t)(l + 1) * 8 * DM, 8 * DM);
    MoeOrder MO; if (moe) MO.init(F.ctl + CW_CNT, DM / 256, F.G, 0, EFF, true);
    const MoeLayout& Lay = MO.Lay; const float* PART = (const float*)(F.ws + WS_PART);
    const int gw = F.vcu * NWAVES + F.wave, NGW = F.G * NWAVES; const float* mod = (const float*)(F.ws + WS_MOD);
    const bf16* Y = (const bf16*)(F.ws + WS_Y); const float* YS = (const float*)(F.ws + WS_YS); const unsigned* tok = (const unsigned*)(F.ws + WS_TOK);
    for (int row = gw; row < M; row += NGW) {
        const int b = row / SEQ, s = row % SEQ; const float* mb = mod + ((size_t)l * NB + b) * (NMOD * DM);
        f32x4 y[4], v[4]; float ss = 0.f;
        if (moe) {
            const u32x4 a = *(const u32x4*)(tok + (size_t)row * 8); const u32x2 ww = *(const u32x2*)(tok + (size_t)row * 8 + 4);
            int s0 = Lay.panel_base((int)a.x) * 256 + (int)a.z, s1 = Lay.panel_base((int)a.y) * 256 + (int)a.w; if (s0 >= CAPROWS) s0 = 0; if (s1 >= CAPROWS) s1 = 0;
            const float w0 = __uint_as_float(ww.x), w1 = __uint_as_float(ww.y);
#pragma unroll
            for (int j = 0; j < 4; ++j) {
                f32x4 ya, yb;
                { const int q = MO.unit_index(s0 >> 8, j) - MO.R * MO.G;
                  if (MO.sp > 1 && q >= 0) { const f32x4* pp = (const f32x4*)(PART + ((size_t)(q * 14) * 256 + (s0 & 255)) * 256) + F.lane; f32x4 t[14];
#pragma unroll
                      for (int sl = 0; sl < 14; ++sl) t[sl] = pp[(size_t)(sl < MO.sp ? sl : MO.sp - 1) * 16384];
                      ya = t[0];
#pragma unroll
                      for (int sl = 1; sl < 14; ++sl) ya += (sl < MO.sp) ? t[sl] : (f32x4){0.f, 0.f, 0.f, 0.f}; }
                  else ya = ld4(YS + (size_t)s0 * DM, j, F.lane); }
                { const int q = MO.unit_index(s1 >> 8, j) - MO.R * MO.G;
                  if (MO.sp > 1 && q >= 0) { const f32x4* pp = (const f32x4*)(PART + ((size_t)(q * 14) * 256 + (s1 & 255)) * 256) + F.lane; f32x4 t[14];
#pragma unroll
                      for (int sl = 0; sl < 14; ++sl) t[sl] = pp[(size_t)(sl < MO.sp ? sl : MO.sp - 1) * 16384];
                      yb = t[0];
#pragma unroll
                      for (int sl = 1; sl < 14; ++sl) yb += (sl < MO.sp) ? t[sl] : (f32x4){0.f, 0.f, 0.f, 0.f}; }
                  else yb = ld4(YS + (size_t)s1 * DM, j, F.lane); }
                y[j] = w0 * ya + w1 * yb;
            }
        } else {
#pragma unroll
            for (int j = 0; j < 4; ++j) y[j] = ld4bf(Y + (size_t)row * DM, j, F.lane);
        }
#pragma unroll
        for (int j = 0; j < 4; ++j) { v[j] = ld4(F.out + (size_t)row * DM, j, F.lane); ss += dot4(y[j], y[j]); }
        const float rstd = 1.0f / sqrtf(wave_sum(ss) * (1.f / DM) + EPS);
#pragma unroll
        for (int j = 0; j < 4; ++j) { const f32x4 g = ld4(F.in[I_GPOSTFFN] + l * DM, j, F.lane), gt = ld4(mb + 5 * DM, j, F.lane); v[j] = v[j] + (1.f + gt) * (y[j] * rstd * g);
            *((f32x4*)(F.out + (size_t)row * DM) + 64 * j + F.lane) = v[j]; }
        if (nxt) {
            const float* mn = mod + ((size_t)(l + 1) * NB + b) * (NMOD * DM);
            ada_norm_row(v, F.in[I_GPREMIX] + (l + 1) * DM, mn + 1 * DM, mn + 0 * DM, (bf16*)(F.ws + WS_H) + (size_t)row * DM, F.lane);
            forget_row(F, v, wf, F.in[I_BFORGET] + (l + 1) * NH, b, s);
        }
    }
    __syncthreads();
}

__device__ __forceinline__ void attn_simple(Frame& F) {
    F.refresh();
    const bf16* Q = (const bf16*)(F.ws + WS_QKVUV); const bf16* Kb = Q + (size_t)M * 512; const bf16* Vb = Kb + (size_t)M * 512;
    const float* logf = (const float*)(F.ws + WS_LOGF); bf16* MG = (bf16*)(F.ws + WS_MG); float* ssq = (float*)(F.ws + WS_SSQA);
    for (int g2 = F.vcu * NTHREADS + F.tid; g2 < NB * NH * SEQ * 2; g2 += F.G * NTHREADS) {
        const int gt = g2 >> 1, hf = g2 & 1;
        const int bh = gt / SEQ, t = gt % SEQ, b = bh / NH, h = bh % NH; const size_t rb = (size_t)b * SEQ;
        float q[32], o[32];
        { const u32x4* qp = (const u32x4*)(Q + (rb + t) * 512 + h * 64 + hf * 32);
#pragma unroll
          for (int i = 0; i < 4; ++i) { const u32x4 w = qp[i];
#pragma unroll
              for (int k = 0; k < 4; ++k) { q[8 * i + 2 * k] = __uint_as_float(w[k] << 16); q[8 * i + 2 * k + 1] = __uint_as_float(w[k] & 0xffff0000u); } } }
#pragma unroll
        for (int d = 0; d < 32; ++d) o[d] = 0.f;
        float m = -INFINITY, lsum = 0.f, Lrun = 0.f;
        const int tmax = __builtin_amdgcn_readfirstlane(t | 31);
        for (int s = 0; s <= tmax; ++s) {
            Lrun += logf[(size_t)bh * SEQ + s];
            const u32x4* kp = (const u32x4*)(Kb + (rb + s) * 512 + h * 64 + hf * 32); float dot = 0.f;
#pragma unroll
            for (int i = 0; i < 4; ++i) { const u32x4 w = kp[i];
#pragma unroll
                for (int k = 0; k < 4; ++k) dot += q[8 * i + 2 * k] * __uint_as_float(w[k] << 16) + q[8 * i + 2 * k + 1] * __uint_as_float(w[k] & 0xffff0000u); }
            dot += __shfl_xor(dot, 1);
            if (s <= t) {
                const float sc = dot - Lrun * LOG2E, mn = fmaxf(m, sc), al = exp2f(m - mn), p = exp2f(sc - mn);
                lsum = lsum * al + p; m = mn;
                const u32x4* vp = (const u32x4*)(Vb + (rb + s) * 512 + h * 64 + hf * 32);
#pragma unroll
                for (int i = 0; i < 4; ++i) { const u32x4 w = vp[i];
#pragma unroll
                    for (int k = 0; k < 4; ++k) { o[8 * i + 2 * k] = o[8 * i + 2 * k] * al + p * __uint_as_float(w[k] << 16); o[8 * i + 2 * k + 1] = o[8 * i + 2 * k + 1] * al + p * __uint_as_float(w[k] & 0xffff0000u); } }
            }
        }
        const float il = 1.f / lsum; float sq = 0.f;
        bf16* op = MG + (rb + t) * DM + h * 64 + hf * 32;
#pragma unroll
        for (int i = 0; i < 4; ++i) { float v[8];
#pragma unroll
            for (int k = 0; k < 8; ++k) { v[k] = o[8 * i + k] * il; sq += v[k] * v[k]; }
            store8_bf16(op + 8 * i, v); }
        sq += __shfl_xor(sq, 1);
        if (hf == 0) ssq[(rb + t) * 8 + h] = sq;
    }
}
__device__ __forceinline__ void sgu_simple(Frame& F, int l) {
    F.refresh();
    const bf16* U = (const bf16*)(F.ws + WS_QKVUV) + (size_t)3 * M * 512; const bf16* SV = U + (size_t)M * 512;
    bf16* MG = (bf16*)(F.ws + WS_MG); float* ssq = (float*)(F.ws + WS_SSQS);
    LAS float* st = (LAS float*)F.lds;
    LAS float* vn = (LAS float*)(F.lds + 1024);
    LAS float* wl = (LAS float*)(F.lds + 1024 + 128 * 65 * 4);
    const float* gv = F.in[I_GV] + l * AW;
    for (int un = F.vcu; un < NB * 16 * 8; un += F.G) {
        const int g = un & 7, ch = (un >> 3) & 15, b = un >> 7; const size_t rb = (size_t)b * SEQ + ch * 128;
        __syncthreads();
        for (int r = F.wave * 16; r < F.wave * 16 + 16; ++r) {
            const u32x4 w = *((const u32x4*)(SV + (rb + r) * 512) + F.lane); float x[8];
#pragma unroll
            for (int k = 0; k < 4; ++k) { x[2 * k] = __uint_as_float(w[k] << 16); x[2 * k + 1] = __uint_as_float(w[k] & 0xffff0000u); }
            float s = 0.f;
#pragma unroll
            for (int k = 0; k < 8; ++k) s += x[k];
            const float mean = wave_sum(s) * (1.f / 512.f); float q = 0.f;
#pragma unroll
            for (int k = 0; k < 8; ++k) { const float d = x[k] - mean; q += d * d; }
            const float rstd = 1.0f / sqrtf(wave_sum(q) * (1.f / 512.f) + EPS);
            if (F.lane == 0) { st[2 * r] = mean; st[2 * r + 1] = rstd; }
        }
        const float* W = F.in[I_WSP] + ((size_t)l * 8 + g) * 128 * 128;
        for (int i = F.tid; i < 128 * 128; i += NTHREADS) { const int t = i >> 7, s = i & 127; wl[t * 129 + s] = (s <= t) ? W[i] : 0.f; }
        __syncthreads();
        for (int i = F.tid; i < 128 * 64; i += NTHREADS) { const int s = i >> 6, d = i & 63; vn[s * 65 + d] = (bf2f(SV[(rb + s) * 512 + g * 64 + d]) - st[2 * s]) * st[2 * s + 1] * gv[g * 64 + d]; }
        __syncthreads();
        const int t = F.tid >> 2, dq = F.tid & 3;
        float acc[16];
#pragma unroll
        for (int i = 0; i < 16; ++i) acc[i] = 0.f;
        for (int s = 0; s <= t; ++s) { const float w = wl[t * 129 + s];
#pragma unroll
            for (int i = 0; i < 16; ++i) acc[i] += w * vn[s * 65 + dq * 16 + i]; }
        const float bs = F.in[I_BSP][((size_t)l * 8 + g) * 128 + t]; float sq = 0.f;
        const bf16* up = U + (rb + t) * 512 + g * 64 + dq * 16; bf16* op = MG + (rb + t) * DM + AW + g * 64 + dq * 16;
#pragma unroll
        for (int i = 0; i < 2; ++i) { float v[8];
#pragma unroll
            for (int k = 0; k < 8; ++k) { v[k] = bf2f(up[8 * i + k]) * (acc[8 * i + k] + bs); sq += v[k] * v[k]; }
            store8_bf16(op + 8 * i, v); }
        sq += __shfl_xor(sq, 1); sq += __shfl_xor(sq, 2);
        if (dq == 0) { ssq[(rb + t) * 16 + 2 * g] = sq; ssq[(rb + t) * 16 + 2 * g + 1] = 0.f; }
    }
    __syncthreads();
}

#include <hip/hip_bf16.h>
#include <cmath>
namespace attn_body {
typedef float f32x4_t __attribute__((ext_vector_type(4)));
using bf16=__hip_bfloat16;
using bf16x8=__attribute__((ext_vector_type(8)))short;
using s16x4=__attribute__((ext_vector_type(4)))short;
using f32x16=__attribute__((ext_vector_type(16)))float;
using u32x4=__attribute__((ext_vector_type(4)))unsigned;
constexpr int BATCH=8,NHEAD=8,SEQ=2048,D=64,DM=NHEAD*D,OP=1024;
constexpr int NW=8,QBLK=32,QB=QBLK*NW,KVBLK=64,NQB=SEQ/QB;
constexpr int ATTN_PITCH=DM, ATTN_UNIT_ROWS=QB;
__device__ __forceinline__ int crow(int r,int hi){return (r&3)+8*(r>>2)+4*hi;}
#define SBAR() __builtin_amdgcn_sched_barrier(0)
__device__ __forceinline__ void cmask(f32x16&p0,f32x16&p1,int jb,int qrel,int hi){
  const float NEG=-INFINITY; int kb=64*jb+4*hi;
  #pragma unroll
  for(int r=0;r<16;++r){int kv=kb+(r&3)+8*(r>>2); if(kv>qrel)p0[r]=NEG; if(kv+32>qrel)p1[r]=NEG;}
}

constexpr int NSLOT=3, SLOTB=8192;
constexpr int LDS_K=0, LDS_V=NSLOT*SLOTB, LDS_WS=2*NSLOT*SLOTB, LDS_OST=LDS_WS+NW*64*4, LDS_BIAS=LDS_OST+NW*4096, LDS_BYTES=LDS_BIAS+SEQ*4;
constexpr float C2=0.125f*1.4426950408889634f;
__device__ __forceinline__ void glds16(const void*gsrc,unsigned lds_dst){unsigned keep;
  asm volatile("s_mov_b32 %0, m0\n\ts_mov_b32 m0, %2\n\ts_nop 0\n\tglobal_load_lds_dwordx4 %1, off\n\ts_mov_b32 m0, %0":"=&s"(keep):"v"(gsrc),"s"(lds_dst):"memory");}
__device__ __forceinline__ float max3f(float a,float b,float c){float r;asm("v_max3_f32 %0, %1, %2, %3":"=v"(r):"v"(a),"v"(b),"v"(c));return r;}
__device__ __forceinline__ float max2f(float a,float b){float r;asm("v_max_f32_e32 %0, %1, %2":"=v"(r):"v"(a),"v"(b));return r;}
__device__ __forceinline__ float fadd_s(float a,float b){float r;asm("v_add_f32_e32 %0, %1, %2":"=v"(r):"v"(a),"v"(b));return r;}
__device__ __forceinline__ float fsub_s(float a,float b){float r;asm("v_sub_f32_e32 %0, %1, %2":"=v"(r):"v"(a),"v"(b));return r;}
typedef float f32x2_t __attribute__((ext_vector_type(2))); typedef __bf16 bf16x2_t __attribute__((ext_vector_type(2)));
__device__ __forceinline__ unsigned cvtpk_s(float lo,float hi){f32x2_t v={lo,hi};bf16x2_t b=__builtin_convertvector(v,bf16x2_t);return __builtin_bit_cast(unsigned,b);}
#define WAIT_BAR(N) asm volatile("s_waitcnt vmcnt(" #N ") lgkmcnt(0)\n\ts_barrier":::"memory")

__device__ __forceinline__ void qkt(f32x16&p0,f32x16&p1,const char*Kslot,const bf16x8*qr,int r32,int hi){
  const char*kb=Kslot+hi*1024+r32*16;
  #pragma unroll
  for(int d0=0;d0<4;++d0){
    const bf16x8 b0=*reinterpret_cast<const bf16x8*>(kb+d0*2048);
    const bf16x8 b1=*reinterpret_cast<const bf16x8*>(kb+d0*2048+512);
    {p0=__builtin_amdgcn_mfma_f32_32x32x16_bf16(b0,qr[d0],p0,0,0,0);p1=__builtin_amdgcn_mfma_f32_32x32x16_bf16(b1,qr[d0],p1,0,0,0);}}
}
typedef __attribute__((address_space(3))) const char* lds_cptr;
typedef short v4i16_t __attribute__((ext_vector_type(4)));
__device__ __forceinline__ void kload8(bf16x8*kf,lds_cptr kp){
  kf[0]=*(const __attribute__((address_space(3))) bf16x8*)(kp);      kf[1]=*(const __attribute__((address_space(3))) bf16x8*)(kp+512);
  kf[2]=*(const __attribute__((address_space(3))) bf16x8*)(kp+2048); kf[3]=*(const __attribute__((address_space(3))) bf16x8*)(kp+2560);
  kf[4]=*(const __attribute__((address_space(3))) bf16x8*)(kp+4096); kf[5]=*(const __attribute__((address_space(3))) bf16x8*)(kp+4608);
  kf[6]=*(const __attribute__((address_space(3))) bf16x8*)(kp+6144); kf[7]=*(const __attribute__((address_space(3))) bf16x8*)(kp+6656);
}
__device__ __forceinline__ void kload2(bf16x8*kf,lds_cptr kp,int j){ kf[2*j]=*(const __attribute__((address_space(3))) bf16x8*)(kp+j*2048); kf[2*j+1]=*(const __attribute__((address_space(3))) bf16x8*)(kp+j*2048+512); }
__device__ __forceinline__ s16x4 vtr(lds_cptr p){ return __builtin_bit_cast(s16x4,__builtin_amdgcn_ds_read_tr16_b64_v4i16((__attribute__((address_space(3))) v4i16_t*)p)); }
__device__ __forceinline__ float rowmax(const f32x16&p0,const f32x16&p1){
  float a=max3f(p0[0],p0[1],p1[0]),b=max3f(p0[2],p0[3],p1[1]);a=max3f(a,p1[2],p1[3]);
  #pragma unroll
  for(int r=4;r<16;r+=4){a=max3f(a,p0[r],p0[r+1]);b=max3f(b,p0[r+2],p0[r+3]);a=max3f(a,p1[r],p1[r+1]);b=max3f(b,p1[r+2],p1[r+3]);}
  const float m=max2f(a,b);
  auto rr=__builtin_amdgcn_permlane32_swap(__float_as_uint(m),__float_as_uint(m),false,false);
  return max2f(__uint_as_float(rr[0]),__uint_as_float(rr[1]));
}
__device__ __forceinline__ void pv(f32x16*o,int vb,bf16x8 pa0,bf16x8 pa1,bf16x8 pa2,bf16x8 pa3){
  #pragma unroll
  for(int d0=0;d0<2;++d0){s16x4 lo[4],hi[4];
    #pragma unroll
    for(int ks=0;ks<4;++ks){
      asm volatile("ds_read_b64_tr_b16 %0,%1 offset:%c2":"=&v"(lo[ks]):"v"(vb),"i"(d0*4096+ks*1024):"memory");
      asm volatile("ds_read_b64_tr_b16 %0,%1 offset:%c2":"=&v"(hi[ks]):"v"(vb),"i"(d0*4096+ks*1024+512):"memory");}
    asm volatile("s_waitcnt lgkmcnt(0)":::"memory");SBAR();
    #define PK(k) (bf16x8){lo[k][0],lo[k][1],lo[k][2],lo[k][3],hi[k][0],hi[k][1],hi[k][2],hi[k][3]}
    o[d0]=__builtin_amdgcn_mfma_f32_32x32x16_bf16(pa0,PK(0),o[d0],0,0,0);
    o[d0]=__builtin_amdgcn_mfma_f32_32x32x16_bf16(pa1,PK(1),o[d0],0,0,0);
    o[d0]=__builtin_amdgcn_mfma_f32_32x32x16_bf16(pa2,PK(2),o[d0],0,0,0);
    o[d0]=__builtin_amdgcn_mfma_f32_32x32x16_bf16(pa3,PK(3),o[d0],0,0,0);
    #undef PK
  }
}

#ifndef ATTN_STORE16
#define ATTN_STORE16(p,v) (*(u32x4*)(p)=(v))
#endif
template<int THRL> __device__ __forceinline__ void attn_unit(int b,int h,int qb,const bf16*Q,const bf16*__restrict__ K,const bf16*__restrict__ V,bf16*O,float*SSQ,char*shm,const int wid){
  const int lane=fresh_lane(),r32=lane&31,hi=lane>>5;
  const long rowbase=(long)b*SEQ; const int q0=qb*QB;
  const bf16*Qw=Q+(rowbase+q0+wid*QBLK)*DM+h*D;
  const bf16*Kh=K+rowbase*DM+h*D,*Vh=V+rowbase*DM+h*D;
  const unsigned lds0=(unsigned)(uintptr_t)shm;
  float*wsf=(float*)(shm+LDS_WS)+wid*64;
  const bf16*ksrc=Kh+(long)lane*DM+wid*8;
  const bf16*vsrc=Vh+(long)(16*(wid&3)+(lane>>2))*DM+(wid>>2)*32+(lane&3)*8;
  const unsigned kdst=lds0+LDS_K+wid*1024, vdst=lds0+LDS_V+wid*1024;
  #define DMA_K(t,slot) glds16(ksrc+(long)(t)*KVBLK*DM,(unsigned)__builtin_amdgcn_readfirstlane(kdst+(slot)))
  #define DMA_V(t,slot) glds16(vsrc+(long)(t)*KVBLK*DM,(unsigned)__builtin_amdgcn_readfirstlane(vdst+(slot)))
  const char*Kbase=shm+LDS_K; bf16x8 kf[8];
  const lds_cptr shm3=(lds_cptr)shm; const lds_cptr kp0=shm3+LDS_K+hi*1024+r32*16; const lds_cptr vp0=shm3+LDS_V+((lane>>4)&1)*32+(lane&3)*8+(4*hi+((lane&15)>>2))*64;
  const __attribute__((address_space(3))) float* biasp=(const __attribute__((address_space(3))) float*)(shm3+LDS_BIAS)+4*hi;
  #define CINIT(P0,P1,t) do{ const __attribute__((address_space(3))) float* bp_=biasp+64*(t); _Pragma("unroll") for(int j_=0;j_<4;++j_){ const f32x4_t b0_=*(const __attribute__((address_space(3))) f32x4_t*)(bp_+8*j_), b1_=*(const __attribute__((address_space(3))) f32x4_t*)(bp_+32+8*j_); _Pragma("unroll") for(int k_=0;k_<4;++k_){ P0[4*j_+k_]=b0_[k_]-mhat; P1[4*j_+k_]=b1_[k_]-mhat; } } }while(0)
  const int NT=(q0+QB)/KVBLK;
  DMA_K(0,0);DMA_V(0,0);DMA_K(1,SLOTB);
  bf16x8 qr[4];
  #pragma unroll
  for(int d0=0;d0<4;++d0)qr[d0]=*reinterpret_cast<const bf16x8*>(&Qw[(long)r32*DM+d0*16+hi*8]);
  float mhat=0.f,l_reg=0.f;f32x16 o[2];o[0]=f32x16{};o[1]=f32x16{};
  const int qrel=wid*QBLK+r32;
  #define CMASK(P0,P1,t) do{int jb_=(t)-(NT-4); if(jb_>=0)cmask(P0,P1,jb_,qrel,hi);}while(0)
  bool resc=false;
  #define START(P0,P1) do{ const float rm=rowmax(P0,P1); resc=false; \
    { const float dl=rm; mhat=fadd_s(mhat,dl); \
      _Pragma("unroll") for(int r=0;r<16;++r){P0[r]=fsub_s(P0[r],dl);P1[r]=fsub_s(P1[r],dl);} \
      } \
    _Pragma("unroll") for(int r=0;r<16;++r)P0[r]=__builtin_amdgcn_exp2f(P0[r]); }while(0)
  #define RESC() do{ if(resc){ asm volatile("s_waitcnt lgkmcnt(0)":::"memory"); \
      _Pragma("unroll") for(int d_=0;d_<2;++d_) _Pragma("unroll") for(int r=0;r<16;++r)o[d_][r]*=wsf[crow(r,hi)]; } }while(0)
  f32x16 pA0,pA1,pB0,pB1;
  int sl_prev=0,sl_cur=0,sl_next=SLOTB;
  #define ROT() do{sl_prev=sl_cur;sl_cur=sl_next;sl_next=(sl_next==(NSLOT-1)*SLOTB)?0:sl_next+SLOTB;}while(0)
  DMA_K(2,2*SLOTB);
  WAIT_BAR(3);
  CINIT(pA0,pA1,0);qkt(pA0,pA1,Kbase,qr,r32,hi);asm volatile("s_nop 15\n\ts_nop 7":"+v"(pA0),"+v"(pA1));CMASK(pA0,pA1,0);
  START(pA0,pA1);
  _Pragma("unroll") for(int r=0;r<16;++r)pA1[r]=__builtin_amdgcn_exp2f(pA1[r]);
  WAIT_BAR(0);
  DMA_K(3,0);DMA_V(1,SLOTB);
  ROT();
  kload8(kf,kp0+sl_cur);
  WAIT_BAR(2);
  s16x4 vlo[8],vhi[8]; u32x4 pw0,pw1,pw2,pw3;
  #define PKW(P,B) cvtpk_s(P[B],P[B+1])
  #define PAF(k) __builtin_bit_cast(bf16x8,pw##k)
  #define VFR(i) (bf16x8){vlo[i][0],vlo[i][1],vlo[i][2],vlo[i][3],vhi[i][0],vhi[i][1],vhi[i][2],vhi[i][3]}
  #define PIN(x) asm volatile("":"+v"(x))
  #define MX3(a,b,c) __builtin_fmaxf(__builtin_fmaxf((a),(b)),(c))
  #define GAPA(MF,A0,A1,A2,A3,W0,W1,PW) do{ MF; sacc+=A0; sacc+=A1; sacc+=A2; sacc+=A3; PIN(sacc); W0; W1; PIN(PW); SBAR(); }while(0)
  #define EX(v) __builtin_amdgcn_exp2f(v)
  #define GAPB(MF,X,B) do{ MF; X[B]=EX(X[B]); X[B+1]=EX(X[B+1]); X[B+2]=EX(X[B+2]); X[B+3]=EX(X[B+3]); PIN(X); SBAR(); }while(0)
  #define VRD(i) do{ vlo[i]=vtr(vp_+(((i)>>2)*4096+((i)&3)*1024)); vhi[i]=vtr(vp_+(((i)>>2)*4096+((i)&3)*1024+512)); }while(0)
  #define KRD(G,j) do{ if(G){ kload2(kf,kp0+sl_next,j); SBAR(); } }while(0)
  #define STEP(C0,C1,P0,P1,t,GK,GV,GL) do{ SBAR(); CINIT(C0,C1,t); SBAR(); \
    const lds_cptr vp_=vp0+sl_prev; \
    VRD(0); SBAR(); float sacc=(P0[0]+P0[1]); \
    GAPA(C0=__builtin_amdgcn_mfma_f32_32x32x16_bf16(kf[0],qr[0],C0,0,0,0), P0[2],P0[3],P0[4],P0[5],     pw0[0]=PKW(P0,0), pw0[1]=PKW(P0,2), pw0); \
    VRD(4); SBAR(); GAPA(C1=__builtin_amdgcn_mfma_f32_32x32x16_bf16(kf[1],qr[0],C1,0,0,0), P0[6],P0[7],P0[8],P0[9],     pw0[2]=PKW(P0,4), pw0[3]=PKW(P0,6), pw0); \
    VRD(1); SBAR(); GAPA(C0=__builtin_amdgcn_mfma_f32_32x32x16_bf16(kf[2],qr[1],C0,0,0,0),   P0[10],P0[11],P0[12],P0[13], pw1[0]=PKW(P0,8), pw1[1]=PKW(P0,10), pw1); \
    VRD(5); SBAR(); GAPA(C1=__builtin_amdgcn_mfma_f32_32x32x16_bf16(kf[3],qr[1],C1,0,0,0),   P0[14],P0[15],P1[0],P1[1],   pw1[2]=PKW(P0,12),pw1[3]=PKW(P0,14), pw1); \
    VRD(2); SBAR(); GAPA(C0=__builtin_amdgcn_mfma_f32_32x32x16_bf16(kf[4],qr[2],C0,0,0,0),   P1[2],P1[3],P1[4],P1[5],     pw2[0]=PKW(P1,0), pw2[1]=PKW(P1,2), pw2); \
    VRD(6); SBAR(); GAPA(C1=__builtin_amdgcn_mfma_f32_32x32x16_bf16(kf[5],qr[2],C1,0,0,0),   P1[6],P1[7],P1[8],P1[9],     pw2[2]=PKW(P1,4), pw2[3]=PKW(P1,6), pw2); \
    VRD(3); SBAR(); GAPA(C0=__builtin_amdgcn_mfma_f32_32x32x16_bf16(kf[6],qr[3],C0,0,0,0),   P1[10],P1[11],P1[12],P1[13], pw3[0]=PKW(P1,8), pw3[1]=PKW(P1,10), pw3); \
    VRD(7); SBAR(); GAPA(C1=__builtin_amdgcn_mfma_f32_32x32x16_bf16(kf[7],qr[3],C1,0,0,0),   P1[14],P1[15],0.f,0.f,       pw3[2]=PKW(P1,12),pw3[3]=PKW(P1,14), pw3); \
    l_reg+=sacc; \
    if(GK){DMA_K((t)+3,sl_cur);} if(GV){DMA_V((t)+1,sl_next);} \
    CMASK(C0,C1,t); \
    { float a=MX3(C0[0],C0[1],C1[0]),b=MX3(C0[2],C0[3],C1[1]); a=MX3(a,C1[2],C1[3]); \
      _Pragma("unroll") for(int r=4;r<16;r+=4){a=MX3(a,C0[r],C0[r+1]);b=MX3(b,C0[r+2],C0[r+3]);a=MX3(a,C1[r],C1[r+1]);b=MX3(b,C1[r+2],C1[r+3]);} \
      float rm=__builtin_fmaxf(a,b); { auto rr=__builtin_amdgcn_permlane32_swap(__float_as_uint(rm),__float_as_uint(rm),false,false); rm=__builtin_fmaxf(__uint_as_float(rr[0]),__uint_as_float(rr[1])); } \
      resc=false; \
      if(__builtin_expect(__any(rm>(float)THRL),0)){ const float dl=__builtin_fmaxf(rm,0.f); mhat+=dl; \
        _Pragma("unroll") for(int r=0;r<16;++r){C0[r]-=dl;C1[r]-=dl;} \
        const float f=__builtin_amdgcn_exp2f(-dl); l_reg*=f; if(hi==0)wsf[r32]=f; resc=true; } } \
    SBAR(); \
    GAPB(o[0]=__builtin_amdgcn_mfma_f32_32x32x16_bf16(PAF(0),VFR(0),o[0],0,0,0), C0,0); \
    GAPB(o[1]=__builtin_amdgcn_mfma_f32_32x32x16_bf16(PAF(0),VFR(4),o[1],0,0,0), C0,4); \
    KRD(GL,0); GAPB(o[0]=__builtin_amdgcn_mfma_f32_32x32x16_bf16(PAF(1),VFR(1),o[0],0,0,0), C0,8); \
    KRD(GL,1); GAPB(o[1]=__builtin_amdgcn_mfma_f32_32x32x16_bf16(PAF(1),VFR(5),o[1],0,0,0), C0,12); \
    KRD(GL,2); GAPB(o[0]=__builtin_amdgcn_mfma_f32_32x32x16_bf16(PAF(2),VFR(2),o[0],0,0,0), C1,0); \
    KRD(GL,3); GAPB(o[1]=__builtin_amdgcn_mfma_f32_32x32x16_bf16(PAF(2),VFR(6),o[1],0,0,0), C1,4); \
    GAPB(o[0]=__builtin_amdgcn_mfma_f32_32x32x16_bf16(PAF(3),VFR(3),o[0],0,0,0), C1,8); \
    GAPB(o[1]=__builtin_amdgcn_mfma_f32_32x32x16_bf16(PAF(3),VFR(7),o[1],0,0,0), C1,12); \
    }while(0)
  int t=1;
  #undef CMASK
  #define CMASK(P0,P1,t) do{}while(0)
  for(;t+5<NT;t+=2){
    STEP(pB0,pB1,pA0,pA1,t,true,true,true);     WAIT_BAR(2); RESC(); ROT();
    STEP(pA0,pA1,pB0,pB1,t+1,true,true,true);   WAIT_BAR(2); RESC(); ROT();
  }
  #undef CMASK
  #define CMASK(P0,P1,t) do{int jb_=(t)-(NT-4); if(jb_>=0)cmask(P0,P1,jb_,qrel,hi);}while(0)
  #define ENDW(tt) do{ if((tt)+3<NT){WAIT_BAR(2);} else if((tt)+2<NT){WAIT_BAR(1);} else {WAIT_BAR(0);} }while(0)
  for(;t+1<NT;t+=2){
    STEP(pB0,pB1,pA0,pA1,t,(t+3<NT),(t+1<NT),(t+1<NT));       ENDW(t);   RESC(); ROT();
    STEP(pA0,pA1,pB0,pB1,t+1,(t+4<NT),(t+2<NT),(t+2<NT));     ENDW(t+1); RESC(); ROT();
  }
  STEP(pB0,pB1,pA0,pA1,NT-1,false,false,false); RESC();
  { float sacc=pB0[0]+pB0[1]; _Pragma("unroll") for(int r=2;r<16;++r)sacc+=pB0[r]; _Pragma("unroll") for(int r=0;r<16;++r)sacc+=pB1[r]; l_reg+=sacc;
    pw0=(u32x4){PKW(pB0,0),PKW(pB0,2),PKW(pB0,4),PKW(pB0,6)};pw1=(u32x4){PKW(pB0,8),PKW(pB0,10),PKW(pB0,12),PKW(pB0,14)};pw2=(u32x4){PKW(pB1,0),PKW(pB1,2),PKW(pB1,4),PKW(pB1,6)};pw3=(u32x4){PKW(pB1,8),PKW(pB1,10),PKW(pB1,12),PKW(pB1,14)};
    SBAR(); pv(o,(int)(uintptr_t)vp0+sl_cur,PAF(0),PAF(1),PAF(2),PAF(3)); }
  #undef PKW
  #undef PAF
  #undef VFR
  #undef PIN
  #undef MX3
  #undef GAPA
  #undef GAPB
  #undef EX
  #undef VRD
  #undef KRD
  #undef STEP
  #undef ENDW
  {auto rr=__builtin_amdgcn_permlane32_swap(__float_as_uint(l_reg),__float_as_uint(l_reg),false,false);l_reg=__uint_as_float(rr[0])+__uint_as_float(rr[1]);}
  if(hi==0)wsf[32+r32]=l_reg;asm volatile("s_waitcnt lgkmcnt(0)":::"memory");
  float rli[16];
  #pragma unroll
  for(int r=0;r<16;++r)rli[r]=__builtin_amdgcn_rcpf(wsf[32+crow(r,hi)]);
  bf16*Ow=O+(rowbase+q0+wid*QBLK)*OP+h*D; float*Sw=SSQ+(rowbase+q0+wid*QBLK)*8+h;
  { bf16*stg=(bf16*)(shm+LDS_OST)+wid*2048;
    #pragma unroll
    for(int r=0;r<16;++r){const int orow=crow(r,hi);
      #pragma unroll
      for(int d0=0;d0<2;++d0)stg[orow*64+d0*32+r32]=__float2bfloat16(o[d0][r]*rli[r]);}
    asm volatile("s_waitcnt lgkmcnt(0)":::"memory");
    #pragma unroll
    for(int i=0;i<4;++i){const int row=i*8+(lane>>3),ch=lane&7; const u32x4 v=*(const u32x4*)(stg+row*64+ch*8); ATTN_STORE16(Ow+(long)row*OP+ch*8,v);
      float sq=0.f; _Pragma("unroll") for(int k_=0;k_<4;++k_){ const float a_=__uint_as_float(v[k_]<<16), b_=__uint_as_float(v[k_]&0xffff0000u); sq+=a_*a_+b_*b_; }
      sq+=__shfl_xor(sq,1); sq+=__shfl_xor(sq,2); sq+=__shfl_xor(sq,4); if(ch==0)Sw[(long)row*8]=sq; } }
  asm volatile("s_waitcnt lgkmcnt(0)\n\ts_barrier":::"memory");
  #undef DMA_K
  #undef DMA_V
  #undef CMASK
  #undef CINIT
  #undef START
  #undef RESC
  #undef ROT
}
constexpr int ATTN_LDS_BYTES=LDS_BYTES;
#undef SBAR
#undef WAIT_BAR
}

__device__ __forceinline__ void attn_fast(Frame& F) {
    F.refresh();
    const attn_body::bf16* Q = (const attn_body::bf16*)(F.ws + WS_QKVUV); const attn_body::bf16* Kb = Q + (size_t)M * 512; const attn_body::bf16* Vb = Kb + (size_t)M * 512;
    attn_body::bf16* O = (attn_body::bf16*)(F.ws + WS_MG); float* SSQ = (float*)(F.ws + WS_SSQA); const float* logf = (const float*)(F.ws + WS_LOGF);
    LAS float* bias = (LAS float*)(F.lds + attn_body::LDS_BIAS); LAS float* wsum = (LAS float*)(F.lds + attn_body::LDS_WS);
    for (int it = 0;; ++it) {
        const int pr = F.vcu + (it >> 1) * F.G; if (pr >= NB * NH * 4) break;
        const int bh = pr >> 2, sidx = pr & 3;
        if (!(it & 1)) {
            const f32x4 v = *(const f32x4*)(logf + (size_t)bh * SEQ + 4 * F.tid);
            const float a0 = v.x, a1 = a0 + v.y, a2 = a1 + v.z, a3 = a2 + v.w; float run = a3;
#pragma unroll
            for (int o = 1; o < 64; o <<= 1) { const float t = __shfl_up(run, o); if (F.lane >= o) run += t; }
            if (F.lane == 63) wsum[F.wave] = run;
            __syncthreads();
            float base = run - a3;
#pragma unroll
            for (int w = 0; w < 8; ++w) if (w < F.wave) base += wsum[w];
            *(LAS f32x4*)(bias + 4 * F.tid) = (f32x4){-(base + a0) * LOG2E, -(base + a1) * LOG2E, -(base + a2) * LOG2E, -(base + a3) * LOG2E};
            __syncthreads();
        }
        attn_body::attn_unit<8>(bh / NH, bh % NH, (it & 1) ? 7 - sidx : sidx, Q, Kb, Vb, O, SSQ, (char*)F.lds, F.wave);
    }
}
typedef float f32x16 __attribute__((ext_vector_type(16)));
__device__ __forceinline__ void sgu_fast(Frame& F, int l) {
    const bf16* U = (const bf16*)(F.ws + WS_QKVUV) + (size_t)3 * M * 512; const bf16* SV = U + (size_t)M * 512;
    bf16* MG = (bf16*)(F.ws + WS_MG); float* ssq = (float*)(F.ws + WS_SSQS);
    LAS float* st = (LAS float*)F.lds;
    LAS unsigned char* vnT = F.lds + 1024;
    const float* gv = F.in[I_GV] + l * AW;
    F.refresh();
    const int lane = F.lane, wave = F.wave, r32 = lane & 31, hi = lane >> 5, gl = wave >> 1, dh = wave & 1;
    for (int un = F.vcu; un < NB * 16 * 2; un += F.G) {
        const int gh = un & 1, ch = (un >> 1) & 15, b = un >> 5; const size_t rb = (size_t)b * SEQ + ch * 128;
        __syncthreads();
        for (int r = wave * 16; r < wave * 16 + 16; ++r) {
            const u32x4 w = *((const u32x4*)(SV + (rb + r) * 512) + lane); float x[8];
#pragma unroll
            for (int k = 0; k < 4; ++k) { x[2 * k] = __uint_as_float(w[k] << 16); x[2 * k + 1] = __uint_as_float(w[k] & 0xffff0000u); }
            float sm = 0.f;
#pragma unroll
            for (int k = 0; k < 8; ++k) sm += x[k];
            const float mean = wave_sum(sm) * (1.f / 512.f); float q = 0.f;
#pragma unroll
            for (int k = 0; k < 8; ++k) { const float d = x[k] - mean; q += d * d; }
            const float rstd = 1.0f / sqrtf(wave_sum(q) * (1.f / 512.f) + EPS);
            if (lane == 0) { st[2 * r] = mean; st[2 * r + 1] = rstd; }
        }
        __syncthreads();
#pragma unroll
        for (int k = 0; k < 4; ++k) {
            const int c = wave + 8 * k, s0 = 2 * lane; const int col = gh * 256 + 8 * c;
            const u32x4 w0 = *(const u32x4*)(SV + (rb + s0) * 512 + col), w1 = *(const u32x4*)(SV + (rb + s0 + 1) * 512 + col);
            const f32x4 g0 = *(const f32x4*)(gv + col), g1 = *(const f32x4*)(gv + col + 4);
            const float m0 = st[2 * s0], r0 = st[2 * s0 + 1], m1 = st[2 * s0 + 2], r1 = st[2 * s0 + 3];
#pragma unroll
            for (int j = 0; j < 8; ++j) { const float gj = j < 4 ? g0[j] : g1[j - 4];
                const float x0 = (j & 1) ? __uint_as_float(w0[j >> 1] & 0xffff0000u) : __uint_as_float(w0[j >> 1] << 16);
                const float x1 = (j & 1) ? __uint_as_float(w1[j >> 1] & 0xffff0000u) : __uint_as_float(w1[j >> 1] << 16);
                *(LAS unsigned*)(vnT + (size_t)(8 * c + j) * 272 + 2 * s0) = pk2((x0 - m0) * r0 * gj, (x1 - m1) * r1 * gj); }
        }
        __syncthreads();
        const int g = gh * 4 + gl;
        f32x16 acc[4];
#pragma unroll
        for (int tt = 0; tt < 4; ++tt) acc[tt] = (f32x16){};
        const float* Wg = F.in[I_WSP] + ((size_t)l * 8 + g) * 128 * 128;
#pragma unroll
        for (int kk = 0; kk < 8; ++kk) {
            const bf16x8 bfrag = *(const LAS bf16x8*)(vnT + (size_t)(gl * 64 + dh * 32 + r32) * 272 + (16 * kk + 8 * hi) * 2);
#pragma unroll
            for (int tt = 0; tt < 4; ++tt) if (kk < 2 * (tt + 1)) {
                const int t = 32 * tt + r32, s0 = 16 * kk + 8 * hi;
                const f32x4 w0 = *(const f32x4*)(Wg + t * 128 + s0), w1 = *(const f32x4*)(Wg + t * 128 + s0 + 4);
                float wv[8] = {w0[0], w0[1], w0[2], w0[3], w1[0], w1[1], w1[2], w1[3]};
#pragma unroll
                for (int j = 0; j < 8; ++j) if (s0 + j > t) wv[j] = 0.f;
                u32x4 pa; pa.x = pk2(wv[0], wv[1]); pa.y = pk2(wv[2], wv[3]); pa.z = pk2(wv[4], wv[5]); pa.w = pk2(wv[6], wv[7]);
                acc[tt] = __builtin_amdgcn_mfma_f32_32x32x16_bf16(__builtin_bit_cast(bf16x8, pa), bfrag, acc[tt], 0, 0, 0);
            }
        }
        __syncthreads();
        LAS float* stg = (LAS float*)(vnT + wave * 8192);
        const float* bsp = F.in[I_BSP] + ((size_t)l * 8 + g) * 128;
#pragma unroll
        for (int rnd = 0; rnd < 2; ++rnd) {
#pragma unroll
            for (int t2 = 0; t2 < 2; ++t2)
#pragma unroll
                for (int r = 0; r < 16; ++r) stg[(t2 * 32 + (r & 3) + 8 * (r >> 2) + 4 * hi) * 32 + r32] = acc[2 * rnd + t2][r];
            asm volatile("s_waitcnt lgkmcnt(0)" ::: "memory");
#pragma unroll
            for (int k = 0; k < 4; ++k) {
                const int row = (lane >> 2) + 16 * k, c4 = lane & 3, t = 64 * rnd + row;
                const f32x4 m0 = *(const LAS f32x4*)(stg + row * 32 + 8 * c4), m1 = *(const LAS f32x4*)(stg + row * 32 + 8 * c4 + 4);
                const int col = g * 64 + dh * 32 + 8 * c4; const float bs = bsp[t];
                const u32x4 uw = *(const u32x4*)(U + (rb + t) * 512 + col);
                float o[8]; float sq = 0.f;
#pragma unroll
                for (int j = 0; j < 8; ++j) { const float uu = (j & 1) ? __uint_as_float(uw[j >> 1] & 0xffff0000u) : __uint_as_float(uw[j >> 1] << 16);
                    o[j] = uu * ((j < 4 ? m0[j] : m1[j - 4]) + bs); sq += o[j] * o[j]; }
                store8_bf16(MG + (rb + t) * DM + AW + col, o);
                sq += __shfl_xor(sq, 1); sq += __shfl_xor(sq, 2);
                if (c4 == 0) ssq[(rb + t) * 16 + g * 2 + dh] = sq;
            }
            asm volatile("s_waitcnt lgkmcnt(0)" ::: "memory");
        }
    }
    __syncthreads();
}
#define XB_TMO      128
#define XB_XCNT(j)  (256  + 64 * (j))
#define XB_XSUB(j)  (1280 + 64 * (j))
#define XB_XGEN(j)  (2304 + 64 * (j))
#define XB_TOP      3328
#define XB_TOPGEN   3392
#define XCD_BAR_WORDS 3456
#define XB_SPIN_CAP (1u << 18)

__device__ __forceinline__ unsigned xb_ld(unsigned* p)              { return __hip_atomic_load(p, __ATOMIC_RELAXED, __HIP_MEMORY_SCOPE_AGENT); }
__device__ __forceinline__ unsigned xb_add(unsigned* p, unsigned v) { return __hip_atomic_fetch_add(p, v, __ATOMIC_RELAXED, __HIP_MEMORY_SCOPE_AGENT); }
__device__ __forceinline__ unsigned xb_xcc_id() { return (unsigned)__builtin_amdgcn_s_getreg((3 << 11) | 20) & 0xFu; }
#define XB_SPIN(cond, bar) do { unsigned _sp = 0; while (cond) { __builtin_amdgcn_s_sleep(1); \
    if ((++_sp & 255u) == 0u) { if (xb_ld(&(bar)[XB_TMO])) break; if (_sp > XB_SPIN_CAP) { atomicAdd(&(bar)[XB_TMO], 1u); break; } } } } while (0)

struct XcdBarrier {
    unsigned* bar; unsigned x;
    volatile LAS unsigned* st;
};

__device__ __forceinline__ XcdBarrier xcd_barrier_post(unsigned* bar, volatile LAS unsigned* st, const bool leader) {
    XcdBarrier b; b.bar = bar; b.x = xb_xcc_id(); b.st = st;
    if (leader) (void)xb_add(&bar[XB_XCNT(b.x)], 1u);
    return b;
}
__device__ __forceinline__ void xcd_barrier_complete(unsigned* bar, unsigned x, unsigned& nloc, unsigned& nx) {
    const unsigned G = gridDim.x * gridDim.y * gridDim.z;
    unsigned sum, cnt, mine, sp = 0u;
    for (;;) {
        sum = 0u; cnt = 0u; mine = 0u;
#pragma unroll
        for (unsigned j = 0; j < 16; ++j) { const unsigned c = xb_ld(&bar[XB_XCNT(j)]); sum += c; cnt += (c > 0u) ? 1u : 0u; mine = (j == x) ? c : mine; }
        if (sum == G) break;
        __builtin_amdgcn_s_sleep(1);
        if ((++sp & 255u) == 0u) { if (xb_ld(&bar[XB_TMO])) break; if (sp > XB_SPIN_CAP) { atomicAdd(&bar[XB_TMO], 1u); break; } }
    }
    nloc = mine > 0u ? mine : 1u; nx = cnt > 0u ? cnt : 1u;
}

__device__ __forceinline__ void xcd_barrier(const XcdBarrier& b, const bool leader) {
    asm volatile("s_waitcnt vmcnt(0)" ::: "memory");
    __syncthreads();
    if (leader) {
        unsigned* bar = b.bar;
        __builtin_amdgcn_s_waitcnt(0);
        unsigned nloc = b.st[0], nx = b.st[1];
        if (nloc == 0u) { xcd_barrier_complete(bar, b.x, nloc, nx); b.st[0] = nloc; b.st[1] = nx; }
        const unsigned old = xb_add(&bar[XB_XSUB(b.x)], 1u);
        const unsigned gen = old / nloc;
        if (old + 1u == (gen + 1u) * nloc) {
            __builtin_amdgcn_fence(__ATOMIC_RELEASE, "agent");
            asm volatile("s_waitcnt vmcnt(0)" ::: "memory");
            const unsigned og = xb_add(&bar[XB_TOP], 1u);
            const unsigned tg = og / nx;
            if (og + 1u == (tg + 1u) * nx) xb_add(&bar[XB_TOPGEN], 1u);
            else XB_SPIN(xb_ld(&bar[XB_TOPGEN]) == tg, bar);
            __builtin_amdgcn_fence(__ATOMIC_ACQUIRE, "agent");
            xb_add(&bar[XB_XGEN(b.x)], 1u);
            asm volatile("s_waitcnt vmcnt(0)" ::: "memory");
        } else {
            XB_SPIN(xb_ld(&bar[XB_XGEN(b.x)]) == gen, bar);
            __builtin_amdgcn_fence(__ATOMIC_ACQUIRE, "agent");
            asm volatile("s_waitcnt vmcnt(0)" ::: "memory");
        }
    }
    __syncthreads();
}

template <int L> __device__ __forceinline__ void layer_phases(Frame& F, const int lo, const int hi, const XcdBarrier& bar) {
#define IN(k) (lo <= (k) && (k) < hi)
#define SEAM(k) do { if (IN(k) && IN((k) + 1)) { xcd_barrier(bar, F.wave == 0 && fresh_lane() == 0); } } while (0)

        constexpr int l = L, pb = 2 + 9 * L; constexpr bool moe = (L & 1) != 0;
        if (IN(pb + 0)) {
            StaticOrder S; S.init(M, NIN, F.G, (int)blockIdx.x, DM); EpiInproj E{(bf16*)(F.ws + WS_QKVUV)};
            gemm_run<FAST_INPROJ>(F, (const bf16*)(F.ws + WS_H), (const bf16*)(F.ws + WS_WIN) + (size_t)l * NIN * DM, DM, S, E);
        }
        SEAM(pb + 0);
        if (IN(pb + 1)) {
#if FAST_ATTN
            attn_fast(F);
#else
            attn_simple(F);
#endif
#if FAST_SGU
            sgu_fast(F, l);
#else
            sgu_simple(F, l);
#endif
        }
#if FUSE_MERGE
        if (IN(pb + 1) && IN(pb + 3)) xcd_barrier(bar, F.wave == 0 && fresh_lane() == 0);
#else
        SEAM(pb + 1);
#endif
#if FUSE_MERGE
#else
        if (IN(pb + 2)) phase_merge_norm(F);
        SEAM(pb + 2);
#endif
        if (IN(pb + 3)) {
#if FUSE_MERGE
            StaticOrder S; S.init(M, DM, F.G, (int)blockIdx.x, DM); SingleOrder S1;
            for (int i = 0; S.next(i, S1.u0); ++i) {
                F.refresh();
                if (F.tid < 256) { const int row = S1.u0.pm * 256 + F.tid; const float* sa = (const float*)(F.ws + WS_SSQA) + (size_t)row * 8; const float* ss = (const float*)(F.ws + WS_SSQS) + (size_t)row * 16;
                    const f32x4 a0 = *(const f32x4*)sa, a1 = *(const f32x4*)(sa + 4), s0 = *(const f32x4*)ss + *(const f32x4*)(ss + 8), s1 = *(const f32x4*)(ss + 4) + *(const f32x4*)(ss + 12);
                    const float ra = 1.0f / sqrtf(((a0.x + a0.y) + (a0.z + a0.w) + (a1.x + a1.y) + (a1.z + a1.w)) * (1.f / AW) + EPS);
                    const float rs = 1.0f / sqrtf(((s0.x + s0.y) + (s0.z + s0.w) + (s1.x + s1.y) + (s1.z + s1.w)) * (1.f / AW) + EPS);
                    LAS float* rt = (LAS float*)(F.lds + RTAB_OFF); rt[2 * F.tid] = ra / rs; rt[2 * F.tid + 1] = rs; }
                __syncthreads();
                const Gemm g{(const bf16*)(F.ws + WS_MG), (const bf16*)(F.ws + WS_WOUT) + (size_t)l * DM * DM, 0, 0, DM}; const EpiWrap<EpiYscaled> W{EpiYscaled{(bf16*)(F.ws + WS_Y), F.lds}};
                gemm_phase<EpiWrap<EpiYscaled>, SingleOrder, true, true, false, true>(F.lds, g, S1, W, F.wave);
                __syncthreads();
            }
#else
            StaticOrder S; S.init(M, DM, F.G, (int)blockIdx.x, DM); EpiYbf16 E{(bf16*)(F.ws + WS_Y)};
            gemm_run<FAST_OUTPROJ>(F, (const bf16*)(F.ws + WS_MG2), (const bf16*)(F.ws + WS_WOUT) + (size_t)l * DM * DM, DM, S, E);
#endif
        }
        SEAM(pb + 3);
        if (IN(pb + 4)) phase_postmix(F, l, l == 0 ? F.in[I_X] : F.out, moe);
        if (moe) { SEAM(pb + 4); if (IN(pb + 5)) phase_scatter(F); SEAM(pb + 5); }
        else { if (IN(pb + 4) && IN(pb + 6)) xcd_barrier(bar, F.wave == 0 && fresh_lane() == 0); }
        if (IN(pb + 6)) {
            if (!moe) { StaticOrder S; S.init(M, 2 * DFF, F.G, (int)blockIdx.x, DM); EpiSwiglu E{(bf16*)(F.ws + WS_ACT), DFF, 2 * DFF / 256};
                gemm_run<FAST_FFN1D>(F, (const bf16*)(F.ws + WS_H), (const bf16*)(F.ws + WS_WGU), DM, S, E); }
            else { MoeOrder S; S.init(F.ctl + CW_CNT, 2 * EFF / 256, F.G, (int)blockIdx.x, DM, false); EpiSwiglu E{(bf16*)(F.ws + WS_ACT), EFF, 2 * EFF / 256};
                gemm_run<FAST_FFN1E>(F, (const bf16*)(F.ws + WS_HS), (const bf16*)(F.ws + WS_EGU), DM, S, E); }
        }
        SEAM(pb + 6);
        if (IN(pb + 7)) {
            if (!moe) { StaticOrder S; S.init(M, DM, F.G, (int)blockIdx.x, DFF); EpiYbf16 E{(bf16*)(F.ws + WS_Y)};
                gemm_run<FAST_FFN2D>(F, (const bf16*)(F.ws + WS_ACT), (const bf16*)(F.ws + WS_WD), DFF, S, E); }
            else { MoeOrder S; S.init(F.ctl + CW_CNT, DM / 256, F.G, (int)blockIdx.x, EFF, true); EpiF32 E{(float*)(F.ws + WS_YS), DM, 4, (float*)(F.ws + WS_PART)};
                gemm_run<FAST_FFN2E, true>(F, (const bf16*)(F.ws + WS_ACT), (const bf16*)(F.ws + WS_ED), EFF, S, E); }
        }
        SEAM(pb + 7);
        if (IN(pb + 8)) phase_final(F, l, moe);
        SEAM(pb + 8);
#undef SEAM
#undef IN
}
struct Args { const float* in[21]; float* out; unsigned char* ws; int ph_lo, ph_hi, li, pad; };
constexpr int NPHASES = 20;
__global__ void __launch_bounds__(NTHREADS, 2) fwd(Args args) {
    extern __shared__ __attribute__((aligned(16))) unsigned char lds[];
    Frame F;
    F.lds = (LAS unsigned char*)lds; F.wave = __builtin_amdgcn_readfirstlane((int)threadIdx.x >> 6); F.refresh();
    F.G = gridDim.x; { const int bx = blockIdx.x; F.vcu = (F.G % 8 == 0) ? (bx % 8) * (F.G / 8) + bx / 8 : bx; }
    F.ws = args.ws; F.ctl = (unsigned*)(args.ws + WS_CTL); F.out = args.out;
#pragma unroll
    for (int i = 0; i < 21; ++i) F.in[i] = args.in[i];
    const int lo = args.ph_lo, hi = args.ph_hi;
    volatile LAS unsigned* MISC = (volatile LAS unsigned*)(F.lds + MISC_OFF);
    if (F.tid < 32) MISC[F.tid] = 0u;
    __syncthreads();
    const XcdBarrier bar = xcd_barrier_post(F.ctl + CW_BAR + args.li * XCD_BAR_WORDS, MISC + 8, F.tid == 0);
#define IN(k) (lo <= (k) && (k) < hi)
    if (IN(0)) p0_prologue(F);
    if (IN(0) && IN(1)) xcd_barrier(bar, F.wave == 0 && fresh_lane() == 0);
    if (IN(1)) phase_premix(F, 0, F.in[I_X]);
    if (IN(1) && IN(2)) xcd_barrier(bar, F.wave == 0 && fresh_lane() == 0);
    layer_phases<0>(F, lo, hi, bar);
    layer_phases<1>(F, lo, hi, bar);
#undef IN
}

extern "C" void kernel_launch(void* const* d_in, const int* in_sizes, int n_in, void* d_out, int out_size, void* d_ws, size_t ws_size, hipStream_t stream) {
    static int grid = 0;
    if (grid == 0) {
        if (n_in != 21 || out_size != M * DM || ws_size < WS_END) { fprintf(stderr, "kernel_launch: unexpected problem (n_in %d out %d ws %zu)\n", n_in, out_size, ws_size); grid = -1; return; }
        int dev = 0, cus = 0;
        if (hipGetDevice(&dev) != hipSuccess || hipDeviceGetAttribute(&cus, hipDeviceAttributeMultiprocessorCount, dev) != hipSuccess) { grid = -1; return; }
        if (hipFuncSetAttribute((const void*)fwd, hipFuncAttributeMaxDynamicSharedMemorySize, LDS_BYTES) != hipSuccess) { grid = -1; return; }
        grid = cus;
    }
    if (grid < 0) return;
    (void)hipMemsetAsync((char*)d_ws + WS_CTL, 0, CTL_ZERO_BYTES, stream);
    Args a{};
    for (int i = 0; i < 21; ++i) a.in[i] = (const float*)d_in[i];
    a.out = (float*)d_out; a.ws = (unsigned char*)d_ws;
#ifndef N_LAUNCH
#define N_LAUNCH 1
#endif
#if N_LAUNCH == 1
    a.ph_lo = 0; a.ph_hi = NPHASES; a.li = 0;
    hipLaunchKernelGGL(fwd, dim3(grid), dim3(NTHREADS), LDS_BYTES, stream, a);
#else
    for (int p = 0; p < NPHASES; ++p) {
        if (p == 2 + 5) continue;
#if FUSE_MERGE
        if (p == 2 + 2 || p == 11 + 2) continue;
#endif
        a.ph_lo = p; a.ph_hi = p + 1; a.li = 0;
        hipLaunchKernelGGL(fwd, dim3(grid), dim3(NTHREADS), LDS_BYTES, stream, a);
    }
#endif
}
```

```cpp
#include <hip/hip_runtime.h>
#include <cstdio>
#include <cstdint>
#include <type_traits>

#define GAS __attribute__((address_space(1)))
#define LAS __attribute__((address_space(3)))
typedef unsigned short bf16;
typedef float f32x4 __attribute__((ext_vector_type(4)));
typedef float f32x2 __attribute__((ext_vector_type(2)));
typedef unsigned u32x4 __attribute__((ext_vector_type(4)));
typedef unsigned u32x2 __attribute__((ext_vector_type(2)));
typedef unsigned long long u64;

constexpr int NB = 8, SEQ = 2048, DM = 1024, M = NB * SEQ, NL = 2;
constexpr int AW = 512, NH = 8, HD = 64, NIN = 2560, INC = 2568, DFF = 2816, EFF = 3584, NE = 8, NMOD = 6;
constexpr int CAPROWS = 2 * M + NE * 256;
constexpr float EPS = 1e-6f;
constexpr float LOG2E = 1.4426950408889634f;
constexpr float C2 = 0.125f * LOG2E;
constexpr int NWAVES = 8, NTHREADS = 512;

constexpr size_t MiB = 1u << 20;
constexpr size_t WS_CTL = 0, CTL_ZERO_BYTES = 64 * 1024;
constexpr size_t WS_MOD = 1 * MiB;
constexpr size_t WS_WF = 1 * MiB + 512 * 1024;
constexpr size_t WS_WR = WS_WF + 64 * 1024;
constexpr size_t WS_LOGF = 2 * MiB;
constexpr size_t WS_SSQA = 2 * MiB + 512 * 1024;
constexpr size_t WS_SSQS = 3 * MiB;
constexpr size_t WS_TOK = 512 * 1024;
constexpr size_t WS_WIN = 4 * MiB;
constexpr size_t WS_WOUT = 14 * MiB;
constexpr size_t WS_WGU = 18 * MiB;
constexpr size_t WS_WD = 29 * MiB;
constexpr size_t WS_EGU = 35 * MiB;
constexpr size_t WS_ED = 147 * MiB;
constexpr size_t WS_PART = WS_EGU;
constexpr size_t WS_H = 203 * MiB;
constexpr size_t WS_QKVUV = 235 * MiB;
constexpr size_t WS_MG = 315 * MiB;
constexpr size_t WS_Y = 347 * MiB;
constexpr size_t WS_YS = WS_QKVUV;
constexpr size_t WS_ACT = 411 * MiB;
constexpr size_t WS_HS = 649 * MiB;
constexpr size_t WS_MG2 = WS_HS;
constexpr size_t WS_XR = 717 * MiB;
constexpr size_t WS_END = 749 * MiB;
static_assert(WS_YS + (size_t)CAPROWS * DM * 4 <= WS_ACT && WS_ACT + (size_t)CAPROWS * EFF * 2 <= WS_HS && WS_HS + (size_t)CAPROWS * DM * 2 <= WS_XR && WS_XR + (size_t)M * DM * 2 <= WS_END, "ws map");
constexpr int CW_TMO = 0, CW_CODE = 1, CW_BAR = 4096, CW_CNT = 8192;

constexpr int RING_BYTES = 131072, MISC_OFF = RING_BYTES + 320, LDS_BYTES = 147456;

__device__ __forceinline__ float bf2f(bf16 v) { return __uint_as_float((unsigned)v << 16); }
__device__ __forceinline__ unsigned f2bf(float f) { unsigned u = __float_as_uint(f); return (u + 0x7fffu + ((u >> 16) & 1u)) >> 16; }
typedef __bf16 bf16x2_t __attribute__((ext_vector_type(2)));
__device__ __forceinline__ unsigned pk2(float lo, float hi) { const f32x2 v = {lo, hi}; return __builtin_bit_cast(unsigned, __builtin_convertvector(v, bf16x2_t)); }
__device__ __forceinline__ float wave_sum(float v) {
#pragma unroll
    for (int o = 1; o < 64; o <<= 1) v += __shfl_xor(v, o);
    return v;
}
__device__ __forceinline__ float gelu_tanh(float x) {
    const float u = x * (-2.f * 0.7978845608028654f * LOG2E) * (1.f + 0.044715f * x * x);
    return x * __builtin_amdgcn_rcpf(1.f + __builtin_amdgcn_exp2f(u));
}
__device__ __forceinline__ float silu_f(float x) { return x * __builtin_amdgcn_rcpf(1.f + __builtin_amdgcn_exp2f(-LOG2E * x)); }
__device__ __forceinline__ float dot4(f32x4 a, f32x4 b) { return (a.x * b.x + a.y * b.y) + (a.z * b.z + a.w * b.w); }
__device__ __forceinline__ void store8_bf16(bf16* p, const float (&v)[8]) {
    u32x4 w; w.x = pk2(v[0], v[1]); w.y = pk2(v[2], v[3]); w.z = pk2(v[4], v[5]); w.w = pk2(v[6], v[7]); *(u32x4*)p = w;
}
__device__ __forceinline__ void store8_f32(float* p, const float (&v)[8]) {
    *(f32x4*)p = (f32x4){v[0], v[1], v[2], v[3]}; *(f32x4*)(p + 4) = (f32x4){v[4], v[5], v[6], v[7]};
}

constexpr float W8_SCALE = 32.f, A8_SCALE = 4.f;
__device__ __forceinline__ float clamp8(float x) { return __builtin_fminf(__builtin_fmaxf(x, -440.f), 440.f); }
__device__ __forceinline__ u32x2 pk8_fp8(const float (&v)[8]) {
    int w0 = 0, w1 = 0;
    w0 = __builtin_amdgcn_cvt_pk_fp8_f32(clamp8(v[0]), clamp8(v[1]), w0, false); w0 = __builtin_amdgcn_cvt_pk_fp8_f32(clamp8(v[2]), clamp8(v[3]), w0, true);
    w1 = __builtin_amdgcn_cvt_pk_fp8_f32(clamp8(v[4]), clamp8(v[5]), w1, false); w1 = __builtin_amdgcn_cvt_pk_fp8_f32(clamp8(v[6]), clamp8(v[7]), w1, true);
    return (u32x2){(unsigned)w0, (unsigned)w1};
}
__device__ __forceinline__ int fresh_lane() { int l; asm volatile("v_mbcnt_lo_u32_b32 %0, -1, 0\n\tv_mbcnt_hi_u32_b32 %0, -1, %0" : "=v"(l)); return l; }
struct Frame {
    LAS unsigned char* lds;
    unsigned* ctl;
    int tid, lane, wave, vcu, G;
    __device__ __forceinline__ void refresh() { lane = fresh_lane(); tid = wave * 64 + lane; }
    unsigned char* ws;
    const float* in[21];
    float* out;
};
enum { I_X = 0, I_C, I_WADA, I_BADA, I_GPREMIX, I_GPOSTMIX, I_GPREFFN, I_GPOSTFFN, I_WIN, I_BFORGET, I_GV, I_WSP, I_BSP, I_GOA, I_GOS, I_WOUT, I_WGUD, I_WDD, I_WROUTER, I_WGUE, I_WDE };

struct Unit { int pm, pn, kt0, nkt, part; };
struct StaticOrder {
    int nM, nN, nwg, G, c, nkt;
    __device__ void init(int M_, int N_, int G_, int c_, int K_) { nM = M_ / 256; nN = N_ / 256; nwg = nM * nN; G = G_; c = c_; nkt = K_ / 64; }
    __device__ bool next(int i, Unit& u) const {
        const long L = (long)i * G + c; if (L >= nwg) return false;
        int wgid = (int)L; { const int q = nwg / 8, r = nwg % 8, xcd = wgid % 8, off = wgid / 8; wgid = (xcd < r ? xcd * (q + 1) : r * (q + 1) + (xcd - r) * q) + off; }
        const int nig = 8 * nN, gid = wgid / nig, fm = gid * 8, gsz = (nM - fm) < 8 ? (nM - fm) : 8;
        u.pm = fm + ((wgid % nig) % gsz); u.pn = (wgid % nig) / gsz; u.kt0 = 0; u.nkt = nkt; u.part = -1; return true;
    }
    __device__ __forceinline__ void a_ready(const Unit&) const {}
    __device__ __forceinline__ void done(const Unit&) const {}
};
struct MoeLayout {
    int P1, P2, P3, P4, P5, P6, P7, P8;
    __device__ void init(const unsigned* cnt) {
#define RFL(x) __builtin_amdgcn_readfirstlane((int)(x))
        int c0 = RFL(cnt[0]), c1 = RFL(cnt[64]), c2 = RFL(cnt[128]), c3 = RFL(cnt[192]), c4 = RFL(cnt[256]), c5 = RFL(cnt[320]), c6 = RFL(cnt[384]), c7 = RFL(cnt[448]);
#undef RFL
        P1 = (c0 + 255) >> 8; P2 = P1 + ((c1 + 255) >> 8); P3 = P2 + ((c2 + 255) >> 8); P4 = P3 + ((c3 + 255) >> 8);
        P5 = P4 + ((c4 + 255) >> 8); P6 = P5 + ((c5 + 255) >> 8); P7 = P6 + ((c6 + 255) >> 8); P8 = P7 + ((c7 + 255) >> 8);
        if (P8 > CAPROWS / 256) P8 = CAPROWS / 256;
    }
    __device__ __forceinline__ int expert_of_panel(int p) const { return (p >= P1) + (p >= P2) + (p >= P3) + (p >= P4) + (p >= P5) + (p >= P6) + (p >= P7); }
    __device__ __forceinline__ int panel_base(int e) const { int b = 0; b = e == 1 ? P1 : b; b = e == 2 ? P2 : b; b = e == 3 ? P3 : b; b = e == 4 ? P4 : b; b = e == 5 ? P5 : b; b = e == 6 ? P6 : b; b = e == 7 ? P7 : b; return b; }
};
struct MoeOrder {
    MoeLayout Lay; int NT, G, c, nkt, U, R, Lf, sp, q0, r0;
    __device__ void init(const unsigned* cnt, int NT_, int G_, int c_, int K_, bool split) {
        Lay.init(cnt); NT = NT_; G = G_; c = c_; nkt = K_ / 64; U = Lay.P8 * NT; R = U / G; Lf = U - R * G; sp = 1; q0 = U / 8; r0 = U % 8;
        if (split) {
#define SP_OK(v) (nkt % (v) == 0 && ((nkt / (v)) & 1) == 0 && nkt / (v) >= 4 && Lf * (v) <= G)
            if (SP_OK(2)) sp = 2; if (SP_OK(4)) sp = 4; if (SP_OK(7)) sp = 7; if (SP_OK(14)) sp = 14;
#undef SP_OK
        }
    }
    __device__ __forceinline__ int remap(int L) const { const int x = L & 7, off = L >> 3; return (x < r0 ? x * (q0 + 1) : r0 * (q0 + 1) + (x - r0) * q0) + off; }
    __device__ __forceinline__ int unmap(int W) const { const int t = W - r0 * (q0 + 1); return t < 0 ? (W % (q0 + 1)) * 8 + W / (q0 + 1) : (t % q0) * 8 + r0 + t / q0; }
    __device__ __forceinline__ void decode(int Lin, Unit& u) const {
        const int L = remap(Lin); const int TP = Lay.P8, nig = 8 * NT, gid = L / nig, fm = gid * 8, gsz = (TP - fm) < 8 ? (TP - fm) : 8, r = L % nig;
        const int p = fm + r % gsz, j = r / gsz;
        u.pm = p; u.pn = Lay.expert_of_panel(p) * NT + j;
    }
    __device__ __forceinline__ int unit_index(int p, int j) const {
        const int TP = Lay.P8, gid = p >> 3, fm = gid * 8, gsz = (TP - fm) < 8 ? (TP - fm) : 8;
        return unmap(gid * 8 * NT + j * gsz + (p - fm));
    }
    __device__ bool next(int i, Unit& u) const {
        if (i < R) { decode(i * G + c, u); u.kt0 = 0; u.nkt = nkt; u.part = -1; return true; }
        if (i == R && c < Lf * sp) { const int q = c % Lf, sl = c / Lf; decode(R * G + q, u); u.nkt = nkt / sp; u.kt0 = sl * u.nkt; u.part = sp > 1 ? q * 14 + sl : -1; return true; }
        return false;
    }
    __device__ __forceinline__ void a_ready(const Unit&) const {}
    __device__ __forceinline__ void done(const Unit&) const {}
};

struct EpiInproj {
    bf16* base;
    __device__ __forceinline__ void pair8(const Unit& u, int row, int c, const float (&lo)[8], const float (&hi)[8]) const {
        const int t = u.pn >> 1; bf16* dst = base + (size_t)t * M * 512 + (size_t)row * 512 + (u.pn & 1) * 256 + c;
        float a[8], b[8];
#pragma unroll
        for (int i = 0; i < 8; ++i) { float x = lo[i], y = hi[i]; if (t == 0) { x *= C2; y *= C2; } else if (t >= 3) { x = gelu_tanh(x); y = gelu_tanh(y); } a[i] = x; b[i] = y; }
        store8_bf16(dst, a); store8_bf16(dst + 128, b);
    }
};
struct EpiF32 {
    float* O; int ldc, ntn; float* part; float scale;
    __device__ __forceinline__ void pair8(const Unit& u, int row, int c, const float (&lo)[8], const float (&hi)[8]) const {
        const bool sp = u.part >= 0; const int ld = sp ? 256 : ldc;
        float* base = sp ? part + (long)(u.part - u.pm) * 65536 : O + (u.pn % ntn) * 256;
        float a[8], b[8];
#pragma unroll
        for (int i = 0; i < 8; ++i) { a[i] = lo[i] * scale; b[i] = hi[i] * scale; }
        float* dst = base + (size_t)row * ld + c; store8_f32(dst, a); store8_f32(dst + 128, b);
    }
};
struct EpiYbf16 {
    bf16* O;
    __device__ __forceinline__ void pair8(const Unit& u, int row, int c, const float (&lo)[8], const float (&hi)[8]) const {
        bf16* dst = O + (size_t)row * DM + (u.pn & 3) * 256 + c; store8_bf16(dst, lo); store8_bf16(dst + 128, hi);
    }
};
constexpr int RTAB_OFF = 132096;
struct EpiYscaled {
    bf16* O; LAS unsigned char* lds;
    __device__ __forceinline__ void pair8(const Unit& u, int row, int c, const float (&lo)[8], const float (&hi)[8]) const {
        const float rs = ((const LAS float*)(lds + RTAB_OFF))[2 * (row & 255) + 1]; float a[8], b[8];
#pragma unroll
        for (int i = 0; i < 8; ++i) { a[i] = lo[i] * rs; b[i] = hi[i] * rs; }
        bf16* dst = O + (size_t)row * DM + (u.pn & 3) * 256 + c; store8_bf16(dst, a); store8_bf16(dst + 128, b);
    }
};
struct SingleOrder {
    Unit u0;
    __device__ __forceinline__ bool next(int i, Unit& u) const { if (i != 0) return false; u = u0; return true; }
    __device__ __forceinline__ void a_ready(const Unit&) const {}
    __device__ __forceinline__ void done(const Unit&) const {}
};
struct EpiSwiglu8 {
    unsigned char* O; int ldc, ntn;
    __device__ __forceinline__ void pair8(const Unit& u, int row, int c, const float (&lo)[8], const float (&hi)[8]) const {
        float a[8];
#pragma unroll
        for (int i = 0; i < 8; ++i) a[i] = silu_f(lo[i] * (1.f / W8_SCALE)) * hi[i] * (A8_SCALE / W8_SCALE);
        *(u32x2*)(O + (size_t)row * ldc + (u.pn % ntn) * 128 + c) = pk8_fp8(a);
    }
};
struct EpiSwiglu {
    bf16* O; int ldc, ntn;
    __device__ __forceinline__ void pair8(const Unit& u, int row, int c, const float (&lo)[8], const float (&hi)[8]) const {
        float a[8];
#pragma unroll
        for (int i = 0; i < 8; ++i) a[i] = silu_f(lo[i]) * hi[i];
        store8_bf16(O + (size_t)row * ldc + (u.pn % ntn) * 128 + c, a);
    }
};

#define PG8_LAS __attribute__((address_space(3)))
typedef short bf16x8 __attribute__((ext_vector_type(8)));
typedef int v4i_t __attribute__((ext_vector_type(4)));
typedef int v8i_t __attribute__((ext_vector_type(8)));
typedef unsigned short bf16_t;
constexpr int BM = 256, BK = 64, HALF = 128, HTB = HALF * BK * 2, STAGE_BYTES = 8 * HTB;
__host__ __device__ __forceinline__ int lds_byte(int r, int c) { const int st = (r >> 4) * 2 + (c >> 5), rr = r & 15, cc = c & 31, ob = rr * 64 + cc * 2; return st * 1024 + (ob ^ (((ob >> 9) & 1) << 5)); }
__host__ __device__ __forceinline__ void stage_rc(int b, int& R, int& C) { const int st = b / 1024, sb = b % 1024, swz = sb ^ (((sb >> 9) & 1) << 5); R = (st >> 1) * 16 + swz / 64; C = (st & 1) * 32 + (swz % 64) / 2; }
__host__ __device__ __forceinline__ int perm32(int rho) { const int n = rho >> 4, i = rho & 15; return 8 * (i >> 2) + 4 * n + (i & 3); }
struct Gemm { const bf16_t* A; const bf16_t* Bt; int M, N, K; };
template <class E> struct EpiWrap {
    static constexpr bool PERM = true, AFTER_DRAIN = false; E e;
    __device__ __forceinline__ void operator()(const f32x4 (&acc)[2][2][4][2], const Unit& u, int wr, int wc, int fr, int fq) const {
#pragma unroll
        for (int ai = 0; ai < 2; ++ai)
#pragma unroll
            for (int m = 0; m < 4; ++m) { const int row = u.pm * BM + ai * HALF + wr * 64 + m * 16 + fr;
                const f32x4 a0 = acc[ai][0][m][0], a1 = acc[ai][0][m][1], b0 = acc[ai][1][m][0], b1 = acc[ai][1][m][1];
                const float lo[8] = {a0[0], a0[1], a0[2], a0[3], a1[0], a1[1], a1[2], a1[3]}, hi[8] = {b0[0], b0[1], b0[2], b0[3], b1[0], b1[1], b1[2], b1[3]};
                e.pair8(u, row, wc * 32 + 8 * fq, lo, hi); }
    }
};
template <class Epi, class Sched, bool ALIGN_EPI = false, bool SP2 = false, bool VARK = false, bool MIDSCALE = false, bool F8 = false>
__device__ __forceinline__ void gemm_phase(PG8_LAS unsigned char* lds, const Gemm g, const Sched& S, const Epi& E, const int wid) {
    const int lane = fresh_lane(), tid = wid * 64 + lane, wr = wid >> 2, wc = wid & 3, fr = lane & 15, fq = lane >> 4;
    const int K = g.K;
    struct Frag16 { bf16x8 k[2]; }; typedef v8i_t Frag32; using FragT = typename std::conditional<F8, Frag32, Frag16>::type;
    unsigned voffA[1], voffB[1];
    { int R, C; stage_rc(tid * 16, R, C); const int Rb = Epi::PERM ? ((R & ~31) + perm32(R & 31)) : R;
        voffA[0] = (unsigned)(R * K + C) * 2u; voffB[0] = (unsigned)(Rb * K + C) * 2u; }
    const size_t rstep = (size_t)64 * K * 2;
    const size_t kstep = (size_t)(BK * 2);
    const size_t hstep = (size_t)HALF * K * 2;
    const size_t tstep = 2 * hstep;
    const unsigned ldsw = (unsigned)wid * 1024u;
    const int aoff = lds_byte(wr * 64 + fr, fq * 8), boff = lds_byte(wc * 32 + fr, fq * 8);
#define PG8_SA(b, h) (((b) * 2 + (h)) * HTB)
#define PG8_SB(b, h) ((4 + (b) * 2 + (h)) * HTB)
#define PG8_STAGE(bufoff, gbase, voff) do { _Pragma("unroll") for (int _i = 0; _i < 2; ++_i) \
        __builtin_amdgcn_global_load_lds((const unsigned*)((const char*)(gbase) + (size_t)_i * rstep + (voff)[0]), (PG8_LAS unsigned*)(lds + (bufoff) + ldsw + _i * 8192), 16, 0, 0); } while (0)
#define PG8_LD16(base_, off_) (*(const PG8_LAS bf16x8*)(lds + (base_) + (off_)))
#define PG8_LD32(base_, off_) __builtin_shufflevector(__builtin_bit_cast(v4i_t, PG8_LD16(base_, off_)), __builtin_bit_cast(v4i_t, PG8_LD16(base_, (off_) + 1024)), 0, 1, 2, 3, 4, 5, 6, 7)
#define PG8_LDA(dst, b, h) do { _Pragma("unroll") for (int m = 0; m < 4; ++m) { if constexpr (F8) dst[m] = PG8_LD32(PG8_SA(b, h), aoff + m * 2048); else { _Pragma("unroll") for (int k = 0; k < 2; ++k) dst[m].k[k] = PG8_LD16(PG8_SA(b, h), aoff + m * 2048 + k * 1024); } } } while (0)
#define PG8_LDB(dst, b, h) do { _Pragma("unroll") for (int n = 0; n < 2; ++n) { if constexpr (F8) dst[n] = PG8_LD32(PG8_SB(b, h), boff + n * 2048); else { _Pragma("unroll") for (int k = 0; k < 2; ++k) dst[n].k[k] = PG8_LD16(PG8_SB(b, h), boff + n * 2048 + k * 1024); } } } while (0)
#define PG8_MMA(ai, bj, At, Bt) do { __builtin_amdgcn_s_setprio(1); if constexpr (F8) { _Pragma("unroll") for (int m = 0; m < 4; ++m) _Pragma("unroll") for (int n = 0; n < 2; ++n) \
            asm volatile("v_mfma_scale_f32_16x16x128_f8f6f4 %0, %1, %2, %0, %3, %3 op_sel_hi:[0,0,0]" : "+v"(acc[ai][bj][m][n]) : "v"(Bt[n]), "v"(At[m]), "v"(sc8_)); } \
        else { _Pragma("unroll") for (int m = 0; m < 4; ++m) _Pragma("unroll") for (int n = 0; n < 2; ++n) _Pragma("unroll") for (int k = 0; k < 2; ++k) \
        acc[ai][bj][m][n] = __builtin_amdgcn_mfma_f32_16x16x32_bf16(Bt[n].k[k], At[m].k[k], acc[ai][bj][m][n], 0, 0, 0); } __builtin_amdgcn_s_setprio(0); } while (0)
#define PG8_WAIT_V(n) asm volatile("s_waitcnt vmcnt(" #n ")" ::: "memory")
#define PG8_WAIT_L(n) asm volatile("s_waitcnt lgkmcnt(" #n ")" ::: "memory")
#define PG8_BAR __builtin_amdgcn_s_barrier()
#define PG8_SCHED __builtin_amdgcn_sched_barrier(0)
    Unit cur, nxt; int ui = 0;
    if (!S.next(0, cur)) return;
    f32x4 acc[2][2][4][2];
#pragma unroll
    for (int a = 0; a < 2; ++a)
#pragma unroll
        for (int b = 0; b < 2; ++b)
#pragma unroll
            for (int m = 0; m < 4; ++m)
#pragma unroll
                for (int n = 0; n < 2; ++n) acc[a][b][m][n] = (f32x4){0.f, 0.f, 0.f, 0.f};
    FragT At[4], B0[2], B1[2];
    int sc8_ = 0x7f7f7f7f; asm volatile("" : "+v"(sc8_));
    const char* cA = (const char*)g.A + (size_t)cur.pm * tstep + (VARK ? (size_t)cur.kt0 * kstep : 0); const char* cB = (const char*)g.Bt + (size_t)cur.pn * tstep + (VARK ? (size_t)cur.kt0 * kstep : 0);
    S.a_ready(cur);
    if constexpr (SP2) {
        PG8_STAGE(PG8_SB(0, 0), cB, voffB); PG8_STAGE(PG8_SB(0, 1), cB + hstep, voffB); PG8_STAGE(PG8_SA(0, 0), cA, voffA); PG8_STAGE(PG8_SA(0, 1), cA + hstep, voffA);
        if (wr == 1) PG8_BAR;
        PG8_WAIT_V(2); PG8_BAR;
        PG8_STAGE(PG8_SB(1, 0), cB + kstep, voffB); PG8_STAGE(PG8_SA(1, 0), cA + kstep, voffA); PG8_STAGE(PG8_SB(1, 1), cB + hstep + kstep, voffB);
        PG8_WAIT_V(6); PG8_BAR;
    } else {
        PG8_STAGE(PG8_SB(0, 0), cB, voffB); PG8_STAGE(PG8_SA(0, 0), cA, voffA); PG8_STAGE(PG8_SB(0, 1), cB + hstep, voffB); PG8_STAGE(PG8_SA(0, 1), cA + hstep, voffA);
        if (wr == 1) PG8_BAR;
        PG8_WAIT_V(4); PG8_BAR;
        PG8_STAGE(PG8_SB(1, 0), cB + kstep, voffB); PG8_STAGE(PG8_SA(1, 0), cA + kstep, voffA); PG8_STAGE(PG8_SB(1, 1), cB + hstep + kstep, voffB);
        PG8_WAIT_V(6); PG8_BAR;
    }
    for (;;) {
        const bool has_next = S.next(ui + 1, nxt);
        const char* nA = has_next ? (const char*)g.A + (size_t)nxt.pm * tstep + (VARK ? (size_t)nxt.kt0 * kstep : 0) : cA; const char* nB = has_next ? (const char*)g.Bt + (size_t)nxt.pn * tstep + (VARK ? (size_t)nxt.kt0 * kstep : 0) : cB;
        const int nt = VARK ? cur.nkt : K / BK;
#pragma clang loop unroll(disable)
        for (int t = 0; t < nt; t += 2) {
            if constexpr (MIDSCALE) { if (t == nt / 2) {
                const PG8_LAS float* rt = (const PG8_LAS float*)(lds + RTAB_OFF);
                _Pragma("unroll") for (int a = 0; a < 2; ++a) _Pragma("unroll") for (int m = 0; m < 4; ++m) { const float rr = rt[2 * (a * HALF + wr * 64 + m * 16 + fr)];
                    _Pragma("unroll") for (int b = 0; b < 2; ++b) _Pragma("unroll") for (int n = 0; n < 2; ++n) acc[a][b][m][n] = acc[a][b][m][n] * rr; } } }
            const bool last = (t == nt - 2);
            const char* a1 = cA + (size_t)(t + 1) * kstep;
            const char* a2 = last ? nA : cA + (size_t)(t + 2) * kstep; const char* b2 = last ? nB : cB + (size_t)(t + 2) * kstep;
            const char* a3 = a2 + kstep; const char* b3 = b2 + kstep;
            if (last && has_next) S.a_ready(nxt);
            if constexpr (SP2) {
            PG8_LDB(B0, 0, 0); PG8_LDB(B1, 0, 1); PG8_SCHED; PG8_LDA(At, 0, 0); PG8_STAGE(PG8_SA(1, 1), a1 + hstep, voffA);
            PG8_WAIT_V(8); PG8_WAIT_L(0); PG8_BAR; PG8_MMA(0, 0, At, B0); PG8_MMA(0, 1, At, B1); PG8_BAR; PG8_SCHED;
            PG8_LDA(At, 0, 1); PG8_STAGE(PG8_SB(0, 0), b2, voffB); PG8_STAGE(PG8_SB(0, 1), b2 + hstep, voffB); PG8_STAGE(PG8_SA(0, 0), a2, voffA);
            PG8_WAIT_V(8); PG8_WAIT_L(0); PG8_BAR; PG8_MMA(1, 0, At, B0); PG8_MMA(1, 1, At, B1); PG8_BAR; PG8_SCHED;
            PG8_LDB(B0, 1, 0); PG8_LDB(B1, 1, 1); PG8_SCHED; PG8_LDA(At, 1, 0); PG8_STAGE(PG8_SA(0, 1), a2 + hstep, voffA);
            PG8_WAIT_V(8); PG8_WAIT_L(0); PG8_BAR; PG8_MMA(0, 0, At, B0); PG8_MMA(0, 1, At, B1); PG8_BAR; PG8_SCHED;
            PG8_LDA(At, 1, 1); PG8_STAGE(PG8_SB(1, 0), b3, voffB); PG8_STAGE(PG8_SB(1, 1), b3 + hstep, voffB); PG8_STAGE(PG8_SA(1, 0), a3, voffA);
            PG8_WAIT_V(8); PG8_WAIT_L(0); PG8_BAR; PG8_MMA(1, 0, At, B0); PG8_MMA(1, 1, At, B1); PG8_BAR; PG8_SCHED;
            } else {
            PG8_LDB(B0, 0, 0); PG8_SCHED; PG8_LDA(At, 0, 0); PG8_STAGE(PG8_SA(1, 1), a1 + hstep, voffA);
            PG8_WAIT_L(8); PG8_BAR; PG8_WAIT_L(0); PG8_MMA(0, 0, At, B0); PG8_BAR; PG8_SCHED;
            PG8_LDB(B1, 0, 1); PG8_STAGE(PG8_SB(0, 0), b2, voffB);
            PG8_BAR; PG8_WAIT_L(0); PG8_MMA(0, 1, At, B1); PG8_BAR;
            PG8_LDA(At, 0, 1); PG8_STAGE(PG8_SA(0, 0), a2, voffA);
            PG8_BAR; PG8_WAIT_L(0); PG8_MMA(1, 0, At, B0); PG8_BAR; PG8_SCHED;
            PG8_STAGE(PG8_SB(0, 1), b2 + hstep, voffB);
            PG8_WAIT_V(6); PG8_BAR; PG8_MMA(1, 1, At, B1); PG8_BAR;
            PG8_LDB(B0, 1, 0); PG8_SCHED; PG8_LDA(At, 1, 0); PG8_STAGE(PG8_SA(0, 1), a2 + hstep, voffA);
            PG8_WAIT_L(8); PG8_BAR; PG8_WAIT_L(0); PG8_MMA(0, 0, At, B0); PG8_BAR; PG8_SCHED;
            PG8_LDB(B1, 1, 1); PG8_STAGE(PG8_SB(1, 0), b3, voffB);
            PG8_BAR; PG8_WAIT_L(0); PG8_MMA(0, 1, At, B1); PG8_BAR;
            PG8_LDA(At, 1, 1); PG8_STAGE(PG8_SA(1, 0), a3, voffA);
            PG8_BAR; PG8_WAIT_L(0); PG8_MMA(1, 0, At, B0); PG8_BAR; PG8_SCHED;
            PG8_STAGE(PG8_SB(1, 1), b3 + hstep, voffB);
            PG8_WAIT_V(6); PG8_BAR; PG8_MMA(1, 1, At, B1); PG8_BAR;
            }
        }
        if constexpr (ALIGN_EPI) { if (wr == 0) PG8_BAR; }
        if constexpr (F8) asm volatile("s_nop 15\n\ts_nop 15" ::: "memory");
        if constexpr (!Epi::AFTER_DRAIN) { const int le_ = fresh_lane(); E(acc, cur, wr, wc, le_ & 15, le_ >> 4); S.done(cur); }
        if (!has_next) break;
#pragma unroll
        for (int a = 0; a < 2; ++a)
#pragma unroll
            for (int b = 0; b < 2; ++b)
#pragma unroll
                for (int m = 0; m < 4; ++m)
#pragma unroll
                    for (int n = 0; n < 2; ++n) acc[a][b][m][n] = (f32x4){0.f, 0.f, 0.f, 0.f};
        cur = nxt; cA = nA; cB = nB; ++ui;
        if constexpr (ALIGN_EPI) { if (wr == 1) PG8_BAR; }
    }
    PG8_WAIT_V(0);
    if constexpr (!ALIGN_EPI) { if (wr == 0) PG8_BAR; }
    PG8_BAR;
    if constexpr (Epi::AFTER_DRAIN) { E.fused(acc, cur, wr, wc, fr, fq, lds, wid, lane); S.done(cur); }
#undef PG8_SA
#undef PG8_SB
#undef PG8_STAGE
#undef PG8_LDA
#undef PG8_LDB
#undef PG8_LD16
#undef PG8_LD32
#undef PG8_MMA
#undef PG8_WAIT_V
#undef PG8_WAIT_L
#undef PG8_BAR
#undef PG8_SCHED
}

template <class Epi, class Sched>
__device__ __forceinline__ void gemm_simple(Frame& F, const bf16* A, const bf16* Bt, int K, const Sched& S, const Epi& E) {
    LAS float* As = (LAS float*)F.lds;
    LAS float* Bs = (LAS float*)(F.lds + 16 * 132 * 4);
    const int tid = F.tid, ty = tid >> 4, tx = tid & 15;
    Unit u;
    for (int i = 0; S.next(i, u); ++i) {
        for (int half = 0; half < 2; ++half) {
            const bf16* Ab = A + (size_t)(u.pm * 256 + half * 128) * K; const bf16* Bb = Bt + (size_t)u.pn * 256 * K;
            float acc[4][16];
#pragma unroll
            for (int r = 0; r < 4; ++r)
#pragma unroll
                for (int q = 0; q < 16; ++q) acc[r][q] = 0.f;
            for (int k0 = u.kt0 * 64; k0 < (u.kt0 + u.nkt) * 64; k0 += 16) {
                __syncthreads();
                { const int r = tid >> 1, kh = tid & 1;
                  if (tid < 256) { const u32x4 w = *(const u32x4*)(Ab + (size_t)r * K + k0 + kh * 8);
#pragma unroll
                      for (int q = 0; q < 4; ++q) { As[(kh * 8 + 2 * q) * 132 + r] = __uint_as_float(w[q] << 16); As[(kh * 8 + 2 * q + 1) * 132 + r] = __uint_as_float(w[q] & 0xffff0000u); } }
                  const u32x4 w = *(const u32x4*)(Bb + (size_t)r * K + k0 + kh * 8);
#pragma unroll
                  for (int q = 0; q < 4; ++q) { Bs[(kh * 8 + 2 * q) * 260 + r] = __uint_as_float(w[q] << 16); Bs[(kh * 8 + 2 * q + 1) * 260 + r] = __uint_as_float(w[q] & 0xffff0000u); } }
                __syncthreads();
#pragma unroll 4
                for (int k = 0; k < 16; ++k) {
                    const f32x4 a = *(const LAS f32x4*)(As + k * 132 + 4 * ty);
                    const f32x4 b0 = *(const LAS f32x4*)(Bs + k * 260 + 8 * tx), b1 = *(const LAS f32x4*)(Bs + k * 260 + 8 * tx + 4);
                    const f32x4 b2 = *(const LAS f32x4*)(Bs + k * 260 + 128 + 8 * tx), b3 = *(const LAS f32x4*)(Bs + k * 260 + 128 + 8 * tx + 4);
#pragma unroll
                    for (int r = 0; r < 4; ++r) {
#pragma unroll
                        for (int q = 0; q < 4; ++q) { acc[r][q] += a[r] * b0[q]; acc[r][4 + q] += a[r] * b1[q]; acc[r][8 + q] += a[r] * b2[q]; acc[r][12 + q] += a[r] * b3[q]; }
                    }
                }
            }
#pragma unroll
            for (int r = 0; r < 4; ++r) {
                float lo[8], hi[8];
#pragma unroll
                for (int q = 0; q < 8; ++q) { lo[q] = acc[r][q]; hi[q] = acc[r][8 + q]; }
                E.pair8(u, u.pm * 256 + half * 128 + 4 * ty + r, 8 * tx, lo, hi);
            }
        }
    }
    __syncthreads();
}

template <bool FAST, bool VARK = false, bool F8 = false, class Epi, class Sched>
__device__ __forceinline__ void gemm_run(Frame& F, const bf16* A, const bf16* Bt, int K, const Sched& S, const Epi& E) {
    if constexpr (FAST) { const Gemm g{A, Bt, 0, 0, K}; const EpiWrap<Epi> W{E}; gemm_phase<EpiWrap<Epi>, Sched, true, true, VARK, false, F8>(F.lds, g, S, W, F.wave); }
    else { F.refresh(); gemm_simple(F, A, Bt, K, S, E); }
}
#ifndef FUSE_MERGE
#define FUSE_MERGE 1
#endif
#ifndef FAST_ATTN
#define FAST_ATTN 1
#endif
#ifndef FAST_SGU
#define FAST_SGU 1
#endif
#ifndef FAST_INPROJ
#define FAST_INPROJ true
#endif
#ifndef FAST_OUTPROJ
#define FAST_OUTPROJ true
#endif
#ifndef FAST_FFN1D
#define FAST_FFN1D true
#endif
#ifndef FAST_FFN2D
#define FAST_FFN2D true
#endif
#ifndef FAST_FFN1E
#define FAST_FFN1E true
#endif
#ifndef FAST_FFN2E
#define FAST_FFN2E true
#endif
template <bool F8OUT = false>
__device__ __forceinline__ void tr_item(const float* W, int ldw, int k0, int srcCol0, bf16* WT, int Kd, int dstRow0, const float* scaleK, LAS float* scr, int lane) {
    const int kr = lane >> 4, nc = (lane & 15) * 4, c4 = lane & 3;
    f32x4 v[16];
#pragma unroll
    for (int i = 0; i < 16; ++i) v[i] = *(const f32x4*)(W + (size_t)(k0 + 4 * i + kr) * ldw + srcCol0 + nc);
    if (scaleK) {
#pragma unroll
        for (int i = 0; i < 16; ++i) v[i] = v[i] * scaleK[k0 + 4 * i + kr];
    }
#pragma unroll
    for (int ps = 0; ps < 2; ++ps) {
#pragma unroll
        for (int i = 0; i < 8; ++i)
#pragma unroll
            for (int q = 0; q < 4; ++q) scr[(4 * i + kr) * 65 + nc + q] = v[8 * ps + i][q];
        asm volatile("s_waitcnt lgkmcnt(0)" ::: "memory");
#pragma unroll
        for (int j = 0; j < 4; ++j) { const int n = (lane >> 2) + 16 * j; const LAS float* sp = scr + (8 * c4) * 65 + n;
            if constexpr (F8OUT) { const float v8[8] = {sp[0] * W8_SCALE, sp[65] * W8_SCALE, sp[2 * 65] * W8_SCALE, sp[3 * 65] * W8_SCALE, sp[4 * 65] * W8_SCALE, sp[5 * 65] * W8_SCALE, sp[6 * 65] * W8_SCALE, sp[7 * 65] * W8_SCALE};
                *(u32x2*)((unsigned char*)WT + (size_t)(dstRow0 + n) * Kd + k0 + 32 * ps + 8 * c4) = pk8_fp8(v8); }
            else { u32x4 o; o.x = pk2(sp[0], sp[65]); o.y = pk2(sp[2 * 65], sp[3 * 65]); o.z = pk2(sp[4 * 65], sp[5 * 65]); o.w = pk2(sp[6 * 65], sp[7 * 65]);
                *(u32x4*)(WT + (size_t)(dstRow0 + n) * Kd + k0 + 32 * ps + 8 * c4) = o; } }
        asm volatile("s_waitcnt lgkmcnt(0)" ::: "memory");
    }
}
constexpr int N_IN = NL * (NIN / 64) * (DM / 64);
constexpr int N_OUT = NL * (DM / 64) * (DM / 64);
constexpr int N_GU = (2 * DFF / 64) * (DM / 64);
constexpr int N_D = (DM / 64) * (DFF / 64);
constexpr int N_EGU = NE * (2 * EFF / 64) * (DM / 64);
constexpr int N_ED = NE * (DM / 64) * (EFF / 64);
constexpr int NITEMS = N_IN + N_OUT + N_GU + N_D + N_EGU + N_ED;
#ifndef CONV_QUOTA
#define CONV_QUOTA 4
#endif
#ifndef CONV_TAIL_ITEMS
#define CONV_TAIL_ITEMS 4096
#endif
constexpr int N_SLOTS = 3, SLOT_ITEMS = CONV_QUOTA * 1024, N_TAIL = CONV_TAIL_ITEMS, N_DEFER = N_SLOTS * SLOT_ITEMS + N_TAIL;
static_assert(N_DEFER <= N_EGU + N_ED && N_TAIL <= N_ED, "deferred items are expert items; the tail items are expert DOWN weights (first needed after the expert gate/up GEMM)");
__device__ __forceinline__ void conv_item(Frame& F, int it, LAS float* scr) {
            int r = it;
            if (r < N_IN) {
                const int l = r / (40 * 16), nb = (r / 16) % 40, kb = r % 16; const int dr = nb * 64, sc = dr < 1536 ? dr : dr + 8;
                tr_item(F.in[I_WIN] + (size_t)l * DM * INC, INC, kb * 64, sc, (bf16*)(F.ws + WS_WIN) + (size_t)l * NIN * DM, DM, dr, nullptr, scr, F.lane); return; }
            r -= N_IN;
            if (r < N_OUT) {
                const int l = r / 256, nb = (r / 16) % 16, kb = r % 16; const float* g = kb < 8 ? F.in[I_GOA] + l * AW : F.in[I_GOS] + l * AW - AW;
                tr_item(F.in[I_WOUT] + (size_t)l * DM * DM, DM, kb * 64, nb * 64, (bf16*)(F.ws + WS_WOUT) + (size_t)l * DM * DM, DM, nb * 64, g, scr, F.lane); return; }
            r -= N_OUT;
            if (r < N_GU) {
                const int nb = r / 16, kb = r % 16; const int dr = nb * 64, t = dr >> 8, w = dr & 255; const int sc = (w < 128) ? (128 * t + w) : (DFF + 128 * t + (w - 128));
                tr_item(F.in[I_WGUD], 2 * DFF, kb * 64, sc, (bf16*)(F.ws + WS_WGU), DM, dr, nullptr, scr, F.lane); return; }
            r -= N_GU;
            if (r < N_D) {
                const int nb = r / 44, kb = r % 44;
                tr_item(F.in[I_WDD], DM, kb * 64, nb * 64, (bf16*)(F.ws + WS_WD), DFF, nb * 64, nullptr, scr, F.lane); return; }
            r -= N_D;
            if (r < N_EGU) {
                const int e = r / (112 * 16), nb = (r / 16) % 112, kb = r % 16; const int dr = nb * 64, t = dr >> 8, w = dr & 255; const int sc = (w < 128) ? (128 * t + w) : (EFF + 128 * t + (w - 128));
                tr_item<true>(F.in[I_WGUE] + (size_t)e * DM * 2 * EFF, 2 * EFF, kb * 64, sc, (bf16*)(F.ws + WS_EGU + (size_t)e * 2 * EFF * DM), DM, dr, nullptr, scr, F.lane); return; }
            r -= N_EGU;
            {
                const int e = r / (16 * 56), nb = (r / 56) % 16, kb = r % 56;
                tr_item<true>(F.in[I_WDE] + (size_t)e * EFF * DM, DM, kb * 64, nb * 64, (bf16*)(F.ws + WS_ED + (size_t)e * DM * EFF), EFF, nb * 64, nullptr, scr, F.lane); }
}
__device__ __forceinline__ void conv_filler(Frame& F, int slot) {
    F.refresh();
    LAS float* scr = (LAS float*)(F.lds + F.wave * 8320);
    const int idx = ((int)blockIdx.x - 128) * NWAVES + F.wave;
    for (int k = 0; k < CONV_QUOTA; ++k) conv_item(F, NITEMS - N_DEFER + slot * SLOT_ITEMS + k * 1024 + idx, scr);
    __syncthreads();
}
__device__ __forceinline__ void conv_tail(Frame& F, int rank, int nidle) {
    F.refresh();
    LAS float* scr = (LAS float*)(F.lds + F.wave * 8320);
    if (nidle < 64) { rank = (int)blockIdx.x; nidle = F.G; }
    if (rank >= 0) for (int it = rank * NWAVES + F.wave; it < N_TAIL; it += nidle * NWAVES) conv_item(F, NITEMS - N_TAIL + it, scr);
    __syncthreads();
}
__device__ __forceinline__ void p0_prologue(Frame& F) {
    F.refresh();
    {
        LAS float* cact = (LAS float*)F.lds;
        LAS float* red = (LAS float*)(F.lds + 32768);
        const float* c = F.in[I_C];
        for (int i = F.tid; i < NB * DM; i += NTHREADS) cact[i] = silu_f(c[i]);
        __syncthreads();
        float* mod = (float*)(F.ws + WS_MOD);
        for (int it = F.vcu; it < NL * (NMOD * DM / 64); it += F.G) {
            const int l = it / (NMOD * DM / 64), j0 = (it % (NMOD * DM / 64)) * 64;
            const float* W = F.in[I_WADA] + (size_t)l * DM * (NMOD * DM) + j0 + F.lane;
            float acc[8];
#pragma unroll
            for (int b = 0; b < 8; ++b) acc[b] = 0.f;
            const int d0 = F.wave * 128;
#pragma unroll 8
            for (int d = 0; d < 128; ++d) { const float w = W[(size_t)(d0 + d) * (NMOD * DM)];
#pragma unroll
                for (int b = 0; b < 8; ++b) acc[b] += cact[b * DM + d0 + d] * w; }
#pragma unroll
            for (int b = 0; b < 8; ++b) red[(F.wave * 8 + b) * 64 + F.lane] = acc[b];
            __syncthreads();
            { const int b = F.tid >> 6, ln = F.tid & 63; float s = 0.f;
#pragma unroll
              for (int w = 0; w < 8; ++w) s += red[(w * 8 + b) * 64 + ln];
              mod[((size_t)l * NB + b) * (NMOD * DM) + j0 + ln] = s + F.in[I_BADA][(size_t)l * (NMOD * DM) + j0 + ln]; }
            __syncthreads();
        }
    }
    {
        float* wf = (float*)(F.ws + WS_WF); float* wr = (float*)(F.ws + WS_WR);
        const int gt = F.vcu * NTHREADS + F.tid, GT = F.G * NTHREADS;
        for (int i = gt; i < NL * 8 * DM; i += GT) { const int l = i / (8 * DM), j = (i / DM) % 8, d = i % DM; wf[i] = F.in[I_WIN][((size_t)l * DM + d) * INC + 3 * AW + j]; }
        for (int i = gt; i < 8 * DM; i += GT) { const int j = i / DM, d = i % DM; wr[i] = F.in[I_WROUTER][(size_t)d * NE + j]; }
    }
    {
        LAS float* scr = (LAS float*)(F.lds + F.wave * 8320);
        const int gw = F.vcu * NWAVES + F.wave, NGW = F.G * NWAVES;
        const int nhere = (F.G == 256) ? NITEMS - N_DEFER : NITEMS;
        for (int it = gw; it < nhere; it += NGW) conv_item(F, it, scr);
    }
}
__device__ __forceinline__ f32x4 ld4(const float* p, int j, int lane) { return *((const f32x4*)p + 64 * j + lane); }
__device__ __forceinline__ void st4bf(bf16* p, int j, int lane, f32x4 v) { *((u64*)p + 64 * j + lane) = (u64)pk2(v.x, v.y) | ((u64)pk2(v.z, v.w) << 32); }
__device__ __forceinline__ f32x4 ld4bf(const bf16* p, int j, int lane) { const u32x2 w = *((const u32x2*)p + 64 * j + lane); return (f32x4){__uint_as_float(w.x << 16), __uint_as_float(w.x & 0xffff0000u), __uint_as_float(w.y << 16), __uint_as_float(w.y & 0xffff0000u)}; }
__device__ __forceinline__ float log_sigmoid_f(float a) { return fminf(a, 0.f) - log1pf(__expf(-fabsf(a))); }
template <bool F8OUT = false>
__device__ __forceinline__ void ada_norm_row(f32x4 (&v)[4], const float* g, const float* sc, const float* sh, bf16* hrow, int lane) {
    float ss = 0.f;
#pragma unroll
    for (int j = 0; j < 4; ++j) ss += dot4(v[j], v[j]);
    const float rstd = 1.0f / sqrtf(wave_sum(ss) * (1.f / DM) + EPS);
#pragma unroll
    for (int j = 0; j < 4; ++j) { const f32x4 gg = ld4(g, j, lane), s1 = ld4(sc, j, lane), s0 = ld4(sh, j, lane); v[j] = v[j] * rstd * gg * (1.f + s1) + s0;
        if constexpr (F8OUT) { int w = 0; w = __builtin_amdgcn_cvt_pk_fp8_f32(clamp8(v[j].x), clamp8(v[j].y), w, false); w = __builtin_amdgcn_cvt_pk_fp8_f32(clamp8(v[j].z), clamp8(v[j].w), w, true); *((unsigned*)hrow + 64 * j + lane) = (unsigned)w; }
        else *((u64*)hrow + 64 * j + lane) = (u64)pk2(v[j].x, v[j].y) | ((u64)pk2(v[j].z, v[j].w) << 32); }
}
__device__ __forceinline__ void forget_row(Frame& F, const f32x4 (&h)[4], const LAS float* wf  , const float* bf, int b, int s) {
    float z = 0.f;
#pragma unroll
    for (int jj = 0; jj < 8; ++jj) { float p = 0.f;
#pragma unroll
        for (int j = 0; j < 4; ++j) p += dot4(h[j], *((const LAS f32x4*)(wf + jj * DM) + 64 * j + F.lane));
        p = wave_sum(p); if (F.lane == jj) z = p; }
    if (F.lane < 8) ((float*)(F.ws + WS_LOGF))[((size_t)b * NH + F.lane) * SEQ + s] = log_sigmoid_f(z + bf[F.lane]);
}
__device__ __forceinline__ void stage_lds_f32(Frame& F, LAS float* dst, const float* src, int n) {
    for (int i = F.tid * 4; i < n; i += NTHREADS * 4) *(LAS f32x4*)(dst + i) = *(const f32x4*)(src + i);
    __syncthreads();
}
__device__ __forceinline__ void phase_premix(Frame& F, int l, const float* xsrc) {
    F.refresh();
    LAS float* wf = (LAS float*)F.lds; stage_lds_f32(F, wf, (const float*)(F.ws + WS_WF) + (size_t)l * 8 * DM, 8 * DM);
    const int gw = F.vcu * NWAVES + F.wave, NGW = F.G * NWAVES; const float* mod = (const float*)(F.ws + WS_MOD);
    for (int row = gw; row < M; row += NGW) {
        const int b = row / SEQ, s = row % SEQ; const float* mb = mod + ((size_t)l * NB + b) * (NMOD * DM);
        f32x4 v[4];
#pragma unroll
        for (int j = 0; j < 4; ++j) v[j] = ld4(xsrc + (size_t)row * DM, j, F.lane);
        ada_norm_row(v, F.in[I_GPREMIX] + l * DM, mb + 1 * DM, mb + 0 * DM, (bf16*)(F.ws + WS_H) + (size_t)row * DM, F.lane);
        forget_row(F, v, wf, F.in[I_BFORGET] + l * NH, b, s);
    }
    __syncthreads();
}
__device__ __forceinline__ void phase_merge_norm(Frame& F) {
    F.refresh();
    const int gw = F.vcu * NWAVES + F.wave, NGW = F.G * NWAVES;
    const float* sa = (const float*)(F.ws + WS_SSQA); const float* ss = (const float*)(F.ws + WS_SSQS);
    for (int row = gw; row < M; row += NGW) {
        const f32x4 a0 = *(const f32x4*)(sa + (size_t)row * 8), a1 = *(const f32x4*)(sa + (size_t)row * 8 + 4);
        const f32x4 s0 = *(const f32x4*)(ss + (size_t)row * 16) + *(const f32x4*)(ss + (size_t)row * 16 + 8), s1 = *(const f32x4*)(ss + (size_t)row * 16 + 4) + *(const f32x4*)(ss + (size_t)row * 16 + 12);
        const float ra = 1.0f / sqrtf(((a0.x + a0.y) + (a0.z + a0.w) + (a1.x + a1.y) + (a1.z + a1.w)) * (1.f / AW) + EPS);
        const float rs = 1.0f / sqrtf(((s0.x + s0.y) + (s0.z + s0.w) + (s1.x + s1.y) + (s1.z + s1.w)) * (1.f / AW) + EPS);
        const u32x4* p = (const u32x4*)((const bf16*)(F.ws + WS_MG) + (size_t)row * DM); u32x4* po = (u32x4*)((bf16*)(F.ws + WS_MG2) + (size_t)row * DM);
#pragma unroll
        for (int j = 0; j < 2; ++j) { u32x4 w = p[64 * j + F.lane]; const float r = j == 0 ? ra : rs;
#pragma unroll
            for (int q = 0; q < 4; ++q) w[q] = pk2(__uint_as_float(w[q] << 16) * r, __uint_as_float(w[q] & 0xffff0000u) * r);
            po[64 * j + F.lane] = w; }
    }
}
__device__ __forceinline__ void phase_postmix(Frame& F, int l, const float* xsrc  , bool moe) {
    F.refresh();
    LAS float* wr = (LAS float*)F.lds; LAS unsigned* lcnt = (LAS unsigned*)(F.lds + 32768); LAS unsigned* lbase = lcnt + 8;
    if (moe) { if (F.tid < 16) lcnt[F.tid] = 0u; stage_lds_f32(F, wr, (const float*)(F.ws + WS_WR), 8 * DM); }
    const int gw = F.vcu * NWAVES + F.wave, NGW = F.G * NWAVES; const float* mod = (const float*)(F.ws + WS_MOD);
    const bf16* Y = (const bf16*)(F.ws + WS_Y); unsigned* tok = (unsigned*)(F.ws + WS_TOK); bf16* XR = (bf16*)(F.ws + WS_XR);
    for (int row = gw; row < M; row += NGW) {
        const int b = row / SEQ; const float* mb = mod + ((size_t)l * NB + b) * (NMOD * DM);
        f32x4 y[4], v[4]; float ss = 0.f;
#pragma unroll
        for (int j = 0; j < 4; ++j) { y[j] = ld4bf(Y + (size_t)row * DM, j, F.lane); v[j] = xsrc ? ld4(xsrc + (size_t)row * DM, j, F.lane) : ld4bf(XR + (size_t)row * DM, j, F.lane); ss += dot4(y[j], y[j]); }
        const float rstd = 1.0f / sqrtf(wave_sum(ss) * (1.f / DM) + EPS);
#pragma unroll
        for (int j = 0; j < 4; ++j) { const f32x4 g = ld4(F.in[I_GPOSTMIX] + l * DM, j, F.lane), gt = ld4(mb + 2 * DM, j, F.lane); v[j] = v[j] + (1.f + gt) * (y[j] * rstd * g);
            st4bf(XR + (size_t)row * DM, j, F.lane, v[j]); }
        if (moe) ada_norm_row<true>(v, F.in[I_GPREFFN] + l * DM, mb + 4 * DM, mb + 3 * DM, (bf16*)(F.ws + WS_H + (size_t)row * DM), F.lane);
        else ada_norm_row(v, F.in[I_GPREFFN] + l * DM, mb + 4 * DM, mb + 3 * DM, (bf16*)(F.ws + WS_H) + (size_t)row * DM, F.lane);
        if (moe) {
            float lg[8];
#pragma unroll
            for (int jj = 0; jj < 8; ++jj) { float p = 0.f;
#pragma unroll
                for (int j = 0; j < 4; ++j) p += dot4(v[j], *((const LAS f32x4*)(wr + jj * DM) + 64 * j + F.lane));
                lg[jj] = wave_sum(p); }
            int e0 = 0; float v0 = lg[0];
#pragma unroll
            for (int jj = 1; jj < 8; ++jj) if (lg[jj] > v0) { v0 = lg[jj]; e0 = jj; }
            int e1 = -1; float v1 = -INFINITY;
#pragma unroll
            for (int jj = 0; jj < 8; ++jj) if (jj != e0 && lg[jj] > v1) { v1 = lg[jj]; e1 = jj; }
            if (e1 < 0) e1 = (e0 + 1) & 7;
            if (F.lane == 0) {
                const float w1 = 1.f / (1.f + __expf(v0 - v1)), w0 = 1.f - w1;
                const unsigned r0 = __hip_atomic_fetch_add(&lcnt[e0], 1u, __ATOMIC_RELAXED, __HIP_MEMORY_SCOPE_WORKGROUP), r1 = __hip_atomic_fetch_add(&lcnt[e1], 1u, __ATOMIC_RELAXED, __HIP_MEMORY_SCOPE_WORKGROUP);
                u32x4 a; a.x = (unsigned)e0; a.y = (unsigned)e1; a.z = r0; a.w = r1; *(u32x4*)(tok + (size_t)row * 8) = a;
                u32x2 w; w.x = __float_as_uint(w0); w.y = __float_as_uint(w1); *(u32x2*)(tok + (size_t)row * 8 + 4) = w;
            }
        }
    }
    if (moe) {
        __syncthreads();
        if (F.tid < 8) lbase[F.tid] = __hip_atomic_fetch_add(F.ctl + CW_CNT + 64 * F.tid, lcnt[F.tid], __ATOMIC_RELAXED, __HIP_MEMORY_SCOPE_AGENT);
        __syncthreads();
        if (F.lane == 0) for (int row = gw; row < M; row += NGW) { u32x4 a = *(u32x4*)(tok + (size_t)row * 8); a.z += lbase[a.x]; a.w += lbase[a.y]; *(u32x4*)(tok + (size_t)row * 8) = a; }
    }
    __syncthreads();
}
__device__ __forceinline__ void phase_scatter(Frame& F) {
    F.refresh();
    MoeLayout Lay; Lay.init(F.ctl + CW_CNT);
    const int gw = F.vcu * NWAVES + F.wave, NGW = F.G * NWAVES; const unsigned* tok = (const unsigned*)(F.ws + WS_TOK);
    const unsigned char* H = F.ws + WS_H; unsigned char* HS = F.ws + WS_HS;
    for (int row = gw; row < M; row += NGW) {
        const u32x4 a = *(const u32x4*)(tok + (size_t)row * 8);
        const int s0 = Lay.panel_base((int)a.x) * 256 + (int)a.z, s1 = Lay.panel_base((int)a.y) * 256 + (int)a.w;
        const u32x4* src = (const u32x4*)(H + (size_t)row * DM); u32x4* d0 = (u32x4*)(HS + (size_t)s0 * DM); u32x4* d1 = (u32x4*)(HS + (size_t)s1 * DM);
#pragma unroll
        for (int j = 0; j < 1; ++j) { const u32x4 w = src[64 * j + F.lane]; if (s0 < CAPROWS) d0[64 * j + F.lane] = w; if (s1 < CAPROWS) d1[64 * j + F.lane] = w; }
    }
}
__device__ __forceinline__ void phase_final(Frame& F, int l, bool moe) {
    F.refresh();
    const bool nxt = (l + 1 < NL);
    LAS float* wf = (LAS float*)F.lds; if (nxt) stage_lds_f32(F, wf, (const float*)(F.ws + WS_WF) + (size_t)(l + 1) * 8 * DM, 8 * DM);
    MoeOrder MO; if (moe) MO.init(F.ctl + CW_CNT, DM / 256, F.G, 0, EFF / 2, true);
    const MoeLayout& Lay = MO.Lay; const float* PART = (const float*)(F.ws + WS_PART);
    const int gw = F.vcu * NWAVES + F.wave, NGW = F.G * NWAVES; const float* mod = (const float*)(F.ws + WS_MOD);
    const bf16* Y = (const bf16*)(F.ws + WS_Y); const float* YS = (const float*)(F.ws + WS_YS); const unsigned* tok = (const unsigned*)(F.ws + WS_TOK); bf16* XR = (bf16*)(F.ws + WS_XR);
    for (int row = gw; row < M; row += NGW) {
        const int b = row / SEQ, s = row % SEQ; const float* mb = mod + ((size_t)l * NB + b) * (NMOD * DM);
        f32x4 y[4], v[4]; float ss = 0.f;
        if (moe) {
            const u32x4 a = *(const u32x4*)(tok + (size_t)row * 8); const u32x2 ww = *(const u32x2*)(tok + (size_t)row * 8 + 4);
            int s0 = Lay.panel_base((int)a.x) * 256 + (int)a.z, s1 = Lay.panel_base((int)a.y) * 256 + (int)a.w; if (s0 >= CAPROWS) s0 = 0; if (s1 >= CAPROWS) s1 = 0;
            const float w0 = __uint_as_float(ww.x), w1 = __uint_as_float(ww.y);
#pragma unroll
            for (int j = 0; j < 4; ++j) {
                f32x4 ya, yb;
                { const int q = MO.unit_index(s0 >> 8, j) - MO.R * MO.G;
                  if (MO.sp > 1 && q >= 0) { const f32x4* pp = (const f32x4*)(PART + ((size_t)(q * 14) * 256 + (s0 & 255)) * 256) + F.lane; f32x4 t[14];
#pragma unroll
                      for (int sl = 0; sl < 14; ++sl) t[sl] = pp[(size_t)(sl < MO.sp ? sl : MO.sp - 1) * 16384];
                      ya = t[0];
#pragma unroll
                      for (int sl = 1; sl < 14; ++sl) ya += (sl < MO.sp) ? t[sl] : (f32x4){0.f, 0.f, 0.f, 0.f}; }
                  else ya = ld4(YS + (size_t)s0 * DM, j, F.lane); }
                { const int q = MO.unit_index(s1 >> 8, j) - MO.R * MO.G;
                  if (MO.sp > 1 && q >= 0) { const f32x4* pp = (const f32x4*)(PART + ((size_t)(q * 14) * 256 + (s1 & 255)) * 256) + F.lane; f32x4 t[14];
#pragma unroll
                      for (int sl = 0; sl < 14; ++sl) t[sl] = pp[(size_t)(sl < MO.sp ? sl : MO.sp - 1) * 16384];
                      yb = t[0];
#pragma unroll
                      for (int sl = 1; sl < 14; ++sl) yb += (sl < MO.sp) ? t[sl] : (f32x4){0.f, 0.f, 0.f, 0.f}; }
                  else yb = ld4(YS + (size_t)s1 * DM, j, F.lane); }
                y[j] = w0 * ya + w1 * yb;
            }
        } else {
#pragma unroll
            for (int j = 0; j < 4; ++j) y[j] = ld4bf(Y + (size_t)row * DM, j, F.lane);
        }
#pragma unroll
        for (int j = 0; j < 4; ++j) { v[j] = ld4bf(XR + (size_t)row * DM, j, F.lane); ss += dot4(y[j], y[j]); }
        const float rstd = 1.0f / sqrtf(wave_sum(ss) * (1.f / DM) + EPS);
#pragma unroll
        for (int j = 0; j < 4; ++j) { const f32x4 g = ld4(F.in[I_GPOSTFFN] + l * DM, j, F.lane), gt = ld4(mb + 5 * DM, j, F.lane); v[j] = v[j] + (1.f + gt) * (y[j] * rstd * g);
            if (nxt) st4bf(XR + (size_t)row * DM, j, F.lane, v[j]); else *((f32x4*)(F.out + (size_t)row * DM) + 64 * j + F.lane) = v[j]; }
        if (nxt) {
            const float* mn = mod + ((size_t)(l + 1) * NB + b) * (NMOD * DM);
            ada_norm_row(v, F.in[I_GPREMIX] + (l + 1) * DM, mn + 1 * DM, mn + 0 * DM, (bf16*)(F.ws + WS_H) + (size_t)row * DM, F.lane);
            forget_row(F, v, wf, F.in[I_BFORGET] + (l + 1) * NH, b, s);
        }
    }
    __syncthreads();
}

__device__ __forceinline__ void attn_simple(Frame& F) {
    F.refresh();
    const bf16* Q = (const bf16*)(F.ws + WS_QKVUV); const bf16* Kb = Q + (size_t)M * 512; const bf16* Vb = Kb + (size_t)M * 512;
    const float* logf = (const float*)(F.ws + WS_LOGF); bf16* MG = (bf16*)(F.ws + WS_MG); float* ssq = (float*)(F.ws + WS_SSQA);
    for (int g2 = F.vcu * NTHREADS + F.tid; g2 < NB * NH * SEQ * 2; g2 += F.G * NTHREADS) {
        const int gt = g2 >> 1, hf = g2 & 1;
        const int bh = gt / SEQ, t = gt % SEQ, b = bh / NH, h = bh % NH; const size_t rb = (size_t)b * SEQ;
        float q[32], o[32];
        { const u32x4* qp = (const u32x4*)(Q + (rb + t) * 512 + h * 64 + hf * 32);
#pragma unroll
          for (int i = 0; i < 4; ++i) { const u32x4 w = qp[i];
#pragma unroll
              for (int k = 0; k < 4; ++k) { q[8 * i + 2 * k] = __uint_as_float(w[k] << 16); q[8 * i + 2 * k + 1] = __uint_as_float(w[k] & 0xffff0000u); } } }
#pragma unroll
        for (int d = 0; d < 32; ++d) o[d] = 0.f;
        float m = -INFINITY, lsum = 0.f, Lrun = 0.f;
        const int tmax = __builtin_amdgcn_readfirstlane(t | 31);
        for (int s = 0; s <= tmax; ++s) {
            Lrun += logf[(size_t)bh * SEQ + s];
            const u32x4* kp = (const u32x4*)(Kb + (rb + s) * 512 + h * 64 + hf * 32); float dot = 0.f;
#pragma unroll
            for (int i = 0; i < 4; ++i) { const u32x4 w = kp[i];
#pragma unroll
                for (int k = 0; k < 4; ++k) dot += q[8 * i + 2 * k] * __uint_as_float(w[k] << 16) + q[8 * i + 2 * k + 1] * __uint_as_float(w[k] & 0xffff0000u); }
            dot += __shfl_xor(dot, 1);
            if (s <= t) {
                const float sc = dot - Lrun * LOG2E, mn = fmaxf(m, sc), al = exp2f(m - mn), p = exp2f(sc - mn);
                lsum = lsum * al + p; m = mn;
                const u32x4* vp = (const u32x4*)(Vb + (rb + s) * 512 + h * 64 + hf * 32);
#pragma unroll
                for (int i = 0; i < 4; ++i) { const u32x4 w = vp[i];
#pragma unroll
                    for (int k = 0; k < 4; ++k) { o[8 * i + 2 * k] = o[8 * i + 2 * k] * al + p * __uint_as_float(w[k] << 16); o[8 * i + 2 * k + 1] = o[8 * i + 2 * k + 1] * al + p * __uint_as_float(w[k] & 0xffff0000u); } }
            }
        }
        const float il = 1.f / lsum; float sq = 0.f;
        bf16* op = MG + (rb + t) * DM + h * 64 + hf * 32;
#pragma unroll
        for (int i = 0; i < 4; ++i) { float v[8];
#pragma unroll
            for (int k = 0; k < 8; ++k) { v[k] = o[8 * i + k] * il; sq += v[k] * v[k]; }
            store8_bf16(op + 8 * i, v); }
        sq += __shfl_xor(sq, 1);
        if (hf == 0) ssq[(rb + t) * 8 + h] = sq;
    }
}
__device__ __forceinline__ void sgu_simple(Frame& F, int l) {
    F.refresh();
    const bf16* U = (const bf16*)(F.ws + WS_QKVUV) + (size_t)3 * M * 512; const bf16* SV = U + (size_t)M * 512;
    bf16* MG = (bf16*)(F.ws + WS_MG); float* ssq = (float*)(F.ws + WS_SSQS);
    LAS float* st = (LAS float*)F.lds;
    LAS float* vn = (LAS float*)(F.lds + 1024);
    LAS float* wl = (LAS float*)(F.lds + 1024 + 128 * 65 * 4);
    const float* gv = F.in[I_GV] + l * AW;
    for (int un = F.vcu; un < NB * 16 * 8; un += F.G) {
        const int g = un & 7, ch = (un >> 3) & 15, b = un >> 7; const size_t rb = (size_t)b * SEQ + ch * 128;
        __syncthreads();
        for (int r = F.wave * 16; r < F.wave * 16 + 16; ++r) {
            const u32x4 w = *((const u32x4*)(SV + (rb + r) * 512) + F.lane); float x[8];
#pragma unroll
            for (int k = 0; k < 4; ++k) { x[2 * k] = __uint_as_float(w[k] << 16); x[2 * k + 1] = __uint_as_float(w[k] & 0xffff0000u); }
            float s = 0.f;
#pragma unroll
            for (int k = 0; k < 8; ++k) s += x[k];
            const float mean = wave_sum(s) * (1.f / 512.f); float q = 0.f;
#pragma unroll
            for (int k = 0; k < 8; ++k) { const float d = x[k] - mean; q += d * d; }
            const float rstd = 1.0f / sqrtf(wave_sum(q) * (1.f / 512.f) + EPS);
            if (F.lane == 0) { st[2 * r] = mean; st[2 * r + 1] = rstd; }
        }
        const float* W = F.in[I_WSP] + ((size_t)l * 8 + g) * 128 * 128;
        for (int i = F.tid; i < 128 * 128; i += NTHREADS) { const int t = i >> 7, s = i & 127; wl[t * 129 + s] = (s <= t) ? W[i] : 0.f; }
        __syncthreads();
        for (int i = F.tid; i < 128 * 64; i += NTHREADS) { const int s = i >> 6, d = i & 63; vn[s * 65 + d] = (bf2f(SV[(rb + s) * 512 + g * 64 + d]) - st[2 * s]) * st[2 * s + 1] * gv[g * 64 + d]; }
        __syncthreads();
        const int t = F.tid >> 2, dq = F.tid & 3;
        float acc[16];
#pragma unroll
        for (int i = 0; i < 16; ++i) acc[i] = 0.f;
        for (int s = 0; s <= t; ++s) { const float w = wl[t * 129 + s];
#pragma unroll
            for (int i = 0; i < 16; ++i) acc[i] += w * vn[s * 65 + dq * 16 + i]; }
        const float bs = F.in[I_BSP][((size_t)l * 8 + g) * 128 + t]; float sq = 0.f;
        const bf16* up = U + (rb + t) * 512 + g * 64 + dq * 16; bf16* op = MG + (rb + t) * DM + AW + g * 64 + dq * 16;
#pragma unroll
        for (int i = 0; i < 2; ++i) { float v[8];
#pragma unroll
            for (int k = 0; k < 8; ++k) { v[k] = bf2f(up[8 * i + k]) * (acc[8 * i + k] + bs); sq += v[k] * v[k]; }
            store8_bf16(op + 8 * i, v); }
        sq += __shfl_xor(sq, 1); sq += __shfl_xor(sq, 2);
        if (dq == 0) { ssq[(rb + t) * 16 + 2 * g] = sq; ssq[(rb + t) * 16 + 2 * g + 1] = 0.f; }
    }
    __syncthreads();
}

#include <hip/hip_bf16.h>
#include <cmath>
namespace attn_body {
typedef float f32x4_t __attribute__((ext_vector_type(4)));
using bf16=__hip_bfloat16;
using bf16x8=__attribute__((ext_vector_type(8)))short;
using s16x4=__attribute__((ext_vector_type(4)))short;
using f32x16=__attribute__((ext_vector_type(16)))float;
using u32x4=__attribute__((ext_vector_type(4)))unsigned;
constexpr int BATCH=8,NHEAD=8,SEQ=2048,D=64,DM=NHEAD*D,OP=1024;
constexpr int NW=8,QBLK=32,QB=QBLK*NW,KVBLK=64,NQB=SEQ/QB;
constexpr int ATTN_PITCH=DM, ATTN_UNIT_ROWS=QB;
__device__ __forceinline__ int crow(int r,int hi){return (r&3)+8*(r>>2)+4*hi;}
#define SBAR() __builtin_amdgcn_sched_barrier(0)
__device__ __forceinline__ void cmask(f32x16&p0,f32x16&p1,int jb,int qrel,int hi){
  const float NEG=-INFINITY; int kb=64*jb+4*hi;
  #pragma unroll
  for(int r=0;r<16;++r){int kv=kb+(r&3)+8*(r>>2); if(kv>qrel)p0[r]=NEG; if(kv+32>qrel)p1[r]=NEG;}
}

constexpr int NSLOT=3, SLOTB=8192;
constexpr int LDS_K=0, LDS_V=NSLOT*SLOTB, LDS_WS=2*NSLOT*SLOTB, LDS_OST=LDS_WS+NW*64*4, LDS_BIAS=LDS_OST+NW*4096, LDS_BYTES=LDS_BIAS+SEQ*4;
constexpr float C2=0.125f*1.4426950408889634f;
__device__ __forceinline__ void glds16(const void*gsrc,unsigned lds_dst){unsigned keep;
  asm volatile("s_mov_b32 %0, m0\n\ts_mov_b32 m0, %2\n\ts_nop 0\n\tglobal_load_lds_dwordx4 %1, off\n\ts_mov_b32 m0, %0":"=&s"(keep):"v"(gsrc),"s"(lds_dst):"memory");}
__device__ __forceinline__ float max3f(float a,float b,float c){float r;asm("v_max3_f32 %0, %1, %2, %3":"=v"(r):"v"(a),"v"(b),"v"(c));return r;}
__device__ __forceinline__ float max2f(float a,float b){float r;asm("v_max_f32_e32 %0, %1, %2":"=v"(r):"v"(a),"v"(b));return r;}
__device__ __forceinline__ float fadd_s(float a,float b){float r;asm("v_add_f32_e32 %0, %1, %2":"=v"(r):"v"(a),"v"(b));return r;}
__device__ __forceinline__ float fsub_s(float a,float b){float r;asm("v_sub_f32_e32 %0, %1, %2":"=v"(r):"v"(a),"v"(b));return r;}
typedef float f32x2_t __attribute__((ext_vector_type(2))); typedef __bf16 bf16x2_t __attribute__((ext_vector_type(2)));
__device__ __forceinline__ unsigned cvtpk_s(float lo,float hi){f32x2_t v={lo,hi};bf16x2_t b=__builtin_convertvector(v,bf16x2_t);return __builtin_bit_cast(unsigned,b);}
#define WAIT_BAR(N) asm volatile("s_waitcnt vmcnt(" #N ") lgkmcnt(0)\n\ts_barrier":::"memory")

__device__ __forceinline__ void qkt(f32x16&p0,f32x16&p1,const char*Kslot,const bf16x8*qr,int r32,int hi){
  const char*kb=Kslot+hi*1024+r32*16;
  #pragma unroll
  for(int d0=0;d0<4;++d0){
    const bf16x8 b0=*reinterpret_cast<const bf16x8*>(kb+d0*2048);
    const bf16x8 b1=*reinterpret_cast<const bf16x8*>(kb+d0*2048+512);
    {p0=__builtin_amdgcn_mfma_f32_32x32x16_bf16(b0,qr[d0],p0,0,0,0);p1=__builtin_amdgcn_mfma_f32_32x32x16_bf16(b1,qr[d0],p1,0,0,0);}}
}
typedef __attribute__((address_space(3))) const char* lds_cptr;
typedef short v4i16_t __attribute__((ext_vector_type(4)));
__device__ __forceinline__ void kload8(bf16x8*kf,lds_cptr kp){
  kf[0]=*(const __attribute__((address_space(3))) bf16x8*)(kp);      kf[1]=*(const __attribute__((address_space(3))) bf16x8*)(kp+512);
  kf[2]=*(const __attribute__((address_space(3))) bf16x8*)(kp+2048); kf[3]=*(const __attribute__((address_space(3))) bf16x8*)(kp+2560);
  kf[4]=*(const __attribute__((address_space(3))) bf16x8*)(kp+4096); kf[5]=*(const __attribute__((address_space(3))) bf16x8*)(kp+4608);
  kf[6]=*(const __attribute__((address_space(3))) bf16x8*)(kp+6144); kf[7]=*(const __attribute__((address_space(3))) bf16x8*)(kp+6656);
}
__device__ __forceinline__ void kload2(bf16x8*kf,lds_cptr kp,int j){ kf[2*j]=*(const __attribute__((address_space(3))) bf16x8*)(kp+j*2048); kf[2*j+1]=*(const __attribute__((address_space(3))) bf16x8*)(kp+j*2048+512); }
__device__ __forceinline__ s16x4 vtr(lds_cptr p){ return __builtin_bit_cast(s16x4,__builtin_amdgcn_ds_read_tr16_b64_v4i16((__attribute__((address_space(3))) v4i16_t*)p)); }
__device__ __forceinline__ float rowmax(const f32x16&p0,const f32x16&p1){
  float a=max3f(p0[0],p0[1],p1[0]),b=max3f(p0[2],p0[3],p1[1]);a=max3f(a,p1[2],p1[3]);
  #pragma unroll
  for(int r=4;r<16;r+=4){a=max3f(a,p0[r],p0[r+1]);b=max3f(b,p0[r+2],p0[r+3]);a=max3f(a,p1[r],p1[r+1]);b=max3f(b,p1[r+2],p1[r+3]);}
  const float m=max2f(a,b);
  auto rr=__builtin_amdgcn_permlane32_swap(__float_as_uint(m),__float_as_uint(m),false,false);
  return max2f(__uint_as_float(rr[0]),__uint_as_float(rr[1]));
}
__device__ __forceinline__ void pv(f32x16*o,int vb,bf16x8 pa0,bf16x8 pa1,bf16x8 pa2,bf16x8 pa3){
  #pragma unroll
  for(int d0=0;d0<2;++d0){s16x4 lo[4],hi[4];
    #pragma unroll
    for(int ks=0;ks<4;++ks){
      asm volatile("ds_read_b64_tr_b16 %0,%1 offset:%c2":"=&v"(lo[ks]):"v"(vb),"i"(d0*4096+ks*1024):"memory");
      asm volatile("ds_read_b64_tr_b16 %0,%1 offset:%c2":"=&v"(hi[ks]):"v"(vb),"i"(d0*4096+ks*1024+512):"memory");}
    asm volatile("s_waitcnt lgkmcnt(0)":::"memory");SBAR();
    #define PK(k) (bf16x8){lo[k][0],lo[k][1],lo[k][2],lo[k][3],hi[k][0],hi[k][1],hi[k][2],hi[k][3]}
    o[d0]=__builtin_amdgcn_mfma_f32_32x32x16_bf16(pa0,PK(0),o[d0],0,0,0);
    o[d0]=__builtin_amdgcn_mfma_f32_32x32x16_bf16(pa1,PK(1),o[d0],0,0,0);
    o[d0]=__builtin_amdgcn_mfma_f32_32x32x16_bf16(pa2,PK(2),o[d0],0,0,0);
    o[d0]=__builtin_amdgcn_mfma_f32_32x32x16_bf16(pa3,PK(3),o[d0],0,0,0);
    #undef PK
  }
}

#ifndef ATTN_STORE16
#define ATTN_STORE16(p,v) (*(u32x4*)(p)=(v))
#endif
template<int THRL> __device__ __forceinline__ void attn_unit(int b,int h,int qb,const bf16*Q,const bf16*__restrict__ K,const bf16*__restrict__ V,bf16*O,float*SSQ,char*shm,const int wid){
  const int lane=fresh_lane(),r32=lane&31,hi=lane>>5;
  const long rowbase=(long)b*SEQ; const int q0=qb*QB;
  const bf16*Qw=Q+(rowbase+q0+wid*QBLK)*DM+h*D;
  const bf16*Kh=K+rowbase*DM+h*D,*Vh=V+rowbase*DM+h*D;
  const unsigned lds0=(unsigned)(uintptr_t)shm;
  float*wsf=(float*)(shm+LDS_WS)+wid*64;
  const bf16*ksrc=Kh+(long)lane*DM+wid*8;
  const bf16*vsrc=Vh+(long)(16*(wid&3)+(lane>>2))*DM+(wid>>2)*32+(lane&3)*8;
  const unsigned kdst=lds0+LDS_K+wid*1024, vdst=lds0+LDS_V+wid*1024;
  #define DMA_K(t,slot) glds16(ksrc+(long)(t)*KVBLK*DM,(unsigned)__builtin_amdgcn_readfirstlane(kdst+(slot)))
  #define DMA_V(t,slot) glds16(vsrc+(long)(t)*KVBLK*DM,(unsigned)__builtin_amdgcn_readfirstlane(vdst+(slot)))
  const char*Kbase=shm+LDS_K; bf16x8 kf[8];
  const lds_cptr shm3=(lds_cptr)shm; const lds_cptr kp0=shm3+LDS_K+hi*1024+r32*16; const lds_cptr vp0=shm3+LDS_V+((lane>>4)&1)*32+(lane&3)*8+(4*hi+((lane&15)>>2))*64;
  const __attribute__((address_space(3))) float* biasp=(const __attribute__((address_space(3))) float*)(shm3+LDS_BIAS)+4*hi;
  #define CINIT(P0,P1,t) do{ const __attribute__((address_space(3))) float* bp_=biasp+64*(t); _Pragma("unroll") for(int j_=0;j_<4;++j_){ const f32x4_t b0_=*(const __attribute__((address_space(3))) f32x4_t*)(bp_+8*j_), b1_=*(const __attribute__((address_space(3))) f32x4_t*)(bp_+32+8*j_); _Pragma("unroll") for(int k_=0;k_<4;++k_){ P0[4*j_+k_]=b0_[k_]-mhat; P1[4*j_+k_]=b1_[k_]-mhat; } } }while(0)
  const int NT=(q0+QB)/KVBLK;
  DMA_K(0,0);DMA_V(0,0);DMA_K(1,SLOTB);
  bf16x8 qr[4];
  #pragma unroll
  for(int d0=0;d0<4;++d0)qr[d0]=*reinterpret_cast<const bf16x8*>(&Qw[(long)r32*DM+d0*16+hi*8]);
  float mhat=((const __attribute__((address_space(3))) float*)((lds_cptr)shm+LDS_BIAS))[q0+wid*QBLK+r32],l_reg=0.f;f32x16 o[2];o[0]=f32x16{};o[1]=f32x16{};
  const int qrel=wid*QBLK+r32;
  #define CMASK(P0,P1,t) do{int jb_=(t)-(NT-4); if(jb_>=0)cmask(P0,P1,jb_,qrel,hi);}while(0)
  bool resc=false;
  #define START(P0,P1) do{ const float rm=rowmax(P0,P1); resc=false; \
    if(__any(rm>(float)THRL)){ const float dl=__builtin_fmaxf(rm,0.f); mhat=fadd_s(mhat,dl); \
      _Pragma("unroll") for(int r=0;r<16;++r){P0[r]=fsub_s(P0[r],dl);P1[r]=fsub_s(P1[r],dl);} \
      } \
    _Pragma("unroll") for(int r=0;r<16;++r)P0[r]=__builtin_amdgcn_exp2f(P0[r]); }while(0)
  #define RESC() do{ if(resc){ asm volatile("s_waitcnt lgkmcnt(0)":::"memory"); \
      _Pragma("unroll") for(int d_=0;d_<2;++d_) _Pragma("unroll") for(int r=0;r<16;++r)o[d_][r]*=wsf[crow(r,hi)]; } }while(0)
  f32x16 pA0,pA1,pB0,pB1;
  int sl_prev=0,sl_cur=0,sl_next=SLOTB;
  #define ROT() do{sl_prev=sl_cur;sl_cur=sl_next;sl_next=(sl_next==(NSLOT-1)*SLOTB)?0:sl_next+SLOTB;}while(0)
  DMA_K(2,2*SLOTB);
  WAIT_BAR(3);
  CINIT(pA0,pA1,0);qkt(pA0,pA1,Kbase,qr,r32,hi);asm volatile("s_nop 15\n\ts_nop 7":"+v"(pA0),"+v"(pA1));CMASK(pA0,pA1,0);
  START(pA0,pA1);
  _Pragma("unroll") for(int r=0;r<16;++r)pA1[r]=__builtin_amdgcn_exp2f(pA1[r]);
  WAIT_BAR(0);
  DMA_K(3,0);DMA_V(1,SLOTB);
  ROT();
  kload8(kf,kp0+sl_cur);
  WAIT_BAR(2);
  s16x4 vlo[8],vhi[8]; u32x4 pw0,pw1,pw2,pw3;
  #define PKW(P,B) cvtpk_s(P[B],P[B+1])
  #define PAF(k) __builtin_bit_cast(bf16x8,pw##k)
  #define VFR(i) (bf16x8){vlo[i][0],vlo[i][1],vlo[i][2],vlo[i][3],vhi[i][0],vhi[i][1],vhi[i][2],vhi[i][3]}
  #define PIN(x) asm volatile("":"+v"(x))
  #define MX3(a,b,c) __builtin_fmaxf(__builtin_fmaxf((a),(b)),(c))
  #define GAPA(MF,A0,A1,A2,A3,W0,W1,PW) do{ MF; sacc+=A0; sacc+=A1; sacc+=A2; sacc+=A3; PIN(sacc); W0; W1; PIN(PW); SBAR(); }while(0)
  #define EX(v) __builtin_amdgcn_exp2f(v)
  #define GAPB(MF,X,B) do{ MF; X[B]=EX(X[B]); X[B+1]=EX(X[B+1]); X[B+2]=EX(X[B+2]); X[B+3]=EX(X[B+3]); PIN(X); SBAR(); }while(0)
  #define VRD(i) do{ vlo[i]=vtr(vp_+(((i)>>2)*4096+((i)&3)*1024)); vhi[i]=vtr(vp_+(((i)>>2)*4096+((i)&3)*1024+512)); }while(0)
  #define KRD(G,j) do{ if(G){ kload2(kf,kp0+sl_next,j); SBAR(); } }while(0)
  #define STEP(C0,C1,P0,P1,t,GK,GV,GL) do{ SBAR(); CINIT(C0,C1,t); SBAR(); \
    const lds_cptr vp_=vp0+sl_prev; \
    VRD(0); SBAR(); float sacc=(P0[0]+P0[1]); \
    GAPA(C0=__builtin_amdgcn_mfma_f32_32x32x16_bf16(kf[0],qr[0],C0,0,0,0), P0[2],P0[3],P0[4],P0[5],     pw0[0]=PKW(P0,0), pw0[1]=PKW(P0,2), pw0); \
    VRD(4); SBAR(); GAPA(C1=__builtin_amdgcn_mfma_f32_32x32x16_bf16(kf[1],qr[0],C1,0,0,0), P0[6],P0[7],P0[8],P0[9],     pw0[2]=PKW(P0,4), pw0[3]=PKW(P0,6), pw0); \
    VRD(1); SBAR(); GAPA(C0=__builtin_amdgcn_mfma_f32_32x32x16_bf16(kf[2],qr[1],C0,0,0,0),   P0[10],P0[11],P0[12],P0[13], pw1[0]=PKW(P0,8), pw1[1]=PKW(P0,10), pw1); \
    VRD(5); SBAR(); GAPA(C1=__builtin_amdgcn_mfma_f32_32x32x16_bf16(kf[3],qr[1],C1,0,0,0),   P0[14],P0[15],P1[0],P1[1],   pw1[2]=PKW(P0,12),pw1[3]=PKW(P0,14), pw1); \
    VRD(2); SBAR(); GAPA(C0=__builtin_amdgcn_mfma_f32_32x32x16_bf16(kf[4],qr[2],C0,0,0,0),   P1[2],P1[3],P1[4],P1[5],     pw2[0]=PKW(P1,0), pw2[1]=PKW(P1,2), pw2); \
    VRD(6); SBAR(); GAPA(C1=__builtin_amdgcn_mfma_f32_32x32x16_bf16(kf[5],qr[2],C1,0,0,0),   P1[6],P1[7],P1[8],P1[9],     pw2[2]=PKW(P1,4), pw2[3]=PKW(P1,6), pw2); \
    VRD(3); SBAR(); GAPA(C0=__builtin_amdgcn_mfma_f32_32x32x16_bf16(kf[6],qr[3],C0,0,0,0),   P1[10],P1[11],P1[12],P1[13], pw3[0]=PKW(P1,8), pw3[1]=PKW(P1,10), pw3); \
    VRD(7); SBAR(); GAPA(C1=__builtin_amdgcn_mfma_f32_32x32x16_bf16(kf[7],qr[3],C1,0,0,0),   P1[14],P1[15],0.f,0.f,       pw3[2]=PKW(P1,12),pw3[3]=PKW(P1,14), pw3); \
    l_reg+=sacc; \
    if(GK){DMA_K((t)+3,sl_cur);} if(GV){DMA_V((t)+1,sl_next);} \
    CMASK(C0,C1,t); \
    { float a=MX3(C0[0],C0[1],C1[0]),b=MX3(C0[2],C0[3],C1[1]); a=MX3(a,C1[2],C1[3]); \
      _Pragma("unroll") for(int r=4;r<16;r+=4){a=MX3(a,C0[r],C0[r+1]);b=MX3(b,C0[r+2],C0[r+3]);a=MX3(a,C1[r],C1[r+1]);b=MX3(b,C1[r+2],C1[r+3]);} \
      float rm=__builtin_fmaxf(a,b); { auto rr=__builtin_amdgcn_permlane32_swap(__float_as_uint(rm),__float_as_uint(rm),false,false); rm=__builtin_fmaxf(__uint_as_float(rr[0]),__uint_as_float(rr[1])); } \
      resc=false; \
      if(__builtin_expect(__any(rm>(float)THRL),0)){ const float dl=__builtin_fmaxf(rm,0.f); mhat+=dl; \
        _Pragma("unroll") for(int r=0;r<16;++r){C0[r]-=dl;C1[r]-=dl;} \
        const float f=__builtin_amdgcn_exp2f(-dl); l_reg*=f; if(hi==0)wsf[r32]=f; resc=true; } } \
    SBAR(); \
    GAPB(o[0]=__builtin_amdgcn_mfma_f32_32x32x16_bf16(PAF(0),VFR(0),o[0],0,0,0), C0,0); \
    GAPB(o[1]=__builtin_amdgcn_mfma_f32_32x32x16_bf16(PAF(0),VFR(4),o[1],0,0,0), C0,4); \
    KRD(GL,0); GAPB(o[0]=__builtin_amdgcn_mfma_f32_32x32x16_bf16(PAF(1),VFR(1),o[0],0,0,0), C0,8); \
    KRD(GL,1); GAPB(o[1]=__builtin_amdgcn_mfma_f32_32x32x16_bf16(PAF(1),VFR(5),o[1],0,0,0), C0,12); \
    KRD(GL,2); GAPB(o[0]=__builtin_amdgcn_mfma_f32_32x32x16_bf16(PAF(2),VFR(2),o[0],0,0,0), C1,0); \
    KRD(GL,3); GAPB(o[1]=__builtin_amdgcn_mfma_f32_32x32x16_bf16(PAF(2),VFR(6),o[1],0,0,0), C1,4); \
    GAPB(o[0]=__builtin_amdgcn_mfma_f32_32x32x16_bf16(PAF(3),VFR(3),o[0],0,0,0), C1,8); \
    GAPB(o[1]=__builtin_amdgcn_mfma_f32_32x32x16_bf16(PAF(3),VFR(7),o[1],0,0,0), C1,12); \
    }while(0)
  int t=1;
  #undef CMASK
  #define CMASK(P0,P1,t) do{}while(0)
  for(;t+5<NT;t+=2){
    STEP(pB0,pB1,pA0,pA1,t,true,true,true);     WAIT_BAR(2); RESC(); ROT();
    STEP(pA0,pA1,pB0,pB1,t+1,true,true,true);   WAIT_BAR(2); RESC(); ROT();
  }
  #undef CMASK
  #define CMASK(P0,P1,t) do{int jb_=(t)-(NT-4); if(jb_>=0)cmask(P0,P1,jb_,qrel,hi);}while(0)
  #define ENDW(tt) do{ if((tt)+3<NT){WAIT_BAR(2);} else if((tt)+2<NT){WAIT_BAR(1);} else {WAIT_BAR(0);} }while(0)
  for(;t+1<NT;t+=2){
    STEP(pB0,pB1,pA0,pA1,t,(t+3<NT),(t+1<NT),(t+1<NT));       ENDW(t);   RESC(); ROT();
    STEP(pA0,pA1,pB0,pB1,t+1,(t+4<NT),(t+2<NT),(t+2<NT));     ENDW(t+1); RESC(); ROT();
  }
  STEP(pB0,pB1,pA0,pA1,NT-1,false,false,false); RESC();
  { float sacc=pB0[0]+pB0[1]; _Pragma("unroll") for(int r=2;r<16;++r)sacc+=pB0[r]; _Pragma("unroll") for(int r=0;r<16;++r)sacc+=pB1[r]; l_reg+=sacc;
    pw0=(u32x4){PKW(pB0,0),PKW(pB0,2),PKW(pB0,4),PKW(pB0,6)};pw1=(u32x4){PKW(pB0,8),PKW(pB0,10),PKW(pB0,12),PKW(pB0,14)};pw2=(u32x4){PKW(pB1,0),PKW(pB1,2),PKW(pB1,4),PKW(pB1,6)};pw3=(u32x4){PKW(pB1,8),PKW(pB1,10),PKW(pB1,12),PKW(pB1,14)};
    SBAR(); pv(o,(int)(uintptr_t)vp0+sl_cur,PAF(0),PAF(1),PAF(2),PAF(3)); }
  #undef PKW
  #undef PAF
  #undef VFR
  #undef PIN
  #undef MX3
  #undef GAPA
  #undef GAPB
  #undef EX
  #undef VRD
  #undef KRD
  #undef STEP
  #undef ENDW
  {auto rr=__builtin_amdgcn_permlane32_swap(__float_as_uint(l_reg),__float_as_uint(l_reg),false,false);l_reg=__uint_as_float(rr[0])+__uint_as_float(rr[1]);}
  if(hi==0)wsf[32+r32]=l_reg;asm volatile("s_waitcnt lgkmcnt(0)":::"memory");
  float rli[16];
  #pragma unroll
  for(int r=0;r<16;++r)rli[r]=__builtin_amdgcn_rcpf(wsf[32+crow(r,hi)]);
  bf16*Ow=O+(rowbase+q0+wid*QBLK)*OP+h*D; float*Sw=SSQ+(rowbase+q0+wid*QBLK)*8+h;
  { bf16*stg=(bf16*)(shm+LDS_OST)+wid*2048;
    #pragma unroll
    for(int r=0;r<16;++r){const int orow=crow(r,hi);
      #pragma unroll
      for(int d0=0;d0<2;++d0)stg[orow*64+d0*32+r32]=__float2bfloat16(o[d0][r]*rli[r]);}
    asm volatile("s_waitcnt lgkmcnt(0)":::"memory");
    #pragma unroll
    for(int i=0;i<4;++i){const int row=i*8+(lane>>3),ch=lane&7; const u32x4 v=*(const u32x4*)(stg+row*64+ch*8); ATTN_STORE16(Ow+(long)row*OP+ch*8,v);
      float sq=0.f; _Pragma("unroll") for(int k_=0;k_<4;++k_){ const float a_=__uint_as_float(v[k_]<<16), b_=__uint_as_float(v[k_]&0xffff0000u); sq+=a_*a_+b_*b_; }
      sq+=__shfl_xor(sq,1); sq+=__shfl_xor(sq,2); sq+=__shfl_xor(sq,4); if(ch==0)Sw[(long)row*8]=sq; } }
  asm volatile("s_waitcnt lgkmcnt(0)\n\ts_barrier":::"memory");
  #undef DMA_K
  #undef DMA_V
  #undef CMASK
  #undef CINIT
  #undef START
  #undef RESC
  #undef ROT
}
constexpr int ATTN_LDS_BYTES=LDS_BYTES;
#undef SBAR
#undef WAIT_BAR
}

__device__ __forceinline__ void attn_fast(Frame& F) {
    F.refresh();
    const attn_body::bf16* Q = (const attn_body::bf16*)(F.ws + WS_QKVUV); const attn_body::bf16* Kb = Q + (size_t)M * 512; const attn_body::bf16* Vb = Kb + (size_t)M * 512;
    attn_body::bf16* O = (attn_body::bf16*)(F.ws + WS_MG); float* SSQ = (float*)(F.ws + WS_SSQA); const float* logf = (const float*)(F.ws + WS_LOGF);
    LAS float* bias = (LAS float*)(F.lds + attn_body::LDS_BIAS); LAS float* wsum = (LAS float*)(F.lds + attn_body::LDS_WS);
    for (int it = 0;; ++it) {
        const int pr = F.vcu + (it >> 1) * F.G; if (pr >= NB * NH * 4) break;
        const int bh = pr >> 2, sidx = pr & 3;
        if (!(it & 1)) {
            const f32x4 v = *(const f32x4*)(logf + (size_t)bh * SEQ + 4 * F.tid);
            const float a0 = v.x, a1 = a0 + v.y, a2 = a1 + v.z, a3 = a2 + v.w; float run = a3;
#pragma unroll
            for (int o = 1; o < 64; o <<= 1) { const float t = __shfl_up(run, o); if (F.lane >= o) run += t; }
            if (F.lane == 63) wsum[F.wave] = run;
            __syncthreads();
            float base = run - a3;
#pragma unroll
            for (int w = 0; w < 8; ++w) if (w < F.wave) base += wsum[w];
            *(LAS f32x4*)(bias + 4 * F.tid) = (f32x4){-(base + a0) * LOG2E, -(base + a1) * LOG2E, -(base + a2) * LOG2E, -(base + a3) * LOG2E};
            __syncthreads();
        }
        attn_body::attn_unit<8>(bh / NH, bh % NH, (it & 1) ? 7 - sidx : sidx, Q, Kb, Vb, O, SSQ, (char*)F.lds, F.wave);
    }
}
typedef float f32x16 __attribute__((ext_vector_type(16)));
__device__ __forceinline__ void sgu_fast(Frame& F, int l) {
    const bf16* U = (const bf16*)(F.ws + WS_QKVUV) + (size_t)3 * M * 512; const bf16* SV = U + (size_t)M * 512;
    bf16* MG = (bf16*)(F.ws + WS_MG); float* ssq = (float*)(F.ws + WS_SSQS);
    LAS float* st = (LAS float*)F.lds;
    LAS unsigned char* vnT = F.lds + 1024;
    const float* gv = F.in[I_GV] + l * AW;
    F.refresh();
    const int lane = F.lane, wave = F.wave, r32 = lane & 31, hi = lane >> 5, gl = wave >> 1, dh = wave & 1;
    for (int un = F.vcu; un < NB * 16 * 2; un += F.G) {
        const int gh = un & 1, ch = (un >> 1) & 15, b = un >> 5; const size_t rb = (size_t)b * SEQ + ch * 128;
        __syncthreads();
        for (int r = wave * 16; r < wave * 16 + 16; ++r) {
            const u32x4 w = *((const u32x4*)(SV + (rb + r) * 512) + lane); float x[8];
#pragma unroll
            for (int k = 0; k < 4; ++k) { x[2 * k] = __uint_as_float(w[k] << 16); x[2 * k + 1] = __uint_as_float(w[k] & 0xffff0000u); }
            float sm = 0.f;
#pragma unroll
            for (int k = 0; k < 8; ++k) sm += x[k];
            const float mean = wave_sum(sm) * (1.f / 512.f); float q = 0.f;
#pragma unroll
            for (int k = 0; k < 8; ++k) { const float d = x[k] - mean; q += d * d; }
            const float rstd = 1.0f / sqrtf(wave_sum(q) * (1.f / 512.f) + EPS);
            if (lane == 0) { st[2 * r] = mean; st[2 * r + 1] = rstd; }
        }
        __syncthreads();
#pragma unroll
        for (int k = 0; k < 4; ++k) {
            const int c = wave + 8 * k, s0 = 2 * lane; const int col = gh * 256 + 8 * c;
            const u32x4 w0 = *(const u32x4*)(SV + (rb + s0) * 512 + col), w1 = *(const u32x4*)(SV + (rb + s0 + 1) * 512 + col);
            const f32x4 g0 = *(const f32x4*)(gv + col), g1 = *(const f32x4*)(gv + col + 4);
            const float m0 = st[2 * s0], r0 = st[2 * s0 + 1], m1 = st[2 * s0 + 2], r1 = st[2 * s0 + 3];
#pragma unroll
            for (int j = 0; j < 8; ++j) { const float gj = j < 4 ? g0[j] : g1[j - 4];
                const float x0 = (j & 1) ? __uint_as_float(w0[j >> 1] & 0xffff0000u) : __uint_as_float(w0[j >> 1] << 16);
                const float x1 = (j & 1) ? __uint_as_float(w1[j >> 1] & 0xffff0000u) : __uint_as_float(w1[j >> 1] << 16);
                *(LAS unsigned*)(vnT + (size_t)(8 * c + j) * 272 + 2 * s0) = pk2((x0 - m0) * r0 * gj, (x1 - m1) * r1 * gj); }
        }
        __syncthreads();
        const int g = gh * 4 + gl;
        f32x16 acc[4];
#pragma unroll
        for (int tt = 0; tt < 4; ++tt) acc[tt] = (f32x16){};
        const float* Wg = F.in[I_WSP] + ((size_t)l * 8 + g) * 128 * 128;
#pragma unroll
        for (int kk = 0; kk < 8; ++kk) {
            const bf16x8 bfrag = *(const LAS bf16x8*)(vnT + (size_t)(gl * 64 + dh * 32 + r32) * 272 + (16 * kk + 8 * hi) * 2);
#pragma unroll
            for (int tt = 0; tt < 4; ++tt) if (kk < 2 * (tt + 1)) {
                const int t = 32 * tt + r32, s0 = 16 * kk + 8 * hi;
                const f32x4 w0 = *(const f32x4*)(Wg + t * 128 + s0), w1 = *(const f32x4*)(Wg + t * 128 + s0 + 4);
                float wv[8] = {w0[0], w0[1], w0[2], w0[3], w1[0], w1[1], w1[2], w1[3]};
#pragma unroll
                for (int j = 0; j < 8; ++j) if (s0 + j > t) wv[j] = 0.f;
                u32x4 pa; pa.x = pk2(wv[0], wv[1]); pa.y = pk2(wv[2], wv[3]); pa.z = pk2(wv[4], wv[5]); pa.w = pk2(wv[6], wv[7]);
                acc[tt] = __builtin_amdgcn_mfma_f32_32x32x16_bf16(__builtin_bit_cast(bf16x8, pa), bfrag, acc[tt], 0, 0, 0);
            }
        }
        __syncthreads();
        LAS float* stg = (LAS float*)(vnT + wave * 8192);
        const float* bsp = F.in[I_BSP] + ((size_t)l * 8 + g) * 128;
#pragma unroll
        for (int rnd = 0; rnd < 2; ++rnd) {
#pragma unroll
            for (int t2 = 0; t2 < 2; ++t2)
#pragma unroll
                for (int r = 0; r < 16; ++r) stg[(t2 * 32 + (r & 3) + 8 * (r >> 2) + 4 * hi) * 32 + r32] = acc[2 * rnd + t2][r];
            asm volatile("s_waitcnt lgkmcnt(0)" ::: "memory");
#pragma unroll
            for (int k = 0; k < 4; ++k) {
                const int row = (lane >> 2) + 16 * k, c4 = lane & 3, t = 64 * rnd + row;
                const f32x4 m0 = *(const LAS f32x4*)(stg + row * 32 + 8 * c4), m1 = *(const LAS f32x4*)(stg + row * 32 + 8 * c4 + 4);
                const int col = g * 64 + dh * 32 + 8 * c4; const float bs = bsp[t];
                const u32x4 uw = *(const u32x4*)(U + (rb + t) * 512 + col);
                float o[8]; float sq = 0.f;
#pragma unroll
                for (int j = 0; j < 8; ++j) { const float uu = (j & 1) ? __uint_as_float(uw[j >> 1] & 0xffff0000u) : __uint_as_float(uw[j >> 1] << 16);
                    o[j] = uu * ((j < 4 ? m0[j] : m1[j - 4]) + bs); sq += o[j] * o[j]; }
                store8_bf16(MG + (rb + t) * DM + AW + col, o);
                sq += __shfl_xor(sq, 1); sq += __shfl_xor(sq, 2);
                if (c4 == 0) ssq[(rb + t) * 16 + g * 2 + dh] = sq;
            }
            asm volatile("s_waitcnt lgkmcnt(0)" ::: "memory");
        }
    }
    __syncthreads();
}
#define XB_TMO      128
#define XB_XCNT(j)  (256  + 64 * (j))
#define XB_XSUB(j)  (1280 + 64 * (j))
#define XB_XGEN(j)  (2304 + 64 * (j))
#define XB_TOP      3328
#define XB_TOPGEN   3392
#define XCD_BAR_WORDS 3456
#define XB_SPIN_CAP (1u << 18)

__device__ __forceinline__ unsigned xb_ld(unsigned* p)              { return __hip_atomic_load(p, __ATOMIC_RELAXED, __HIP_MEMORY_SCOPE_AGENT); }
__device__ __forceinline__ unsigned xb_add(unsigned* p, unsigned v) { return __hip_atomic_fetch_add(p, v, __ATOMIC_RELAXED, __HIP_MEMORY_SCOPE_AGENT); }
__device__ __forceinline__ unsigned xb_xcc_id() { return (unsigned)__builtin_amdgcn_s_getreg((3 << 11) | 20) & 0xFu; }
#define XB_SPIN(cond, bar) do { unsigned _sp = 0; while (cond) { __builtin_amdgcn_s_sleep(1); \
    if ((++_sp & 255u) == 0u) { if (xb_ld(&(bar)[XB_TMO])) break; if (_sp > XB_SPIN_CAP) { atomicAdd(&(bar)[XB_TMO], 1u); break; } } } } while (0)

struct XcdBarrier {
    unsigned* bar; unsigned x;
    volatile LAS unsigned* st;
};

__device__ __forceinline__ XcdBarrier xcd_barrier_post(unsigned* bar, volatile LAS unsigned* st, const bool leader) {
    XcdBarrier b; b.bar = bar; b.x = xb_xcc_id(); b.st = st;
    if (leader) (void)xb_add(&bar[XB_XCNT(b.x)], 1u);
    return b;
}
__device__ __forceinline__ void xcd_barrier_complete(unsigned* bar, unsigned x, unsigned& nloc, unsigned& nx) {
    const unsigned G = gridDim.x * gridDim.y * gridDim.z;
    unsigned sum, cnt, mine, sp = 0u;
    for (;;) {
        sum = 0u; cnt = 0u; mine = 0u;
#pragma unroll
        for (unsigned j = 0; j < 16; ++j) { const unsigned c = xb_ld(&bar[XB_XCNT(j)]); sum += c; cnt += (c > 0u) ? 1u : 0u; mine = (j == x) ? c : mine; }
        if (sum == G) break;
        __builtin_amdgcn_s_sleep(1);
        if ((++sp & 255u) == 0u) { if (xb_ld(&bar[XB_TMO])) break; if (sp > XB_SPIN_CAP) { atomicAdd(&bar[XB_TMO], 1u); break; } }
    }
    nloc = mine > 0u ? mine : 1u; nx = cnt > 0u ? cnt : 1u;
}

__device__ __forceinline__ void xcd_barrier(const XcdBarrier& b, const bool leader) {
    asm volatile("s_waitcnt vmcnt(0)" ::: "memory");
    __syncthreads();
    if (leader) {
        unsigned* bar = b.bar;
        __builtin_amdgcn_s_waitcnt(0);
        unsigned nloc = b.st[0], nx = b.st[1];
        if (nloc == 0u) { xcd_barrier_complete(bar, b.x, nloc, nx); b.st[0] = nloc; b.st[1] = nx; }
        const unsigned old = xb_add(&bar[XB_XSUB(b.x)], 1u);
        const unsigned gen = old / nloc;
        if (old + 1u == (gen + 1u) * nloc) {
            __builtin_amdgcn_fence(__ATOMIC_RELEASE, "agent");
            asm volatile("s_waitcnt vmcnt(0)" ::: "memory");
            const unsigned og = xb_add(&bar[XB_TOP], 1u);
            const unsigned tg = og / nx;
            if (og + 1u == (tg + 1u) * nx) xb_add(&bar[XB_TOPGEN], 1u);
            else XB_SPIN(xb_ld(&bar[XB_TOPGEN]) == tg, bar);
            __builtin_amdgcn_fence(__ATOMIC_ACQUIRE, "agent");
            xb_add(&bar[XB_XGEN(b.x)], 1u);
            asm volatile("s_waitcnt vmcnt(0)" ::: "memory");
        } else {
            XB_SPIN(xb_ld(&bar[XB_XGEN(b.x)]) == gen, bar);
            __builtin_amdgcn_fence(__ATOMIC_ACQUIRE, "agent");
            asm volatile("s_waitcnt vmcnt(0)" ::: "memory");
        }
    }
    __syncthreads();
}

template <int L> __device__ __forceinline__ void layer_phases(Frame& F, const int lo, const int hi, const XcdBarrier& bar) {
#define IN(k) (lo <= (k) && (k) < hi)
#define SEAM(k) do { if (IN(k) && IN((k) + 1)) { xcd_barrier(bar, F.wave == 0 && fresh_lane() == 0); } } while (0)

        constexpr int l = L, pb = 2 + 9 * L; constexpr bool moe = (L & 1) != 0;
        if (IN(pb + 0)) {
            StaticOrder S; S.init(M, NIN, F.G, (int)blockIdx.x, DM); EpiInproj E{(bf16*)(F.ws + WS_QKVUV)};
            gemm_run<FAST_INPROJ>(F, (const bf16*)(F.ws + WS_H), (const bf16*)(F.ws + WS_WIN) + (size_t)l * NIN * DM, DM, S, E);
            if (F.G == 256 && blockIdx.x >= 128) conv_filler(F, l == 0 ? 0 : 2);
        }
        SEAM(pb + 0);
        if (IN(pb + 1)) {
#if FAST_ATTN
            attn_fast(F);
#else
            attn_simple(F);
#endif
#if FAST_SGU
            sgu_fast(F, l);
#else
            sgu_simple(F, l);
#endif
        }
#if FUSE_MERGE
        if (IN(pb + 1) && IN(pb + 3)) xcd_barrier(bar, F.wave == 0 && fresh_lane() == 0);
#else
        SEAM(pb + 1);
#endif
#if FUSE_MERGE
#else
        if (IN(pb + 2)) phase_merge_norm(F);
        SEAM(pb + 2);
#endif
        if (IN(pb + 3)) {
#if FUSE_MERGE
            StaticOrder S; S.init(M, DM, F.G, (int)blockIdx.x, DM); SingleOrder S1;
            for (int i = 0; S.next(i, S1.u0); ++i) {
                F.refresh();
                if (F.tid < 256) { const int row = S1.u0.pm * 256 + F.tid; const float* sa = (const float*)(F.ws + WS_SSQA) + (size_t)row * 8; const float* ss = (const float*)(F.ws + WS_SSQS) + (size_t)row * 16;
                    const f32x4 a0 = *(const f32x4*)sa, a1 = *(const f32x4*)(sa + 4), s0 = *(const f32x4*)ss + *(const f32x4*)(ss + 8), s1 = *(const f32x4*)(ss + 4) + *(const f32x4*)(ss + 12);
                    const float ra = 1.0f / sqrtf(((a0.x + a0.y) + (a0.z + a0.w) + (a1.x + a1.y) + (a1.z + a1.w)) * (1.f / AW) + EPS);
                    const float rs = 1.0f / sqrtf(((s0.x + s0.y) + (s0.z + s0.w) + (s1.x + s1.y) + (s1.z + s1.w)) * (1.f / AW) + EPS);
                    LAS float* rt = (LAS float*)(F.lds + RTAB_OFF); rt[2 * F.tid] = ra / rs; rt[2 * F.tid + 1] = rs; }
                __syncthreads();
                const Gemm g{(const bf16*)(F.ws + WS_MG), (const bf16*)(F.ws + WS_WOUT) + (size_t)l * DM * DM, 0, 0, DM}; const EpiWrap<EpiYscaled> W{EpiYscaled{(bf16*)(F.ws + WS_Y), F.lds}};
                gemm_phase<EpiWrap<EpiYscaled>, SingleOrder, true, true, false, true>(F.lds, g, S1, W, F.wave);
                __syncthreads();
            }
#else
            StaticOrder S; S.init(M, DM, F.G, (int)blockIdx.x, DM); EpiYbf16 E{(bf16*)(F.ws + WS_Y)};
            gemm_run<FAST_OUTPROJ>(F, (const bf16*)(F.ws + WS_MG2), (const bf16*)(F.ws + WS_WOUT) + (size_t)l * DM * DM, DM, S, E);
#endif
        }
        SEAM(pb + 3);
        if (IN(pb + 4)) phase_postmix(F, l, l == 0 ? F.in[I_X] : nullptr, moe);
        if (moe) { SEAM(pb + 4); if (IN(pb + 5)) phase_scatter(F); SEAM(pb + 5); }
        else { if (IN(pb + 4) && IN(pb + 6)) xcd_barrier(bar, F.wave == 0 && fresh_lane() == 0); }
        if (IN(pb + 6)) {
            if (!moe) { StaticOrder S; S.init(M, 2 * DFF, F.G, (int)blockIdx.x, DM); EpiSwiglu E{(bf16*)(F.ws + WS_ACT), DFF, 2 * DFF / 256};
                gemm_run<FAST_FFN1D>(F, (const bf16*)(F.ws + WS_H), (const bf16*)(F.ws + WS_WGU), DM, S, E);
                if (F.G == 256 && blockIdx.x >= 128) conv_filler(F, 1); }
            else { MoeOrder S; S.init(F.ctl + CW_CNT, 2 * EFF / 256, F.G, (int)blockIdx.x, DM / 2, false); EpiSwiglu8 E{F.ws + WS_ACT, EFF, 2 * EFF / 256};
                gemm_run<true, false, true>(F, (const bf16*)(F.ws + WS_HS), (const bf16*)(F.ws + WS_EGU), DM / 2, S, E);
                if (F.G == 256) conv_tail(F, (int)blockIdx.x - S.Lf, F.G - S.Lf); }
        }
        SEAM(pb + 6);
        if (IN(pb + 7)) {
            if (!moe) { StaticOrder S; S.init(M, DM, F.G, (int)blockIdx.x, DFF); EpiYbf16 E{(bf16*)(F.ws + WS_Y)};
                gemm_run<FAST_FFN2D>(F, (const bf16*)(F.ws + WS_ACT), (const bf16*)(F.ws + WS_WD), DFF, S, E); }
            else { MoeOrder S; S.init(F.ctl + CW_CNT, DM / 256, F.G, (int)blockIdx.x, EFF / 2, true); EpiF32 E{(float*)(F.ws + WS_YS), DM, 4, (float*)(F.ws + WS_PART), 1.f / (W8_SCALE * A8_SCALE)};
                gemm_run<true, true, true>(F, (const bf16*)(F.ws + WS_ACT), (const bf16*)(F.ws + WS_ED), EFF / 2, S, E); }
        }
        SEAM(pb + 7);
        if (IN(pb + 8)) phase_final(F, l, moe);
        SEAM(pb + 8);
#undef SEAM
#undef IN
}
struct Args { const float* in[21]; float* out; unsigned char* ws; int ph_lo, ph_hi, li, pad; };
constexpr int NPHASES = 20;
__global__ void __launch_bounds__(NTHREADS, 2) fwd(Args args) {
    extern __shared__ __attribute__((aligned(16))) unsigned char lds[];
    Frame F;
    F.lds = (LAS unsigned char*)lds; F.wave = __builtin_amdgcn_readfirstlane((int)threadIdx.x >> 6); F.refresh();
    F.G = gridDim.x; { const int bx = blockIdx.x; F.vcu = (F.G % 8 == 0) ? (bx % 8) * (F.G / 8) + bx / 8 : bx; }
    F.ws = args.ws; F.ctl = (unsigned*)(args.ws + WS_CTL); F.out = args.out;
#pragma unroll
    for (int i = 0; i < 21; ++i) F.in[i] = args.in[i];
    const int lo = args.ph_lo, hi = args.ph_hi;
    volatile LAS unsigned* MISC = (volatile LAS unsigned*)(F.lds + MISC_OFF);
    if (F.tid < 32) MISC[F.tid] = 0u;
    __syncthreads();
    const XcdBarrier bar = xcd_barrier_post(F.ctl + CW_BAR + args.li * XCD_BAR_WORDS, MISC + 8, F.tid == 0);
#define IN(k) (lo <= (k) && (k) < hi)
    if (IN(0)) p0_prologue(F);
    if (IN(0) && IN(1)) xcd_barrier(bar, F.wave == 0 && fresh_lane() == 0);
    if (IN(1)) phase_premix(F, 0, F.in[I_X]);
    if (IN(1) && IN(2)) xcd_barrier(bar, F.wave == 0 && fresh_lane() == 0);
    layer_phases<0>(F, lo, hi, bar);
    layer_phases<1>(F, lo, hi, bar);
#undef IN
}

extern "C" void kernel_launch(void* const* d_in, const int* in_sizes, int n_in, void* d_out, int out_size, void* d_ws, size_t ws_size, hipStream_t stream) {
    static int grid = 0;
    if (grid == 0) {
        if (n_in != 21 || out_size != M * DM || ws_size < WS_END) { fprintf(stderr, "kernel_launch: unexpected problem (n_in %d out %d ws %zu)\n", n_in, out_size, ws_size); grid = -1; return; }
        int dev = 0, cus = 0;
        if (hipGetDevice(&dev) != hipSuccess || hipDeviceGetAttribute(&cus, hipDeviceAttributeMultiprocessorCount, dev) != hipSuccess) { grid = -1; return; }
        if (hipFuncSetAttribute((const void*)fwd, hipFuncAttributeMaxDynamicSharedMemorySize, LDS_BYTES) != hipSuccess) { grid = -1; return; }
        grid = cus;
    }
    if (grid < 0) return;
    (void)hipMemsetAsync((char*)d_ws + WS_CTL, 0, CTL_ZERO_BYTES, stream);
    Args a{};
    for (int i = 0; i < 21; ++i) a.in[i] = (const float*)d_in[i];
    a.out = (float*)d_out; a.ws = (unsigned char*)d_ws;
#ifndef N_LAUNCH
#define N_LAUNCH 1
#endif
#if N_LAUNCH == 1
    a.ph_lo = 0; a.ph_hi = NPHASES; a.li = 0;
    hipLaunchKernelGGL(fwd, dim3(grid), dim3(NTHREADS), LDS_BYTES, stream, a);
#else
    for (int p = 0; p < NPHASES; ++p) {
        if (p == 2 + 5) continue;
#if FUSE_MERGE
        if (p == 2 + 2 || p == 11 + 2) continue;
#endif
        a.ph_lo = p; a.ph_hi = p + 1; a.li = 0;
        hipLaunchKernelGGL(fwd, dim3(grid), dim3(NTHREADS), LDS_BYTES, stream, a);
    }
#endif
}
```
